# Optimizing an MI355X kernel written in HIP

```python
import math
import jax, jax.numpy as jnp
from jax import lax
import numpy as np

D_MODEL = 1024
BATCH = 8
SEQ = 2048
DEPTH = 2
DEC_BATCH = 128
DEC_SEQ = 4
PAST_LEN = 16384
PAGE_SIZE = 128

N_META = 16
MIX_WIDTH = D_MODEL // 2
GLA_HEADS = 4
GLA_DV = MIX_WIDTH // GLA_HEADS
GLA_DK = GLA_DV // 2
GLA_GATE_RANK = 16
GLA_GATE_NORM = 16.0
GLA_CHUNK = 16
SSM_HEAD_DIM = 64
SSM_HEADS = MIX_WIDTH // SSM_HEAD_DIM
SSM_GROUPS = 2
SSM_STATE = 64
SSM_CONV = 4
SSM_CONV_DIM = MIX_WIDTH + 2 * SSM_GROUPS * SSM_STATE
SSM_CHUNK = 128
RET_HEADS = 4
RET_DV = MIX_WIDTH // RET_HEADS
RET_DK = RET_DV // 2
RET_CHUNK = 128
ROPE_BASE = 10000.0
D_FF = 4 * D_MODEL
ALPHA = (2 * DEPTH) ** 0.25
BETA = (8 * DEPTH) ** -0.25
N_BRANCH = 3
SPLIT_SIZES = (GLA_HEADS * GLA_DK, GLA_HEADS * GLA_DK, MIX_WIDTH, MIX_WIDTH, GLA_GATE_RANK,
               MIX_WIDTH, SSM_CONV_DIM, SSM_HEADS,
               RET_HEADS * RET_DK, RET_HEADS * RET_DK, MIX_WIDTH, MIX_WIDTH,
               N_BRANCH * D_MODEL)
D_IN_PROJ = sum(SPLIT_SIZES)

kernel_name = 'hybrid_gla_ssd_retention_decoder_step'


def layer_norm(x, w, b, eps=1e-5):
    xf = x.astype(jnp.float32)
    mu = jnp.mean(xf, axis=-1, keepdims=True)
    var = jnp.mean(jnp.square(xf - mu), axis=-1, keepdims=True)
    return ((xf - mu) * lax.rsqrt(var + eps) * w + b).astype(x.dtype)


def rms_norm(x, w=None, eps=1e-6):
    xf = x.astype(jnp.float32)
    y = xf * lax.rsqrt(jnp.mean(xf * xf, axis=-1, keepdims=True) + eps)
    if w is not None:
        y = y * w
    return y.astype(x.dtype)


def rotary(x, pos):
    half = x.shape[-1] // 2
    inv_freq = ROPE_BASE ** (-jnp.arange(half, dtype=jnp.float32) / half)
    ang = pos.astype(jnp.float32)[:, None] * inv_freq[None, :]
    cos = jnp.cos(ang)[None, :, None, :]
    sin = jnp.sin(ang)[None, :, None, :]
    xf = x.astype(jnp.float32)
    x1, x2 = xf[..., :half], xf[..., half:]
    return jnp.concatenate([x1 * cos - x2 * sin, x1 * sin + x2 * cos], axis=-1).astype(x.dtype)


def gated_linear_recurrence(q, k, v, g, s0, chunk):
    f32 = jnp.float32
    b, t, h, _ = q.shape
    dv = v.shape[-1]
    n = t // chunk
    scalar_decay = g.shape[-1] == 1
    mask = jnp.tril(jnp.ones((chunk, chunk), dtype=bool))[None, :, :, None, None]

    def blocks(a):
        return a.astype(f32).reshape(b, n, chunk, h, a.shape[-1]).swapaxes(0, 1)

    def step(s, inp):
        qc, kc, vc, gc = inp
        G = jnp.cumsum(gc, axis=1)
        G_end = G[:, -1]
        diff = G[:, :, None] - G[:, None, :]
        decay = jnp.exp(jnp.where(mask, diff, -jnp.inf))
        if scalar_decay:
            att = jnp.einsum('bthk,bshk->btsh', qc, kc) * decay[..., 0]
        else:
            att = jnp.einsum('bthk,bshk,btshk->btsh', qc, kc, decay)
        o = (jnp.einsum('btsh,bshv->bthv', att, vc)
             + jnp.einsum('bthk,bhkv->bthv', qc * jnp.exp(G), s))
        s_new = (jnp.exp(G_end)[..., None] * s
                 + jnp.einsum('bshk,bshv->bhkv', kc * jnp.exp(G_end[:, None] - G), vc))
        return s_new, o

    s_fin, o = lax.scan(step, s0.astype(f32), (blocks(q), blocks(k), blocks(v), blocks(g)))
    o = o.swapaxes(0, 1).reshape(b, t, h, dv)
    return o.astype(v.dtype), s_fin.astype(s0.dtype)


def run_recurrence(q, k, v, g, s0, chunk, prompt):
    if not prompt:
        return gated_linear_recurrence(q, k, v, g, s0, q.shape[1])
    o_meta, s = gated_linear_recurrence(q[:, :N_META], k[:, :N_META], v[:, :N_META],
                                        g[:, :N_META], s0, N_META)
    o_body, s = gated_linear_recurrence(q[:, N_META:], k[:, N_META:], v[:, N_META:],
                                        g[:, N_META:], s, chunk)
    return jnp.concatenate([o_meta, o_body], axis=1), s


def token_mixers(u, pos, state, wl, prompt):
    b, t, _ = u.shape
    f32 = jnp.float32
    dtype = u.dtype
    proj = jnp.einsum('btd,de->bte', u, wl['w_in'])
    offs = np.cumsum(SPLIT_SIZES)[:-1].tolist()
    (gla_q, gla_k, gla_v, gla_r, gla_a, ssm_z, ssm_xbc, ssm_dt,
     ret_q, ret_k, ret_v, ret_g, gate_logits) = jnp.split(proj, offs, axis=-1)
    if prompt:
        s_gla = jnp.zeros((b, GLA_HEADS, GLA_DK, GLA_DV), dtype)
        s_ssm = jnp.zeros((b, SSM_HEADS, SSM_STATE, SSM_HEAD_DIM), dtype)
        conv_buf = jnp.zeros((b, SSM_CONV - 1, SSM_CONV_DIM), dtype)
        s_ret = jnp.zeros((b, RET_HEADS, RET_DK, RET_DV), dtype)
    else:
        s_gla, s_ssm, conv_buf, s_ret = state

    q = gla_q.reshape(b, t, GLA_HEADS, GLA_DK) * (GLA_DK ** -0.5)
    k = gla_k.reshape(b, t, GLA_HEADS, GLA_DK)
    v = gla_v.reshape(b, t, GLA_HEADS, GLA_DV)
    a = jnp.einsum('btr,re->bte', gla_a, wl['w_gla_a2']) + wl['b_gla_a']
    g = (jax.nn.log_sigmoid(a.astype(f32)) / GLA_GATE_NORM).reshape(b, t, GLA_HEADS, GLA_DK)
    o, s_gla_new = run_recurrence(q, k, v, g, s_gla, GLA_CHUNK, prompt)
    y_gla = jax.nn.silu(gla_r) * rms_norm(o, wl['w_gla_norm']).reshape(b, t, MIX_WIDTH)

    xbc_in = jnp.concatenate([conv_buf.astype(dtype), ssm_xbc], axis=1)
    conv_new = xbc_in[:, -(SSM_CONV - 1):]
    cw = wl['conv_w']
    xbc = sum(cw[i] * xbc_in[:, i:i + t] for i in range(SSM_CONV)) + wl['conv_b']
    xbc = jax.nn.silu(xbc)
    xs, bm, cm = jnp.split(xbc, [MIX_WIDTH, MIX_WIDTH + SSM_GROUPS * SSM_STATE], axis=-1)
    dt = jax.nn.softplus(ssm_dt.astype(f32) + wl['dt_bias'])
    a_neg = -jnp.exp(wl['a_log'].astype(f32))
    xh = xs.reshape(b, t, SSM_HEADS, SSM_HEAD_DIM)
    rep = SSM_HEADS // SSM_GROUPS
    bh = jnp.repeat(bm.reshape(b, t, SSM_GROUPS, SSM_STATE), rep, axis=2)
    ch = jnp.repeat(cm.reshape(b, t, SSM_GROUPS, SSM_STATE), rep, axis=2)
    v_ssm = (xh.astype(f32) * dt[..., None]).astype(dtype)
    o, s_ssm_new = run_recurrence(ch, bh, v_ssm, (dt * a_neg)[..., None], s_ssm, SSM_CHUNK, prompt)
    y = o + wl['d_skip'][:, None] * xh
    y = (y.reshape(b, t, MIX_WIDTH) * jax.nn.silu(ssm_z)).reshape(b, t, SSM_GROUPS, MIX_WIDTH // SSM_GROUPS)
    y_ssm = rms_norm(y).reshape(b, t, MIX_WIDTH) * wl['w_ssm_norm']

    q = rotary(ret_q.reshape(b, t, RET_HEADS, RET_DK), pos)
    k = rotary(ret_k.reshape(b, t, RET_HEADS, RET_DK), pos) * (RET_DK ** -0.5)
    v = ret_v.reshape(b, t, RET_HEADS, RET_DV)
    log_gamma = jnp.log1p(-jnp.exp2(-5.0 - jnp.arange(RET_HEADS, dtype=f32)))
    g = jnp.broadcast_to(log_gamma[:, None], (b, t, RET_HEADS, 1))
    o, s_ret_new = run_recurrence(q, k, v, g, s_ret, RET_CHUNK, prompt)
    y_ret = jax.nn.silu(ret_g) * rms_norm(o).reshape(b, t, MIX_WIDTH)

    gates = jax.nn.sigmoid(gate_logits.reshape(b, t, N_BRANCH, D_MODEL))
    merged = (gates[..., 0, :] * jnp.einsum('btm,md->btd', y_gla, wl['w_gla_out'])
              + gates[..., 1, :] * jnp.einsum('btm,md->btd', y_ssm, wl['w_ssm_out'])
              + gates[..., 2, :] * jnp.einsum('btm,md->btd', y_ret, wl['w_ret_out']))
    out = jnp.einsum('btd,de->bte', merged, wl['w_o'])
    return out, (s_gla_new, s_ssm_new, conv_new, s_ret_new)


def run_trunk(x, pos, states, ln_in_w, ln_in_b, layer_w, prompt):
    x = layer_norm(x, ln_in_w, ln_in_b)
    collected = ([], [], [], [])
    for l in range(DEPTH):
        wl = {name: arr[l] for name, arr in layer_w.items()}
        st = None if prompt else tuple(s[l] for s in states)
        mix, new_st = token_mixers(x, pos, st, wl, prompt)
        h = layer_norm(ALPHA * x + mix, wl['ln1_w'], wl['ln1_b'])
        hid = jnp.square(jax.nn.relu(jnp.einsum('btd,df->btf', h, wl['w_ff1']) + wl['b_ff1']))
        ff = jnp.einsum('btf,fd->btd', hid, wl['w_ff2']) + wl['b_ff2']
        x = layer_norm(ALPHA * h + ff, wl['ln2_w'], wl['ln2_b'])
        for store, s in zip(collected, new_st):
            store.append(s)
    return x, tuple(jnp.stack(store) for store in collected)


def setup_inputs(seed: int = 0) -> dict:
    key = jax.random.key(seed)
    ks = jax.random.split(key, 32)
    nrm = jax.random.normal
    f32 = jnp.float32
    dt0 = jnp.exp(jax.random.uniform(ks[15], (DEPTH, SSM_HEADS), minval=math.log(1e-3), maxval=math.log(1e-1)))
    return {
        'x_prompt': nrm(ks[0], (BATCH, SEQ, D_MODEL), f32),
        'x_sample': nrm(ks[1], (DEC_BATCH, DEC_SEQ, D_MODEL), f32),
        'state_gla': nrm(ks[2], (DEPTH, DEC_BATCH, GLA_HEADS, GLA_DK, GLA_DV), f32),
        'state_ssm': 0.1 * nrm(ks[3], (DEPTH, DEC_BATCH, SSM_HEADS, SSM_STATE, SSM_HEAD_DIM), f32),
        'state_conv': nrm(ks[4], (DEPTH, DEC_BATCH, SSM_CONV - 1, SSM_CONV_DIM), f32),
        'state_ret': nrm(ks[5], (DEPTH, DEC_BATCH, RET_HEADS, RET_DK, RET_DV), f32),
        'meta_tokens': nrm(ks[6], (N_META, D_MODEL), f32),
        'ln_in_w': 1.0 + 0.02 * nrm(ks[7], (D_MODEL,), f32),
        'ln_in_b': 0.02 * nrm(ks[8], (D_MODEL,), f32),
        'w_in': nrm(ks[9], (DEPTH, D_MODEL, D_IN_PROJ), f32) * D_MODEL ** -0.5,
        'w_gla_a2': nrm(ks[10], (DEPTH, GLA_GATE_RANK, GLA_HEADS * GLA_DK), f32) * GLA_GATE_RANK ** -0.5,
        'b_gla_a': 0.02 * nrm(ks[11], (DEPTH, GLA_HEADS * GLA_DK), f32),
        'w_gla_norm': 1.0 + 0.02 * nrm(ks[12], (DEPTH, GLA_DV), f32),
        'conv_w': nrm(ks[13], (DEPTH, SSM_CONV, SSM_CONV_DIM), f32) * SSM_CONV ** -0.5,
        'conv_b': 0.02 * nrm(ks[14], (DEPTH, SSM_CONV_DIM), f32),
        'dt_bias': dt0 + jnp.log(-jnp.expm1(-dt0)),
        'a_log': jnp.log(jax.random.uniform(ks[16], (DEPTH, SSM_HEADS), minval=1.0, maxval=16.0)),
        'd_skip': 1.0 + 0.02 * nrm(ks[17], (DEPTH, SSM_HEADS), f32),
        'w_ssm_norm': 1.0 + 0.02 * nrm(ks[18], (DEPTH, MIX_WIDTH), f32),
        'w_gla_out': nrm(ks[19], (DEPTH, MIX_WIDTH, D_MODEL), f32) * (BETA * MIX_WIDTH ** -0.5),
        'w_ssm_out': nrm(ks[20], (DEPTH, MIX_WIDTH, D_MODEL), f32) * (BETA * MIX_WIDTH ** -0.5),
        'w_ret_out': nrm(ks[21], (DEPTH, MIX_WIDTH, D_MODEL), f32) * (BETA * MIX_WIDTH ** -0.5),
        'w_o': nrm(ks[22], (DEPTH, D_MODEL, D_MODEL), f32) * (BETA * D_MODEL ** -0.5),
        'ln1_w': 1.0 + 0.02 * nrm(ks[23], (DEPTH, D_MODEL), f32),
        'ln1_b': 0.02 * nrm(ks[24], (DEPTH, D_MODEL), f32),
        'w_ff1': nrm(ks[25], (DEPTH, D_MODEL, D_FF), f32) * (BETA * D_MODEL ** -0.5),
        'b_ff1': 0.02 * nrm(ks[26], (DEPTH, D_FF), f32),
        'w_ff2': nrm(ks[27], (DEPTH, D_FF, D_MODEL), f32) * (BETA * D_FF ** -0.5),
        'b_ff2': 0.02 * nrm(ks[28], (DEPTH, D_MODEL), f32),
        'ln2_w': 1.0 + 0.02 * nrm(ks[29], (DEPTH, D_MODEL), f32),
        'ln2_b': 0.02 * nrm(ks[30], (DEPTH, D_MODEL), f32),
    }


def reference(x_prompt, x_sample, state_gla, state_ssm, state_conv, state_ret, meta_tokens,
              ln_in_w, ln_in_b, w_in, w_gla_a2, b_gla_a, w_gla_norm, conv_w, conv_b, dt_bias,
              a_log, d_skip, w_ssm_norm, w_gla_out, w_ssm_out, w_ret_out, w_o, ln1_w, ln1_b,
              w_ff1, b_ff1, w_ff2, b_ff2, ln2_w, ln2_b):
    layer_w = {
        'w_in': w_in, 'w_gla_a2': w_gla_a2, 'b_gla_a': b_gla_a, 'w_gla_norm': w_gla_norm,
        'conv_w': conv_w, 'conv_b': conv_b, 'dt_bias': dt_bias, 'a_log': a_log, 'd_skip': d_skip,
        'w_ssm_norm': w_ssm_norm, 'w_gla_out': w_gla_out, 'w_ssm_out': w_ssm_out,
        'w_ret_out': w_ret_out, 'w_o': w_o, 'ln1_w': ln1_w, 'ln1_b': ln1_b,
        'w_ff1': w_ff1, 'b_ff1': b_ff1, 'w_ff2': w_ff2, 'b_ff2': b_ff2,
        'ln2_w': ln2_w, 'ln2_b': ln2_b,
    }
    bp = x_prompt.shape[0]
    meta = jnp.broadcast_to(meta_tokens[None].astype(x_prompt.dtype), (bp, N_META, D_MODEL))
    xp = jnp.concatenate([meta, x_prompt], axis=1)
    pos_p = jnp.arange(xp.shape[1], dtype=jnp.int32)
    yp, (state_gla_prompt, state_ssm_prompt, state_conv_prompt, state_ret_prompt) = run_trunk(
        xp, pos_p, None, ln_in_w, ln_in_b, layer_w, True)
    y_prompt = yp[:, N_META:]
    pos_s = PAST_LEN + jnp.arange(x_sample.shape[1], dtype=jnp.int32)
    y_sample, (state_gla_sample, state_ssm_sample, state_conv_sample, state_ret_sample) = run_trunk(
        x_sample, pos_s, (state_gla, state_ssm, state_conv, state_ret), ln_in_w, ln_in_b, layer_w, False)
    return (y_prompt, y_sample, state_gla_prompt, state_gla_sample, state_ssm_prompt, state_ssm_sample,
            state_conv_prompt, state_conv_sample, state_ret_prompt, state_ret_sample)
```

```cpp
#include <hip/hip_runtime.h>
#include <hip/hip_cooperative_groups.h>
#include <stdint.h>
#include <stdio.h>
namespace cg = cooperative_groups;

#ifndef ONE_LAUNCH
#define ONE_LAUNCH 1
#endif
#ifndef PHASE_ONLY
#define PHASE_ONLY -1
#endif
#define PH_ON(n) (PHASE_ONLY < 0 || PHASE_ONLY == (n))
#ifndef DUP_MASK
#define DUP_MASK 0
#endif
#define DUP(n) ((DUP_MASK >> (n)) & 1)

#define LAS __attribute__((address_space(3)))
typedef unsigned short u16;
typedef __attribute__((ext_vector_type(8))) short bf16x8;
typedef __attribute__((ext_vector_type(4))) float f32x4;

constexpr int D = 1024;
constexpr int TP = 2064;
constexpr int MP = 8 * TP;
constexpr int MS = 512;
constexpr int M = MP + MS;
constexpr int NPJ = 4376;
constexpr int LDT = 72;
constexpr float ALPHA = 1.4142135623730951f;
constexpr int NPHASE = 17;
constexpr int SPLIT_ROW0 = 128 * 128;

constexpr int LDA = 1088;
constexpr int LDY = 576;
constexpr int LDH = 4160;
constexpr size_t WS_WIN = 0;
constexpr size_t WS_WGATE = 9748480;
constexpr size_t WS_WOUT = 16433152;
constexpr size_t WS_WO = 19972096;
constexpr size_t WS_WFF1 = 22200320;
constexpr size_t WS_WFF2 = 31113216;
constexpr size_t WS_ACT = 39632896;
constexpr size_t WS_SSQ = 76677120;
constexpr size_t WS_A = 77221888;
constexpr size_t WS_B = 226215936;
constexpr size_t WS_BAR = 295946240;
constexpr size_t WS_W2 = WS_BAR + 16384;
constexpr size_t WS_G1X = WS_W2 + 22200320;
constexpr size_t WS_END = WS_G1X + 524288;
constexpr int G1_SPLIT = 16768;
constexpr size_t A_PRE = 37044224;

constexpr size_t O_YP = 0, O_YS = 16777216, O_SGP = 17301504, O_SGS = 17825792, O_SSP = 26214400, O_SSS = 26738688,
                 O_SCP = 35127296, O_SCS = 35164160, O_SRP = 35753984, O_SRS = 36278272;

constexpr int LDS_BYTES = 76032;

struct Params { const float* in[31]; float* out; unsigned char* ws; };

__device__ __forceinline__ unsigned f2bf(float f) {
  unsigned u = __float_as_uint(f);
  u += 0x7fffu + ((u >> 16) & 1u);
  return u >> 16;
}
__device__ __forceinline__ float bf2f(u16 h) { return __uint_as_float(((unsigned)h) << 16); }
__device__ __forceinline__ unsigned pack2(float a, float b) { return f2bf(a) | (f2bf(b) << 16); }
__device__ __forceinline__ void unpack8(uint4 v, float (&f)[8]) {
  f[0] = __uint_as_float(v.x << 16); f[1] = __uint_as_float(v.x & 0xffff0000u);
  f[2] = __uint_as_float(v.y << 16); f[3] = __uint_as_float(v.y & 0xffff0000u);
  f[4] = __uint_as_float(v.z << 16); f[5] = __uint_as_float(v.z & 0xffff0000u);
  f[6] = __uint_as_float(v.w << 16); f[7] = __uint_as_float(v.w & 0xffff0000u);
}
__device__ __forceinline__ uint4 pack8(const float (&f)[8]) {
  return make_uint4(pack2(f[0], f[1]), pack2(f[2], f[3]), pack2(f[4], f[5]), pack2(f[6], f[7]));
}
__device__ __forceinline__ int tsw(int row, int col) { return row * LDT + (col ^ (((row >> 3) & 7) << 3)); }
__device__ __forceinline__ int otid() { int t = threadIdx.x; asm volatile("" : "+v"(t)); return t; }
__device__ __forceinline__ float silu_f(float x) { return x / (1.f + __expf(-x)); }
__device__ __forceinline__ float sigmoid_f(float x) { return 1.f / (1.f + __expf(-x)); }
__device__ __forceinline__ float softplus_f(float x) { return fmaxf(x, 0.f) + log1pf(__expf(-fabsf(x))); }

__device__ __forceinline__ void conv_tile64(const float* __restrict__ src, int ld, int ldk, int ncol0, int nvalid, u16* __restrict__ dst,
                            int kt, int nt, const float* __restrict__ kscale, float* tile, int blocked_nkt = 0) {
  const int tid = otid();
  const int c = tid & 63, r4 = tid >> 6;
  const int n = nt * 64 + c;
  const bool ok = n < nvalid;
#pragma unroll
  for (int i = 0; i < 16; ++i) {
    int k = r4 + 4 * i;
    int kg = kt * 64 + k;
    float v = ok ? src[(size_t)kg * ld + ncol0 + n] : 0.f;
    if (kscale) v *= kscale[kg];
    tile[k * 65 + c] = v;
  }
  __syncthreads();
#pragma unroll
  for (int it = 0; it < 2; ++it) {
    int id = tid + 256 * it;
    int nn = id >> 3, kc = id & 7;
    unsigned w0 = pack2(tile[(kc * 8 + 0) * 65 + nn], tile[(kc * 8 + 1) * 65 + nn]);
    unsigned w1 = pack2(tile[(kc * 8 + 2) * 65 + nn], tile[(kc * 8 + 3) * 65 + nn]);
    unsigned w2 = pack2(tile[(kc * 8 + 4) * 65 + nn], tile[(kc * 8 + 5) * 65 + nn]);
    unsigned w3 = pack2(tile[(kc * 8 + 6) * 65 + nn], tile[(kc * 8 + 7) * 65 + nn]);
    const int n_ = nt * 64 + nn;
    const size_t di = blocked_nkt ? ((size_t)((n_ >> 7) * blocked_nkt + kt) * 8192 + (n_ & 127) * 64 + kc * 8)
                                  : ((size_t)n_ * ldk + kt * 64 + kc * 8);
    *(uint4*)(dst + di) = make_uint4(w0, w1, w2, w3);
  }
  __syncthreads();
}

__device__ __forceinline__ void convert_layer(const Params& P, int l, unsigned char* lds, int t_lo, int t_hi, int wb, int nwb) {
  float* tile = (float*)lds;
  unsigned char* ws = P.ws;
  const size_t wsel = (l == 0) ? 0 : WS_W2;
  for (int t = t_lo + wb; t < t_hi; t += nwb) {
    int idx = t;
    if (idx < 1120) {
      conv_tile64(P.in[9] + (size_t)l * 1024 * 7448, 7448, LDA, 0, NPJ, (u16*)(ws + wsel + WS_WIN), idx % 16, idx / 16, nullptr, tile);
      continue;
    }
    idx -= 1120;
    if (idx < 768) {
      conv_tile64(P.in[9] + (size_t)l * 1024 * 7448, 7448, LDA, NPJ, 3072, (u16*)(ws + wsel + WS_WGATE), idx % 16, idx / 16, nullptr, tile);
      continue;
    }
    idx -= 768;
    if (idx < 384) {
      int br = idx / 128, r = idx % 128;
      conv_tile64(P.in[19 + br] + (size_t)l * 512 * 1024, 1024, LDY, 0, 1024, (u16*)(ws + wsel + WS_WOUT) + (size_t)br * 1024 * LDY,
                  r % 8, r / 8, br == 1 ? P.in[18] + l * 512 : nullptr, tile);
      continue;
    }
    idx -= 384;
    if (idx < 256) {
      conv_tile64(P.in[22] + (size_t)l * 1024 * 1024, 1024, LDA, 0, 1024, (u16*)(ws + wsel + WS_WO), idx % 16, idx / 16, nullptr, tile);
      continue;
    }
    idx -= 256;
    if (idx < 1024) {
      conv_tile64(P.in[25] + (size_t)l * 1024 * 4096, 4096, LDA, 0, 4096, (u16*)(ws + WS_WFF1), idx % 16, idx / 16, nullptr, tile);
      continue;
    }
    idx -= 1024;
    conv_tile64(P.in[27] + (size_t)l * 4096 * 1024, 1024, LDH, 0, 1024, (u16*)(ws + WS_WFF2), idx % 64, idx / 64, nullptr, tile, 64);
  }
}

__device__ __forceinline__ void ln_phase(const Params& P, int mode, int l) {
  const int tid_ = otid();
  const int lane = tid_ & 63;
  const int gw = blockIdx.x * 4 + (tid_ >> 6);
  const int nw = gridDim.x * 4;
  const float* wv = mode == 0 ? P.in[7] : (mode == 1 ? P.in[23] + l * D : P.in[29] + l * D);
  const float* bv = mode == 0 ? P.in[8] : (mode == 1 ? P.in[24] + l * D : P.in[30] + l * D);
  u16* act = (u16*)(P.ws + WS_ACT);
  const bool final_out = (mode == 2 && l == 1);
  for (int row = gw; row < M; row += nw) {
    const float* s;
    int b = 0, t = 0;
    if (row < MP) { b = row / TP; t = row - b * TP; }
    if (mode == 0) {
      if (row < MP) s = (t < 16) ? P.in[6] + (size_t)t * D : P.in[0] + ((size_t)b * 2048 + (t - 16)) * D;
      else s = P.in[1] + (size_t)(row - MP) * D;
    } else if (mode == 1) {
      s = (const float*)(P.ws + WS_A + A_PRE) + (size_t)row * D;
    } else {
      s = (const float*)(P.ws + WS_B) + (size_t)row * D;
    }
    float4 v[4];
#pragma unroll
    for (int i = 0; i < 4; ++i) v[i] = *(const float4*)(s + i * 256 + lane * 4);
    float sum = 0.f;
#pragma unroll
    for (int i = 0; i < 4; ++i) sum += v[i].x + v[i].y + v[i].z + v[i].w;
#pragma unroll
    for (int o = 32; o >= 1; o >>= 1) sum += __shfl_xor(sum, o);
    const float mean = sum * (1.f / 1024.f);
    float sq = 0.f;
#pragma unroll
    for (int i = 0; i < 4; ++i) {
      v[i].x -= mean; v[i].y -= mean; v[i].z -= mean; v[i].w -= mean;
      sq += v[i].x * v[i].x + v[i].y * v[i].y + v[i].z * v[i].z + v[i].w * v[i].w;
    }
#pragma unroll
    for (int o = 32; o >= 1; o >>= 1) sq += __shfl_xor(sq, o);
    const float rstd = rsqrtf(sq * (1.f / 1024.f) + 1e-5f);
    float* od = nullptr;
    if (final_out) {
      if (row < MP) { if (t >= 16) od = P.out + O_YP + ((size_t)b * 2048 + (t - 16)) * D; }
      else od = P.out + O_YS + (size_t)(row - MP) * D;
    }
#pragma unroll
    for (int i = 0; i < 4; ++i) {
      const int c = i * 256 + lane * 4;
      float4 w4 = *(const float4*)(wv + c), b4 = *(const float4*)(bv + c);
      float y0 = v[i].x * rstd * w4.x + b4.x, y1 = v[i].y * rstd * w4.y + b4.y;
      float y2 = v[i].z * rstd * w4.z + b4.z, y3 = v[i].w * rstd * w4.w + b4.w;
      if (final_out) {
        if (od) *(float4*)(od + c) = make_float4(y0, y1, y2, y3);
      } else {
        const unsigned p0 = pack2(y0, y1), p1 = pack2(y2, y3);
        *(uint2*)(act + (size_t)row * LDA + c) = make_uint2(p0, p1);
        if (mode == 1 && row >= SPLIT_ROW0) {
          const float4 bb = *(const float4*)(P.in[28] + l * D + c);
          float* pz = (float*)(P.ws + WS_B) + (size_t)row * D + c;
          *(float4*)pz = make_float4(ALPHA * __uint_as_float(p0 << 16) + bb.x, ALPHA * __uint_as_float(p0 & 0xffff0000u) + bb.y,
                                     ALPHA * __uint_as_float(p1 << 16) + bb.z, ALPHA * __uint_as_float(p1 & 0xffff0000u) + bb.w);
        }
      }
    }
  }
}

#define G_LOAD4(R, k0)                                                                    \
  R##a0 = *(const uint4*)(ap + (k0)); R##a1 = *(const uint4*)(ap + sa + (k0));            \
  R##a2 = *(const uint4*)(ap + 2 * sa + (k0)); R##a3 = *(const uint4*)(ap + 3 * sa + (k0)); \
  R##b0 = *(const uint4*)(bp + (k0)); R##b1 = *(const uint4*)(bp + sb + (k0));
#define G_LOADB(R, k0)                                                                    \
  R##b2 = *(const uint4*)(bp + 2 * sb + (k0)); R##b3 = *(const uint4*)(bp + 3 * sb + (k0));
#define L_STORE4(R, buf)                                                                  \
  { u16* ad = As + (buf) * 128 * LDT + crow * LDT + cck;                                  \
    u16* bd = Bs + (buf) * BN * LDT + crow * LDT + cck;                                   \
    *(uint4*)(ad) = R##a0; *(uint4*)(ad + 32 * LDT) = R##a1; *(uint4*)(ad + 64 * LDT) = R##a2; *(uint4*)(ad + 96 * LDT) = R##a3; \
    *(uint4*)(bd) = R##b0; *(uint4*)(bd + 32 * LDT) = R##b1;                              \
    if (NF == 4) { *(uint4*)(bd + 64 * LDT) = R##b2; *(uint4*)(bd + 96 * LDT) = R##b3; } }
#define MMA_TILE(buf)                                                                     \
  { const u16* as = As + (buf) * 128 * LDT + (wm * 64 + r) * LDT + q * 8;                 \
    const u16* bs = Bs + (buf) * BN * LDT + (wn * NF * 16 + r) * LDT + q * 8;             \
    _Pragma("unroll") for (int kk = 0; kk < 2; ++kk) {                                    \
      bf16x8 af[4], bfr[NF];                                                              \
      _Pragma("unroll") for (int mf = 0; mf < 4; ++mf) af[mf] = *(const bf16x8*)(as + mf * 16 * LDT + kk * 32); \
      _Pragma("unroll") for (int nf = 0; nf < NF; ++nf) bfr[nf] = *(const bf16x8*)(bs + nf * 16 * LDT + kk * 32); \
      _Pragma("unroll") for (int mf = 0; mf < 4; ++mf)                                    \
        _Pragma("unroll") for (int nf = 0; nf < NF; ++nf)                                 \
          acc[mf][nf] = __builtin_amdgcn_mfma_f32_16x16x32_bf16(af[mf], bfr[nf], acc[mf][nf], 0, 0, 0); \
    } }

__device__ __forceinline__ int lds_byte(int r, int c) {
  int st = (r >> 4) * 2 + (c >> 5), rr = r & 15, cc = c & 31, ob = rr * 64 + cc * 2;
  return st * 1024 + (ob ^ (((ob >> 9) & 1) << 5));
}
__device__ __forceinline__ void stage_rc(int b, int& R, int& C) {
  int st = b >> 10, sb = b & 1023, swz = sb ^ (((sb >> 9) & 1) << 5);
  R = (st >> 1) * 16 + (swz >> 6);
  C = (st & 1) * 32 + ((swz & 63) >> 1);
}

template <int NF>
__device__ __forceinline__ void gemm_core(f32x4 (&acc)[4][NF], const u16* __restrict__ A, int lda,
                                          const u16* __restrict__ B, int ldb, int K, u16* lds, int kadv = 64) {
  constexpr int BN = 32 * NF;
  constexpr int ABYTES = 128 * 64 * 2;
  constexpr int BBYTES = BN * 64 * 2;
  constexpr int BUF = ABYTES + BBYTES;
  unsigned char* base = (unsigned char*)lds;
  const int tid = otid(), lane = tid & 63, w = tid >> 6, wm = w >> 1, wn = w & 1, r = lane & 15, q = lane >> 4;
  const u16* ga[4]; const u16* gb[NF];
#pragma unroll
  for (int i = 0; i < 4; ++i) { int R, C; stage_rc(tid * 16 + i * 4096, R, C); ga[i] = A + (size_t)R * lda + C; }
#pragma unroll
  for (int i = 0; i < NF; ++i) { int R, C; stage_rc(tid * 16 + i * 4096, R, C); gb[i] = B + (size_t)R * ldb + C; }
  int oa[4][2], ob[NF][2];
#pragma unroll
  for (int mf = 0; mf < 4; ++mf)
#pragma unroll
    for (int kk = 0; kk < 2; ++kk) oa[mf][kk] = lds_byte(wm * 64 + mf * 16 + r, kk * 32 + q * 8);
#pragma unroll
  for (int nf = 0; nf < NF; ++nf)
#pragma unroll
    for (int kk = 0; kk < 2; ++kk) ob[nf][kk] = lds_byte(wn * NF * 16 + nf * 16 + r, kk * 32 + q * 8);
#define STAGE_TILE(buf, k0)                                                                              \
  {                                                                                                      \
    _Pragma("unroll") for (int i = 0; i < 4; ++i)                                                        \
      __builtin_amdgcn_global_load_lds((const unsigned*)(ga[i] + (k0)),                                  \
        (LAS unsigned*)(base + (buf) * BUF + tid * 16 + i * 4096), 16, 0, 0);                            \
    _Pragma("unroll") for (int i = 0; i < NF; ++i)                                                       \
      __builtin_amdgcn_global_load_lds((const unsigned*)(gb[i] + (k0)),                                  \
        (LAS unsigned*)(base + (buf) * BUF + ABYTES + tid * 16 + i * 4096), 16, 0, 0);                   \
  }
  const int nk = K >> 6;
  STAGE_TILE(0, 0)
  asm volatile("s_waitcnt vmcnt(0)" ::: "memory");
  __syncthreads();
  for (int kt = 0; kt < nk; ++kt) {
    const int buf = kt & 1;
    if (kt + 1 < nk) STAGE_TILE(buf ^ 1, (size_t)(kt + 1) * kadv)
    const unsigned char* as = base + buf * BUF;
    const unsigned char* bs = as + ABYTES;
    bf16x8 af0[4], bf0[NF], af1[4], bf1[NF];
#pragma unroll
    for (int mf = 0; mf < 4; ++mf) af0[mf] = *(const bf16x8*)(as + oa[mf][0]);
#pragma unroll
    for (int nf = 0; nf < NF; ++nf) bf0[nf] = *(const bf16x8*)(bs + ob[nf][0]);
    __builtin_amdgcn_s_setprio(3);
#pragma unroll
    for (int nf = 0; nf < NF / 2; ++nf)
#pragma unroll
      for (int mf = 0; mf < 4; ++mf)
        acc[mf][nf] = __builtin_amdgcn_mfma_f32_16x16x32_bf16(af0[mf], bf0[nf], acc[mf][nf], 0, 0, 0);
    __builtin_amdgcn_s_setprio(0);
#pragma unroll
    for (int mf = 0; mf < 4; ++mf) af1[mf] = *(const bf16x8*)(as + oa[mf][1]);
#pragma unroll
    for (int nf = 0; nf < NF; ++nf) bf1[nf] = *(const bf16x8*)(bs + ob[nf][1]);
    __builtin_amdgcn_s_setprio(3);
#pragma unroll
    for (int nf = NF / 2; nf < NF; ++nf)
#pragma unroll
      for (int mf = 0; mf < 4; ++mf)
        acc[mf][nf] = __builtin_amdgcn_mfma_f32_16x16x32_bf16(af0[mf], bf0[nf], acc[mf][nf], 0, 0, 0);
#pragma unroll
    for (int nf = 0; nf < NF; ++nf)
#pragma unroll
      for (int mf = 0; mf < 4; ++mf)
        acc[mf][nf] = __builtin_amdgcn_mfma_f32_16x16x32_bf16(af1[mf], bf1[nf], acc[mf][nf], 0, 0, 0);
    __builtin_amdgcn_s_setprio(0);
    asm volatile("s_waitcnt vmcnt(0)" ::: "memory");
    __syncthreads();
  }
#undef STAGE_TILE
}

#define TILE_LOOP(total)                                                                      \
  const int _nx = (gridDim.x % 8 == 0) ? 8 : 1;                                              \
  const int _ns = gridDim.x / _nx;                                                           \
  const int _x = blockIdx.x % _nx, _s = blockIdx.x / _nx;                                    \
  const int _per = ((total) + _nx - 1) / _nx;                                                \
  const int _lo = _x * _per;                                                                 \
  const int _hi = min((total), _lo + _per);                                                  \
  for (int t = _lo + _s; t < _hi; t += _ns)

__device__ __forceinline__ void tile_decode(int t, int MT, int NT, int& mt, int& nt) {
  int g = t / (8 * NT), r = t - g * 8 * NT;
  int gs = min(8, MT - g * 8);
  mt = g * 8 + r % gs;
  nt = r / gs;
}

template <int NF>
__device__ __forceinline__ void zero_acc(f32x4 (&acc)[4][NF]) {
#pragma unroll
  for (int i = 0; i < 4; ++i)
#pragma unroll
    for (int j = 0; j < NF; ++j) acc[i][j] = (f32x4){0.f, 0.f, 0.f, 0.f};
}

__device__ __forceinline__ void phase_proj(const Params& P, int l, unsigned char* ldsb) {
  const u16* act = (const u16*)(P.ws + WS_ACT);
  const u16* W = (const u16*)(P.ws + (l == 0 ? 0 : WS_W2) + WS_WIN);
  u16* proj = (u16*)(P.ws + WS_A);
  constexpr int MT = 133, NT = 35;
  TILE_LOOP(MT * NT) {
    int mt, nt; tile_decode(t, MT, NT, mt, nt);
    const int tid_ = otid(), lane = tid_ & 63, w = tid_ >> 6, wm = w >> 1, wn = w & 1, r = lane & 15, q = lane >> 4;
    f32x4 acc[4][4]; zero_acc<4>(acc);
    gemm_core<4>(acc, act + (size_t)mt * 128 * LDA, LDA, W + (size_t)nt * 128 * LDA, LDA, D, (u16*)ldsb);
#pragma unroll
    for (int mf = 0; mf < 4; ++mf)
#pragma unroll
      for (int nf = 0; nf < 4; ++nf) {
        const int col = nt * 128 + wn * 64 + nf * 16 + r;
        if (col < NPJ) {
#pragma unroll
          for (int e = 0; e < 4; ++e) {
            const int row = mt * 128 + wm * 64 + mf * 16 + q * 4 + e;
            proj[(size_t)row * NPJ + col] = (u16)f2bf(acc[mf][nf][e]);
          }
        }
      }
  }
}

__device__ __forceinline__ u16* gate_row(const Params& P, int br, int row) {
  if (br == 0) return (u16*)P.out + (size_t)row * D;
  if (row < G1_SPLIT) return (u16*)P.out + (size_t)M * D + (size_t)row * D;
  return (u16*)(P.ws + WS_G1X) + (size_t)(row - G1_SPLIT) * D;
}

__device__ __forceinline__ void phase_gates(const Params& P, int l, int wb, int nwb, unsigned char* ldsb) {
  const u16* act = (const u16*)(P.ws + WS_ACT);
  const u16* Wg = (const u16*)(P.ws + (l == 0 ? 0 : WS_W2) + WS_WGATE);
  constexpr int MT = 133, NT = 8;
  for (int t = wb; t < 2 * MT * NT; t += nwb) {
    const int br = t / (MT * NT);
    int mt, nt; tile_decode(t - br * MT * NT, MT, NT, mt, nt);
    const int tid_ = otid(), lane = tid_ & 63, w = tid_ >> 6, wm = w >> 1, wn = w & 1, r = lane & 15, q = lane >> 4;
    f32x4 acc[4][4]; zero_acc<4>(acc);
    gemm_core<4>(acc, act + (size_t)mt * 128 * LDA, LDA, Wg + ((size_t)br * 1024 + nt * 128) * LDA, LDA, D, (u16*)ldsb);
#pragma unroll
    for (int mf = 0; mf < 4; ++mf)
#pragma unroll
      for (int e = 0; e < 4; ++e) {
        const int row = mt * 128 + wm * 64 + mf * 16 + q * 4 + e;
        u16* gr = gate_row(P, br, row);
#pragma unroll
        for (int nf = 0; nf < 4; ++nf) gr[nt * 128 + wn * 64 + nf * 16 + r] = (u16)f2bf(sigmoid_f(acc[mf][nf][e]));
      }
  }
}

__device__ __forceinline__ void phase_merge(const Params& P, int l, unsigned char* ldsb) {
  const u16* act = (const u16*)(P.ws + WS_ACT);
  const u16* Wg = (const u16*)(P.ws + (l == 0 ? 0 : WS_W2) + WS_WGATE);
  const u16* Wo = (const u16*)(P.ws + (l == 0 ? 0 : WS_W2) + WS_WOUT);
  const u16* ybr = (const u16*)(P.ws + WS_B);
  const float* ssq = (const float*)(P.ws + WS_SSQ);
  u16* merged = (u16*)(P.ws + WS_A);
  constexpr int MT = 133, NT = 16;
  {
    float* pre = (float*)(P.ws + WS_A + A_PRE);
    for (int i = blockIdx.x * 256 + otid(); i < (M - SPLIT_ROW0) * (D / 4); i += gridDim.x * 256) {
      const int row = SPLIT_ROW0 + i / (D / 4), c = (i % (D / 4)) * 4;
      const uint2 xv = *(const uint2*)(act + (size_t)row * LDA + c);
      *(float4*)(pre + (size_t)row * D + c) = make_float4(ALPHA * __uint_as_float(xv.x << 16), ALPHA * __uint_as_float(xv.x & 0xffff0000u),
                                                          ALPHA * __uint_as_float(xv.y << 16), ALPHA * __uint_as_float(xv.y & 0xffff0000u));
    }
  }
  TILE_LOOP(MT * NT) {
    int mt, nt; tile_decode(t, MT, NT, mt, nt);
    const int tid_ = otid(), lane = tid_ & 63, w = tid_ >> 6, wm = w >> 1, wn = w & 1, r = lane & 15, q = lane >> 4;
    f32x4 fin[4][2]; zero_acc<2>(fin);
#pragma unroll 1
    for (int br = 0; br < 3; ++br) {
      f32x4 g[4][2]; zero_acc<2>(g);
      if (br == 2) {
        gemm_core<2>(g, act + (size_t)mt * 128 * LDA, LDA, Wg + ((size_t)br * 1024 + nt * 64) * LDA, LDA, D, (u16*)ldsb);
#pragma unroll
        for (int mf = 0; mf < 4; ++mf)
#pragma unroll
          for (int nf = 0; nf < 2; ++nf)
#pragma unroll
            for (int e = 0; e < 4; ++e) g[mf][nf][e] = sigmoid_f(g[mf][nf][e]);
      } else {
#pragma unroll
        for (int mf = 0; mf < 4; ++mf)
#pragma unroll
          for (int e = 0; e < 4; ++e) {
            const u16* gr = gate_row(P, br, mt * 128 + wm * 64 + mf * 16 + q * 4 + e) + nt * 64 + wn * 32 + r;
#pragma unroll
            for (int nf = 0; nf < 2; ++nf) g[mf][nf][e] = bf2f(gr[nf * 16]);
          }
      }
      const u16* yb = ybr + (size_t)br * M * LDY + (size_t)mt * 128 * LDY;
      const u16* wb = Wo + (size_t)br * 1024 * LDY + (size_t)nt * 64 * LDY;
      if (br != 1) {
        f32x4 acc[4][2]; zero_acc<2>(acc);
        gemm_core<2>(acc, yb, LDY, wb, LDY, 512, (u16*)ldsb);
#pragma unroll
        for (int mf = 0; mf < 4; ++mf)
#pragma unroll
          for (int nf = 0; nf < 2; ++nf)
#pragma unroll
            for (int e = 0; e < 4; ++e) fin[mf][nf][e] += g[mf][nf][e] * acc[mf][nf][e];
      } else {
#pragma unroll 1
        for (int grp = 0; grp < 2; ++grp) {
          f32x4 acc[4][2]; zero_acc<2>(acc);
          gemm_core<2>(acc, yb + grp * 256, LDY, wb + grp * 256, LDY, 256, (u16*)ldsb);
#pragma unroll
          for (int mf = 0; mf < 4; ++mf)
#pragma unroll
            for (int e = 0; e < 4; ++e) {
              const int row = mt * 128 + wm * 64 + mf * 16 + q * 4 + e;
              float4 s4 = *(const float4*)(ssq + (size_t)row * 8 + grp * 4);
              float rs = rsqrtf((s4.x + s4.y + s4.z + s4.w) * (1.f / 256.f) + 1e-6f);
#pragma unroll
              for (int nf = 0; nf < 2; ++nf) fin[mf][nf][e] += g[mf][nf][e] * rs * acc[mf][nf][e];
            }
        }
      }
    }
#pragma unroll
    for (int mf = 0; mf < 4; ++mf)
#pragma unroll
      for (int nf = 0; nf < 2; ++nf)
#pragma unroll
        for (int e = 0; e < 4; ++e) {
          const int row = mt * 128 + wm * 64 + mf * 16 + q * 4 + e;
          const int col = nt * 64 + wn * 32 + nf * 16 + r;
          merged[(size_t)row * LDA + col] = (u16)f2bf(fin[mf][nf][e]);
        }
  }
}

__device__ __forceinline__ void phase_resid(const Params& P, int mode, int l, unsigned char* ldsb) {
  const u16* act = (const u16*)(P.ws + WS_ACT);
  const u16* A = (const u16*)(P.ws + WS_A);
  const int K = mode == 0 ? 1024 : 4096;
  const int ldk = mode == 0 ? LDA : LDH;
  const u16* W = (const u16*)(P.ws + (mode == 0 ? (l == 0 ? 0 : WS_W2) + WS_WO : WS_WFF2));
  float* dst = mode == 0 ? (float*)(P.ws + WS_A + A_PRE) : (float*)(P.ws + WS_B);
  const float* bias = P.in[28] + l * D;
  constexpr int MT = 128, NT = 8;
  TILE_LOOP(MT * NT) {
    int mt, nt; tile_decode(t, MT, NT, mt, nt);
    const int tid_ = otid(), lane = tid_ & 63, w = tid_ >> 6, wm = w >> 1, wn = w & 1, r = lane & 15, q = lane >> 4;
    f32x4 acc[4][4]; zero_acc<4>(acc);
    if (mode == 0) gemm_core<4>(acc, A + (size_t)mt * 128 * ldk, ldk, W + (size_t)nt * 128 * ldk, ldk, K, (u16*)ldsb);
    else gemm_core<4>(acc, A + (size_t)mt * 64 * 8192, 64, W + (size_t)nt * 64 * 8192, 64, K, (u16*)ldsb, 8192);
#pragma unroll
    for (int mf = 0; mf < 4; ++mf)
#pragma unroll
      for (int nf = 0; nf < 4; ++nf) {
        const int col = nt * 128 + wn * 64 + nf * 16 + r;
        const float bb = mode == 1 ? bias[col] : 0.f;
#pragma unroll
        for (int e = 0; e < 4; ++e) {
          const int row = mt * 128 + wm * 64 + mf * 16 + q * 4 + e;
          dst[(size_t)row * D + col] = ALPHA * bf2f(act[(size_t)row * LDA + col]) + acc[mf][nf][e] + bb;
        }
      }
  }
  {
    constexpr int S = 8;
    const int KS = K / S;
    for (int li = blockIdx.x; li < 40 * S; li += gridDim.x) {
      const int sl = li % S, tl = li / S;
      const int mt = 128 + tl / 8, nt = tl % 8;
      const int tid_ = otid(), lane = tid_ & 63, w = tid_ >> 6, wm = w >> 1, wn = w & 1, r = lane & 15, q = lane >> 4;
      f32x4 acc[4][4]; zero_acc<4>(acc);
      if (mode == 0) gemm_core<4>(acc, A + (size_t)mt * 128 * ldk + sl * KS, ldk, W + (size_t)nt * 128 * ldk + sl * KS, ldk, KS, (u16*)ldsb);
      else gemm_core<4>(acc, A + ((size_t)mt * 64 + sl * (KS / 64)) * 8192, 64, W + ((size_t)nt * 64 + sl * (KS / 64)) * 8192, 64, KS, (u16*)ldsb, 8192);
#pragma unroll
      for (int mf = 0; mf < 4; ++mf)
#pragma unroll
        for (int nf = 0; nf < 4; ++nf) {
          const int col = nt * 128 + wn * 64 + nf * 16 + r;
#pragma unroll
          for (int e = 0; e < 4; ++e) {
            const int row = mt * 128 + wm * 64 + mf * 16 + q * 4 + e;
            (void)__hip_atomic_fetch_add(dst + (size_t)row * D + col, acc[mf][nf][e], __ATOMIC_RELAXED, __HIP_MEMORY_SCOPE_AGENT);
          }
        }
    }
  }
}

__device__ __forceinline__ void phase_ff1(const Params& P, int l, unsigned char* ldsb) {
  const u16* act = (const u16*)(P.ws + WS_ACT);
  const u16* W = (const u16*)(P.ws + WS_WFF1);
  u16* hid = (u16*)(P.ws + WS_A);
  const float* bias = P.in[26] + l * 4096;
  constexpr int MT = 133, NT = 32;
  TILE_LOOP(MT * NT) {
    int mt, nt; tile_decode(t, MT, NT, mt, nt);
    const int tid_ = otid(), lane = tid_ & 63, w = tid_ >> 6, wm = w >> 1, wn = w & 1, r = lane & 15, q = lane >> 4;
    f32x4 acc[4][4]; zero_acc<4>(acc);
    gemm_core<4>(acc, act + (size_t)mt * 128 * LDA, LDA, W + (size_t)nt * 128 * LDA, LDA, D, (u16*)ldsb);
#pragma unroll
    for (int mf = 0; mf < 4; ++mf)
#pragma unroll
      for (int nf = 0; nf < 4; ++nf) {
        const int col = nt * 128 + wn * 64 + nf * 16 + r;
        const float bb = bias[col];
#pragma unroll
        for (int e = 0; e < 4; ++e) {
          const int row = mt * 128 + wm * 64 + mf * 16 + q * 4 + e;
          float v = fmaxf(acc[mf][nf][e] + bb, 0.f);
          hid[((size_t)(row >> 7) * 64 + (col >> 6)) * 8192 + (row & 127) * 64 + (col & 63)] = (u16)f2bf(v * v);
        }
      }
  }
}

template <int BR>
__device__ __forceinline__ void rec_item(const Params& P, int l, int b, int h, int sample, unsigned char* ldsb) {
  constexpr int DV = (BR == 1) ? 64 : 128;
  constexpr int NFV = DV / 16;
  constexpr int NH = (BR == 1) ? 8 : 4;
  constexpr int OLD = DV + 4;
  constexpr int NEP = DV / 32;
  u16* QA = (u16*)ldsb;
  u16* KB = QA + 64 * LDT;
  u16* KT = KB + 64 * LDT;
  u16* ATT = KT + 64 * LDT;
  u16* VT = ATT + 64 * LDT;
  u16* ST = VT + 128 * LDT;
  float* Gsc = (float*)(ST + 128 * LDT);
  float* dec = Gsc + 64;
  float* dtv = dec + 64;
  float* psum = dtv + 64;
  float* invf = psum + 256;
  float* Gl = (float*)ST;
  float* AL = (float*)ATT;
  float* OST = (float*)ldsb;
  u16* XH = VT + 64 * LDT;

  const int tid = otid(), lane = tid & 63, w = tid >> 6, r = lane & 15, q = lane >> 4;
  const int T = sample ? 4 : TP;
  const int row0 = sample ? MP + b * 4 : b * TP;
  const int pos0 = sample ? 16384 : 0;
  const u16* proj = (const u16*)(P.ws + WS_A);
  u16* ybr = (u16*)(P.ws + WS_B) + (size_t)BR * M * LDY;
  float* ssq = (float*)(P.ws + WS_SSQ);

  float lg = 0.f, aneg = 0.f, dtb = 0.f, dsk = 0.f;
  if (BR == 2) {
    lg = log1pf(-exp2f(-5.f - (float)h));
    if (tid < 32) invf[tid] = exp2f(-(float)tid * (13.287712379549449f / 32.0f));
  }
  if (BR == 1) {
    aneg = -__expf(P.in[16][l * 8 + h]);
    dtb = P.in[15][l * 8 + h];
    dsk = P.in[17][l * 8 + h];
  }
  const int grp = h >> 2;

  f32x4 S[NFV];
  {
    const float* sin_ = P.in[2];
    if (sample) {
      const float* base = BR == 0 ? P.in[2] : (BR == 1 ? P.in[3] : P.in[5]);
      sin_ = base + ((size_t)(l * 128 + b) * NH + h) * 64 * DV;
    }
#pragma unroll
    for (int nf = 0; nf < NFV; ++nf)
#pragma unroll
      for (int e = 0; e < 4; ++e) {
        float v = sin_[(size_t)(16 * w + q * 4 + e) * DV + nf * 16 + r];
        S[nf][e] = sample ? v : 0.f;
      }
  }
  __syncthreads();

  uint4 Rg[NEP], RgN[NEP];
  uint4 Rq[2], Rk[2], Rv[4], Ral;
  uint4 Rq1, Rq2, Rk1, Rk2;
  uint4 Rx[11];
  float dtraw = 0.f;
  const int ci = tid & 63, part = tid >> 6;
  float w2r[16];
  float bias = 0.f;
  if (BR == 0) {
#pragma unroll
    for (int rr = 0; rr < 16; ++rr) w2r[rr] = P.in[10][(size_t)(l * 16 + rr) * 256 + h * 64 + ci];
    bias = P.in[11][l * 256 + h * 64 + ci];
  }
  const int cc = tid >> 3, ts = tid & 7;
  const bool act = tid < 192;
  const int seg = cc >> 3, c8 = (cc & 7) * 8;
  const int chan = seg == 0 ? h * 64 + c8 : (seg == 1 ? 512 + grp * 64 + c8 : 640 + grp * 64 + c8);
  float cwv[4][8], cbv[8];
  if (BR == 1 && act) {
    const float* cw = P.in[13] + (size_t)l * 4 * 768 + chan;
    const float* cb = P.in[14] + (size_t)l * 768 + chan;
#pragma unroll
    for (int i = 0; i < 4; ++i) {
      *(float4*)&cwv[i][0] = *(const float4*)(cw + i * 768);
      *(float4*)&cwv[i][4] = *(const float4*)(cw + i * 768 + 4);
    }
    *(float4*)&cbv[0] = *(const float4*)cb;
    *(float4*)&cbv[4] = *(const float4*)(cb + 4);
  }
#define REC_LOAD(CB, RGD)                                                                                     \
  {                                                                                                           \
    const int goff_ = BR == 0 ? 1024 + h * 128 : (BR == 1 ? 1552 + h * 64 : 3864 + h * 128);                  \
    _Pragma("unroll") for (int it = 0; it < NEP; ++it) {                                                      \
      const int id = tid + 256 * it;                                                                          \
      const int t = (DV == 128) ? (id >> 4) : (id >> 3);                                                      \
      const int j0 = (DV == 128) ? (id & 15) * 8 : (id & 7) * 8;                                              \
      RGD[it] = *(const uint4*)(proj + (size_t)(row0 + min((CB) + t, T - 1)) * NPJ + goff_ + j0);             \
    }                                                                                                         \
    if (BR == 0) {                                                                                            \
      _Pragma("unroll") for (int it = 0; it < 2; ++it) {                                                      \
        const int id = tid + 256 * it;                                                                        \
        const int t = id >> 3, i0 = (id & 7) * 8;                                                             \
        const u16* rp = proj + (size_t)(row0 + min((CB) + t, T - 1)) * NPJ + h * 64 + i0;                     \
        Rq[it] = *(const uint4*)rp;                                                                           \
        Rk[it] = *(const uint4*)(rp + 256);                                                                   \
      }                                                                                                       \
      { const int t = (tid & 127) >> 1, hf = tid & 1;                                                         \
        Ral = *(const uint4*)(proj + (size_t)(row0 + min((CB) + t, T - 1)) * NPJ + 1536 + hf * 8); }          \
    }                                                                                                         \
    if (BR == 2) {                                                                                            \
      const int t = tid >> 2, i0 = (tid & 3) * 8;                                                             \
      const u16* rp = proj + (size_t)(row0 + min((CB) + t, T - 1)) * NPJ + 2840 + h * 64 + i0;                \
      Rq1 = *(const uint4*)rp; Rq2 = *(const uint4*)(rp + 32);                                                \
      Rk1 = *(const uint4*)(rp + 256); Rk2 = *(const uint4*)(rp + 288);                                       \
    }                                                                                                         \
    if (BR == 1) {                                                                                            \
      if (act) {                                                                                              \
        _Pragma("unroll") for (int k = 0; k < 11; ++k) {                                                      \
          int tau = (CB) + ts * 8 - 3 + k;                                                                    \
          tau = min(max(tau, 0), T - 1);                                                                      \
          Rx[k] = *(const uint4*)(proj + (size_t)(row0 + tau) * NPJ + 2064 + chan);                           \
        }                                                                                                     \
      }                                                                                                       \
      if (w == 0) dtraw = bf2f(proj[(size_t)(row0 + min((CB) + lane, T - 1)) * NPJ + 2832 + h]);              \
    }                                                                                                         \
  }
  REC_LOAD(0, Rg)

  for (int c0 = 0; c0 < T; c0 += 64) {
    const int nvalid = min(64, T - c0);
    if (BR == 0 || BR == 2) {
      const int voff_ = (BR == 0 ? 512 : 3352) + h * 128;
#pragma unroll
      for (int it = 0; it < 4; ++it) {
        const int id = tid + 256 * it;
        const int t = id >> 4, j0 = (id & 15) * 8;
        Rv[it] = *(const uint4*)(proj + (size_t)(row0 + min(c0 + t, T - 1)) * NPJ + voff_ + j0);
      }
    }
    if (BR == 0) {
      if (tid < 128) {
        const int t = tid >> 1, hf = tid & 1;
        float a8[8];
        unpack8(Ral, a8);
        *(float4*)(AL + t * 16 + hf * 8) = make_float4(a8[0], a8[1], a8[2], a8[3]);
        *(float4*)(AL + t * 16 + hf * 8 + 4) = make_float4(a8[4], a8[5], a8[6], a8[7]);
      }
      __syncthreads();
      {
        float run = 0.f;
#pragma unroll 4
        for (int tt = 0; tt < 16; ++tt) {
          const int t = part * 16 + tt;
          const float4 x0 = *(const float4*)(AL + t * 16), x1 = *(const float4*)(AL + t * 16 + 4);
          const float4 x2 = *(const float4*)(AL + t * 16 + 8), x3 = *(const float4*)(AL + t * 16 + 12);
          float a = bias;
          a += x0.x * w2r[0] + x0.y * w2r[1] + x0.z * w2r[2] + x0.w * w2r[3];
          a += x1.x * w2r[4] + x1.y * w2r[5] + x1.z * w2r[6] + x1.w * w2r[7];
          a += x2.x * w2r[8] + x2.y * w2r[9] + x2.z * w2r[10] + x2.w * w2r[11];
          a += x3.x * w2r[12] + x3.y * w2r[13] + x3.z * w2r[14] + x3.w * w2r[15];
          float g = (fminf(a, 0.f) - log1pf(__expf(-fabsf(a)))) * (1.f / 16.f);
          if (t >= nvalid) g = 0.f;
          run += g;
          Gl[t * 64 + ci] = run;
        }
        psum[part * 64 + ci] = run;
      }
      __syncthreads();
      {
        float off = 0.f;
        for (int p = 0; p < part; ++p) off += psum[p * 64 + ci];
#pragma unroll 4
        for (int tt = 0; tt < 16; ++tt) Gl[(part * 16 + tt) * 64 + ci] += off;
      }
      __syncthreads();
#pragma unroll
      for (int it = 0; it < 2; ++it) {
        const int id = tid + 256 * it;
        const int t = id >> 3, i0 = (id & 7) * 8;
        const bool valid = t < nvalid;
        float qf[8], kf[8], G[8], Ge[8], qa[8], kb[8];
        unpack8(Rq[it], qf); unpack8(Rk[it], kf);
        *(float4*)&G[0] = *(const float4*)(Gl + t * 64 + i0);
        *(float4*)&G[4] = *(const float4*)(Gl + t * 64 + i0 + 4);
        *(float4*)&Ge[0] = *(const float4*)(Gl + 63 * 64 + i0);
        *(float4*)&Ge[4] = *(const float4*)(Gl + 63 * 64 + i0 + 4);
#pragma unroll
        for (int e = 0; e < 8; ++e) {
          const float qv = valid ? qf[e] : 0.f, kv = valid ? kf[e] : 0.f;
          qa[e] = qv * 0.125f * __expf(G[e]);
          kb[e] = kv * __expf(-G[e]);
          KT[tsw(i0 + e, t)] = (u16)f2bf(kv * __expf(Ge[e] - G[e]));
        }
        *(uint4*)(QA + t * LDT + i0) = pack8(qa);
        *(uint4*)(KB + t * LDT + i0) = pack8(kb);
        if (t == 63) {
#pragma unroll
          for (int e = 0; e < 8; ++e) dec[i0 + e] = __expf(Ge[e]);
        }
        __builtin_amdgcn_sched_barrier(0);
      }
#pragma unroll
      for (int it = 0; it < 4; ++it) {
        const int id = tid + 256 * it;
        const int t = id >> 4, j0 = (id & 15) * 8;
        uint4 v4 = Rv[it];
        if (t >= nvalid) v4 = make_uint4(0, 0, 0, 0);
        VT[tsw(j0 + 0, t)] = (u16)(v4.x & 0xffffu); VT[tsw(j0 + 1, t)] = (u16)(v4.x >> 16);
        VT[tsw(j0 + 2, t)] = (u16)(v4.y & 0xffffu); VT[tsw(j0 + 3, t)] = (u16)(v4.y >> 16);
        VT[tsw(j0 + 4, t)] = (u16)(v4.z & 0xffffu); VT[tsw(j0 + 5, t)] = (u16)(v4.z >> 16);
        VT[tsw(j0 + 6, t)] = (u16)(v4.w & 0xffffu); VT[tsw(j0 + 7, t)] = (u16)(v4.w >> 16);
      }
      if (tid < 64) Gsc[tid] = 0.f;
    }
    if (BR == 2) {
      {
        const int t = tid >> 2, i0 = (tid & 3) * 8;
        const bool valid = t < nvalid;
        float q1f[8], q2f[8], k1f[8], k2f[8], o1[8], o2[8], p1[8], p2[8];
        unpack8(Rq1, q1f); unpack8(Rq2, q2f); unpack8(Rk1, k1f); unpack8(Rk2, k2f);
        const float pos = (float)(pos0 + c0 + t);
        const float ed = __expf(lg * (float)(nvalid - min(t + 1, nvalid)));
#pragma unroll
        for (int e = 0; e < 8; ++e) {
          const float ang = pos * invf[i0 + e];
          double rev = (double)ang * 0.15915494309189535;
          rev -= floor(rev);
          const float rf = (float)rev;
          const float sn = __builtin_amdgcn_sinf(rf), cs = __builtin_amdgcn_cosf(rf);
          const float a1 = valid ? q1f[e] : 0.f, a2 = valid ? q2f[e] : 0.f;
          const float b1 = valid ? k1f[e] : 0.f, b2 = valid ? k2f[e] : 0.f;
          o1[e] = a1 * cs - a2 * sn;
          o2[e] = a1 * sn + a2 * cs;
          p1[e] = (b1 * cs - b2 * sn) * 0.125f;
          p2[e] = (b1 * sn + b2 * cs) * 0.125f;
          KT[tsw(i0 + e, t)] = (u16)f2bf(p1[e] * ed);
          KT[tsw(32 + i0 + e, t)] = (u16)f2bf(p2[e] * ed);
        }
        *(uint4*)(QA + t * LDT + i0) = pack8(o1);
        *(uint4*)(QA + t * LDT + 32 + i0) = pack8(o2);
        *(uint4*)(KB + t * LDT + i0) = pack8(p1);
        *(uint4*)(KB + t * LDT + 32 + i0) = pack8(p2);
      }
#pragma unroll
      for (int it = 0; it < 4; ++it) {
        const int id = tid + 256 * it;
        const int t = id >> 4, j0 = (id & 15) * 8;
        uint4 v4 = Rv[it];
        if (t >= nvalid) v4 = make_uint4(0, 0, 0, 0);
        VT[tsw(j0 + 0, t)] = (u16)(v4.x & 0xffffu); VT[tsw(j0 + 1, t)] = (u16)(v4.x >> 16);
        VT[tsw(j0 + 2, t)] = (u16)(v4.y & 0xffffu); VT[tsw(j0 + 3, t)] = (u16)(v4.y >> 16);
        VT[tsw(j0 + 4, t)] = (u16)(v4.z & 0xffffu); VT[tsw(j0 + 5, t)] = (u16)(v4.z >> 16);
        VT[tsw(j0 + 6, t)] = (u16)(v4.w & 0xffffu); VT[tsw(j0 + 7, t)] = (u16)(v4.w >> 16);
      }
      if (tid < 64) {
        Gsc[tid] = lg * (float)min(tid + 1, nvalid);
        dec[tid] = __expf(lg * (float)nvalid);
      }
    }
    if (BR == 1) {
      if (w == 0) {
        float dt = 0.f, g = 0.f;
        if (lane < nvalid) {
          dt = softplus_f(dtraw + dtb);
          g = dt * aneg;
        }
        float x = g;
#pragma unroll
        for (int o = 1; o < 64; o <<= 1) {
          float y = __shfl_up(x, o);
          if (lane >= o) x += y;
        }
        const float ge = __shfl(x, 63);
        Gsc[lane] = x; dtv[lane] = dt; dec[lane] = __expf(ge); psum[lane] = __expf(ge - x);
      }
      __syncthreads();
      if (act) {
        const bool first = (c0 == 0 && ts == 0);
        const float* cst = P.in[4] + (size_t)(l * 128 + b) * 3 * 768 + chan;
#pragma unroll
        for (int p = 0; p < 4; ++p) {
          float x0[11], x1[11];
#pragma unroll
          for (int k = 0; k < 11; ++k) {
            const unsigned wd = p == 0 ? Rx[k].x : (p == 1 ? Rx[k].y : (p == 2 ? Rx[k].z : Rx[k].w));
            x0[k] = __uint_as_float(wd << 16);
            x1[k] = __uint_as_float(wd & 0xffff0000u);
          }
          if (first) {
#pragma unroll
            for (int k = 0; k < 3; ++k) {
              const float2 sv = *(const float2*)(cst + k * 768 + 2 * p);
              x0[k] = sample ? sv.x : 0.f;
              x1[k] = sample ? sv.y : 0.f;
            }
          }
          float o0[8], o1[8];
#pragma unroll
          for (int tt = 0; tt < 8; ++tt) {
            const bool valid = (ts * 8 + tt) < nvalid;
            float a0 = cbv[2 * p], a1 = cbv[2 * p + 1];
#pragma unroll
            for (int i = 0; i < 4; ++i) { a0 += cwv[i][2 * p] * x0[tt + i]; a1 += cwv[i][2 * p + 1] * x1[tt + i]; }
            o0[tt] = valid ? silu_f(a0) : 0.f;
            o1[tt] = valid ? silu_f(a1) : 0.f;
          }
          u16* rowdst = seg == 0 ? XH : (seg == 1 ? KB : QA);
#pragma unroll
          for (int tt = 0; tt < 8; ++tt) *(unsigned*)(rowdst + (ts * 8 + tt) * LDT + c8 + 2 * p) = pack2(o0[tt], o1[tt]);
          if (seg < 2) {
            const float* sc = seg == 0 ? dtv : psum;
            u16* cdst = seg == 0 ? VT : KT;
            float c0v[8], c1v[8];
#pragma unroll
            for (int tt = 0; tt < 8; ++tt) { const float f = sc[ts * 8 + tt]; c0v[tt] = o0[tt] * f; c1v[tt] = o1[tt] * f; }
            *(uint4*)(cdst + tsw(c8 + 2 * p, ts * 8)) = pack8(c0v);
            *(uint4*)(cdst + tsw(c8 + 2 * p + 1, ts * 8)) = pack8(c1v);
          }
          __builtin_amdgcn_sched_barrier(0);
        }
      }
    }
    __syncthreads();
    if (c0 + 64 < T) { REC_LOAD(c0 + 64, RgN) }

#pragma unroll
    for (int nf = 0; nf < NFV; ++nf)
      *(uint2*)(ST + (nf * 16 + r) * LDT + 16 * w + q * 4) = make_uint2(pack2(S[nf][0], S[nf][1]), pack2(S[nf][2], S[nf][3]));

    bf16x8 aq[2];
    aq[0] = *(const bf16x8*)(QA + (16 * w + r) * LDT + q * 8);
    aq[1] = *(const bf16x8*)(QA + (16 * w + r) * LDT + 32 + q * 8);
    float gt[4];
#pragma unroll
    for (int e = 0; e < 4; ++e) gt[e] = Gsc[16 * w + q * 4 + e];
#pragma unroll
    for (int n = 0; n < 4; ++n) {
      f32x4 a = (f32x4){0.f, 0.f, 0.f, 0.f};
      if (n <= w) {
#pragma unroll
        for (int kk = 0; kk < 2; ++kk) {
          bf16x8 bk = *(const bf16x8*)(KB + (16 * n + r) * LDT + kk * 32 + q * 8);
          a = __builtin_amdgcn_mfma_f32_16x16x32_bf16(aq[kk], bk, a, 0, 0, 0);
        }
      }
      const int s = 16 * n + r;
      const float gs = Gsc[s];
#pragma unroll
      for (int e = 0; e < 4; ++e) {
        const int t = 16 * w + q * 4 + e;
        float v = (s <= t) ? a[e] * __expf(gt[e] - gs) : 0.f;
        ATT[t * LDT + s] = (u16)f2bf(v);
      }
    }
    __syncthreads();

    f32x4 O[NFV];
#pragma unroll
    for (int nf = 0; nf < NFV; ++nf) O[nf] = (f32x4){0.f, 0.f, 0.f, 0.f};
#pragma unroll
    for (int kk = 0; kk < 2; ++kk)
#pragma unroll
      for (int nf = 0; nf < NFV; ++nf) {
        bf16x8 bs = *(const bf16x8*)(ST + (nf * 16 + r) * LDT + kk * 32 + q * 8);
        O[nf] = __builtin_amdgcn_mfma_f32_16x16x32_bf16(aq[kk], bs, O[nf], 0, 0, 0);
      }
    if (BR != 0) {
#pragma unroll
      for (int e = 0; e < 4; ++e) {
        const float sc = __expf(gt[e]);
#pragma unroll
        for (int nf = 0; nf < NFV; ++nf) O[nf][e] *= sc;
      }
    }
    {
      float dc[4];
#pragma unroll
      for (int e = 0; e < 4; ++e) dc[e] = dec[16 * w + q * 4 + e];
#pragma unroll
      for (int nf = 0; nf < NFV; ++nf)
#pragma unroll
        for (int e = 0; e < 4; ++e) S[nf][e] *= dc[e];
    }
    int vtb[2], ktb[2];
    vtb[0] = r * LDT + ((q ^ (r >> 3)) << 3);
    vtb[1] = r * LDT + ((q ^ (2 + (r >> 3))) << 3);
    ktb[0] = tsw(16 * w + r, q * 8);
    ktb[1] = tsw(16 * w + r, 32 + q * 8);
#pragma unroll
    for (int kk = 0; kk < 2; ++kk) {
      bf16x8 at = *(const bf16x8*)(ATT + (16 * w + r) * LDT + kk * 32 + q * 8);
      bf16x8 ak = *(const bf16x8*)(KT + ktb[kk]);
#pragma unroll
      for (int nf = 0; nf < NFV; ++nf) {
        bf16x8 bv = *(const bf16x8*)(VT + vtb[nf & 1] + nf * 16 * LDT + ((kk ^ ((nf >> 1) & 1)) * 32));
        O[nf] = __builtin_amdgcn_mfma_f32_16x16x32_bf16(at, bv, O[nf], 0, 0, 0);
        S[nf] = __builtin_amdgcn_mfma_f32_16x16x32_bf16(ak, bv, S[nf], 0, 0, 0);
      }
    }
    __syncthreads();
#pragma unroll
    for (int nf = 0; nf < NFV; ++nf)
#pragma unroll
      for (int e = 0; e < 4; ++e) OST[(16 * w + q * 4 + e) * OLD + nf * 16 + r] = O[nf][e];
    __syncthreads();

#pragma unroll
    for (int it = 0; it < NEP; ++it) {
      const int id = tid + 256 * it;
      const int t = (DV == 128) ? (id >> 4) : (id >> 3);
      const int j0 = (DV == 128) ? (id & 15) * 8 : (id & 7) * 8;
      const bool valid = t < nvalid;
      const size_t row = (size_t)(row0 + c0 + t);
      float ov[8], gv[8], y[8];
      *(float4*)&ov[0] = *(const float4*)(OST + t * OLD + j0);
      *(float4*)&ov[4] = *(const float4*)(OST + t * OLD + j0 + 4);
      unpack8(Rg[it], gv);
      if (BR == 1) {
        float xh[8];
        unpack8(*(const uint4*)(XH + t * LDT + j0), xh);
        float ss = 0.f;
#pragma unroll
        for (int e = 0; e < 8; ++e) { y[e] = (ov[e] + dsk * xh[e]) * silu_f(gv[e]); ss += y[e] * y[e]; }
        ss += __shfl_xor(ss, 1); ss += __shfl_xor(ss, 2); ss += __shfl_xor(ss, 4);
        if (valid) {
          *(uint4*)(ybr + row * LDY + h * 64 + j0) = pack8(y);
          if ((tid & 7) == 0) ssq[row * 8 + h] = ss;
        }
      } else {
        float ss = 0.f;
#pragma unroll
        for (int e = 0; e < 8; ++e) ss += ov[e] * ov[e];
        ss += __shfl_xor(ss, 1); ss += __shfl_xor(ss, 2); ss += __shfl_xor(ss, 4); ss += __shfl_xor(ss, 8);
        const float rs = rsqrtf(ss * (1.f / 128.f) + 1e-6f);
        if (BR == 0) {
          const float* wn = P.in[12] + l * 128 + j0;
          const float4 w0 = *(const float4*)wn, w1 = *(const float4*)(wn + 4);
          const float wv[8] = {w0.x, w0.y, w0.z, w0.w, w1.x, w1.y, w1.z, w1.w};
#pragma unroll
          for (int e = 0; e < 8; ++e) y[e] = silu_f(gv[e]) * ov[e] * rs * wv[e];
        } else {
#pragma unroll
          for (int e = 0; e < 8; ++e) y[e] = silu_f(gv[e]) * ov[e] * rs;
        }
        if (valid) *(uint4*)(ybr + row * LDY + h * 128 + j0) = pack8(y);
      }
      __builtin_amdgcn_sched_barrier(0);
    }
#pragma unroll
    for (int it = 0; it < NEP; ++it) Rg[it] = RgN[it];
    __syncthreads();
  }
#undef REC_LOAD

  {
    float* so;
    if (sample) so = P.out + (BR == 0 ? O_SGS : (BR == 1 ? O_SSS : O_SRS)) + ((size_t)(l * 128 + b) * NH + h) * 64 * DV;
    else so = P.out + (BR == 0 ? O_SGP : (BR == 1 ? O_SSP : O_SRP)) + ((size_t)(l * 8 + b) * NH + h) * 64 * DV;
#pragma unroll
    for (int nf = 0; nf < NFV; ++nf)
#pragma unroll
      for (int e = 0; e < 4; ++e) so[(size_t)(16 * w + q * 4 + e) * DV + nf * 16 + r] = S[nf][e];
  }
}

#ifndef REC_ONLY
#define REC_ONLY -1
#endif
template <int BR>
__device__ __forceinline__ void rec_branch(const Params& P, int l, bool split, int wb, int nwb, int lb0, unsigned char* ldsb) {
  if (!(REC_ONLY < 0 || REC_ONLY == BR)) return;
  constexpr int NH = (BR == 1) ? 8 : 4;
  constexpr int nl = 8 * NH;
  const int end = nl + 128 * NH;
  int it, step;
  if (split) {
    const int bx = blockIdx.x;
    if (bx >= lb0 && bx < lb0 + nl) { it = bx - lb0; step = 1 << 20; }
    else if (bx >= 128) { it = nl + wb; step = nwb; }
    else { it = end; step = 1; }
  } else { it = blockIdx.x; step = gridDim.x; }
  for (; it < end; it += step) {
    const int sample = it >= nl;
    const int idx = sample ? it - nl : it;
    int ll = l;
    asm volatile("" : "+s"(ll));
    rec_item<BR>(P, ll, idx / NH, idx % NH, sample, ldsb);
  }
}

__device__ __forceinline__ void phase_rec(const Params& P, int l, unsigned char* ldsb) {
  const int G = gridDim.x;
  const u16* proj = (const u16*)(P.ws + WS_A);
  const bool split = (G >= 256);
  const int wb = split ? (int)blockIdx.x - 128 : (int)blockIdx.x;
  int nwb = split ? G - 128 : G;
  asm volatile("" : "+s"(nwb));
  if (wb >= 0) {
    for (int i = wb * 256 + otid(); i < (8 + 128) * 3 * 768; i += nwb * 256) {
      const bool pr = i < 8 * 3 * 768;
      const int j = pr ? i : i - 8 * 3 * 768;
      const int b = j / (3 * 768), rem = j - b * 3 * 768, rr = rem / 768, c = rem - rr * 768;
      const size_t row = pr ? (size_t)(b * TP + 2061 + rr) : (size_t)(MP + b * 4 + 1 + rr);
      const size_t oo = pr ? O_SCP + (size_t)l * 8 * 3 * 768 + j : O_SCS + (size_t)l * 128 * 3 * 768 + j;
      P.out[oo] = bf2f(proj[row * NPJ + 2064 + c]);
    }
  }
  rec_branch<0>(P, l, split, wb, nwb, 0, ldsb);
  rec_branch<1>(P, l, split, wb, nwb, 32, ldsb);
  rec_branch<2>(P, l, split, wb, nwb, 96, ldsb);
  if (wb >= 0) {
    __syncthreads();
    if (l == 0) {
      convert_layer(P, 0, ldsb, 1888, 4576, wb, nwb);
      convert_layer(P, 1, ldsb, 0, 2528, wb, nwb);
    } else {
      convert_layer(P, 1, ldsb, 2528, 4576, wb, nwb);
    }
    phase_gates(P, l, wb, nwb, ldsb);
  }
}


#define XB_TMO      128
#define XB_XCNT(j)  (256  + 64 * (j))
#define XB_XSUB(j)  (1280 + 64 * (j))
#define XB_XGEN(j)  (2304 + 64 * (j))
#define XB_TOP      3328
#define XB_TOPGEN   3392
#define XCD_BAR_WORDS 3456
#define XB_SPIN_CAP (1u << 22)
__device__ __forceinline__ unsigned xb_ld(unsigned* p) { return __hip_atomic_load(p, __ATOMIC_RELAXED, __HIP_MEMORY_SCOPE_AGENT); }
__device__ __forceinline__ unsigned xb_add(unsigned* p, unsigned v) { return __hip_atomic_fetch_add(p, v, __ATOMIC_RELAXED, __HIP_MEMORY_SCOPE_AGENT); }
__device__ __forceinline__ unsigned xb_xcc_id() { return (unsigned)__builtin_amdgcn_s_getreg((3 << 11) | 20) & 0xFu; }
#define XB_SPIN(cond, bar) do { unsigned _sp = 0; while (cond) { __builtin_amdgcn_s_sleep(1); \
    if ((++_sp & 255u) == 0u) { if (xb_ld(&(bar)[XB_TMO])) break; if (_sp > XB_SPIN_CAP) { atomicAdd(&(bar)[XB_TMO], 1u); break; } } } } while (0)
struct XcdBarrier { unsigned* bar; unsigned x; volatile LAS unsigned* st; };
__device__ __forceinline__ XcdBarrier xcd_barrier_post(unsigned* bar, volatile LAS unsigned* st) {
  XcdBarrier b; b.bar = bar; b.x = xb_xcc_id(); b.st = st;
  if (threadIdx.x == 0) (void)xb_add(&bar[XB_XCNT(b.x)], 1u);
  return b;
}
__device__ __forceinline__ void xcd_barrier_complete(unsigned* bar, unsigned x, unsigned& nloc, unsigned& nx) {
  const unsigned G = gridDim.x * gridDim.y * gridDim.z;
  unsigned sum, cnt, mine, sp = 0u;
  for (;;) {
    sum = 0u; cnt = 0u; mine = 0u;
#pragma unroll
    for (unsigned j = 0; j < 16; ++j) { const unsigned c = xb_ld(&bar[XB_XCNT(j)]); sum += c; cnt += (c > 0u) ? 1u : 0u; mine = (j == x) ? c : mine; }
    if (sum == G) break;
    __builtin_amdgcn_s_sleep(1);
    if ((++sp & 255u) == 0u) { if (xb_ld(&bar[XB_TMO])) break; if (sp > XB_SPIN_CAP) { atomicAdd(&bar[XB_TMO], 1u); break; } }
  }
  nloc = mine > 0u ? mine : 1u; nx = cnt > 0u ? cnt : 1u;
}
__device__ __forceinline__ void xcd_barrier(const XcdBarrier& b) {
  asm volatile("s_waitcnt vmcnt(0)" ::: "memory");
  __syncthreads();
  if (threadIdx.x == 0) {
    unsigned* bar = b.bar;
    __builtin_amdgcn_s_waitcnt(0);
    unsigned nloc = b.st[0], nx = b.st[1];
    if (nloc == 0u) { xcd_barrier_complete(bar, b.x, nloc, nx); b.st[0] = nloc; b.st[1] = nx; }
    const unsigned old = xb_add(&bar[XB_XSUB(b.x)], 1u);
    const unsigned gen = old / nloc;
    if (old + 1u == (gen + 1u) * nloc) {
      __builtin_amdgcn_fence(__ATOMIC_RELEASE, "agent");
      asm volatile("s_waitcnt vmcnt(0)" ::: "memory");
      const unsigned og = xb_add(&bar[XB_TOP], 1u);
      const unsigned tg = og / nx;
      if (og + 1u == (tg + 1u) * nx) xb_add(&bar[XB_TOPGEN], 1u);
      else XB_SPIN(xb_ld(&bar[XB_TOPGEN]) == tg, bar);
      __builtin_amdgcn_fence(__ATOMIC_ACQUIRE, "agent");
      xb_add(&bar[XB_XGEN(b.x)], 1u);
      asm volatile("s_waitcnt vmcnt(0)" ::: "memory");
    } else {
      XB_SPIN(xb_ld(&bar[XB_XGEN(b.x)]) == gen, bar);
      __builtin_amdgcn_fence(__ATOMIC_ACQUIRE, "agent");
      asm volatile("s_waitcnt vmcnt(0)" ::: "memory");
    }
  }
  __syncthreads();
}

__global__ void __launch_bounds__(256, 2) fwd_kernel(Params P, int ph_lo, int ph_hi) {
  extern __shared__ __attribute__((aligned(16))) unsigned char ldsb[];
  cg::grid_group grid = cg::this_grid();
  volatile LAS unsigned* xst = (volatile LAS unsigned*)(ldsb + 75904);
  if (threadIdx.x == 0) { xst[0] = 0u; xst[1] = 0u; xst[2] = 0u; xst[3] = 0u; }
  __syncthreads();
  XcdBarrier xb = xcd_barrier_post((unsigned*)(P.ws + WS_BAR), xst);
  if (ph_hi > 1000) grid.sync();
  for (int ph = ph_lo; ph < ph_hi; ++ph) {
    if (ph > ph_lo) xcd_barrier(xb);
    if (ph == 0) {
      if (PH_ON(0)) { convert_layer(P, 0, ldsb, 0, 1888, blockIdx.x, gridDim.x); ln_phase(P, 0, 0); }
      continue;
    }
    int phl = ph;
    asm volatile("" : "+s"(phl));
    const int l = (phl - 1) >> 3, s = (phl - 1) & 7;
    switch (s) {
      case 0: if (PH_ON(1)) { phase_proj(P, l, ldsb); if (DUP(1)) phase_proj(P, l, ldsb); } break;
      case 1: if (PH_ON(2)) { phase_rec(P, l, ldsb); if (DUP(2)) { __syncthreads(); phase_rec(P, l, ldsb); } } break;
      case 2: if (PH_ON(3)) { phase_merge(P, l, ldsb); if (DUP(3)) phase_merge(P, l, ldsb); } break;
      case 3: if (PH_ON(4)) { phase_resid(P, 0, l, ldsb); if (DUP(4)) phase_resid(P, 0, l, ldsb); } break;
      case 4: if (PH_ON(5)) { ln_phase(P, 1, l); if (DUP(5)) ln_phase(P, 1, l); } break;
      case 5: if (PH_ON(6)) { phase_ff1(P, l, ldsb); if (DUP(6)) phase_ff1(P, l, ldsb); } break;
      case 6: if (PH_ON(7)) { phase_resid(P, 1, l, ldsb); if (DUP(7)) phase_resid(P, 1, l, ldsb); } break;
      case 7:
        if (PH_ON(8)) { ln_phase(P, 2, l); }
        break;
    }
  }
}

extern "C" void kernel_launch(void* const* d_in, const int* in_sizes, int n_in, void* d_out, int out_size, void* d_ws,
                              size_t ws_size, hipStream_t stream) {
  static int grid_blocks = 0;
  if (grid_blocks == 0) {
    if (n_in != 31 || ws_size < WS_END || out_size != 44666880) {
      fprintf(stderr, "kernel_launch: unexpected problem (n_in %d, ws %zu, out %d)\n", n_in, ws_size, out_size);
      grid_blocks = -1;
      return;
    }
    int dev = 0, cus = 0, per_cu = 0;
    hipGetDevice(&dev);
    hipDeviceGetAttribute(&cus, hipDeviceAttributeMultiprocessorCount, dev);
    hipFuncSetAttribute((const void*)fwd_kernel, hipFuncAttributeMaxDynamicSharedMemorySize, LDS_BYTES);
    hipOccupancyMaxActiveBlocksPerMultiprocessor(&per_cu, (const void*)fwd_kernel, 256, LDS_BYTES);
    if (per_cu < 1) { fprintf(stderr, "kernel_launch: occupancy query says 0 blocks per CU\n"); grid_blocks = -1; return; }
    if (per_cu > 2) per_cu = 2;
    grid_blocks = cus * per_cu;
    grid_blocks -= grid_blocks % 8;
  }
  if (grid_blocks < 0) return;
  Params p{};
  for (int i = 0; i < 31; ++i) p.in[i] = (const float*)d_in[i];
  p.out = (float*)d_out;
  p.ws = (unsigned char*)d_ws;
  if (hipMemsetAsync((char*)d_ws + WS_BAR, 0, XCD_BAR_WORDS * 4, stream) != hipSuccess) { fprintf(stderr, "memset failed\n"); return; }
#if ONE_LAUNCH
  int lo = 0, hi = NPHASE;
  void* args[] = {&p, &lo, &hi};
  hipError_t e = hipLaunchCooperativeKernel((const void*)fwd_kernel, dim3(grid_blocks), dim3(256), args, LDS_BYTES, stream);
  if (e != hipSuccess) fprintf(stderr, "cooperative launch failed: %s (grid %d)\n", hipGetErrorString(e), grid_blocks);
#else
  for (int ph = 0; ph < NPHASE; ++ph) {
    hipLaunchKernelGGL(fwd_kernel, dim3(grid_blocks), dim3(256), LDS_BYTES, stream, p, ph, ph + 1);
  }
#endif
}
```

```cpp
#include <hip/hip_runtime.h>
#include <hip/hip_cooperative_groups.h>
#include <stdint.h>
#include <stdio.h>
namespace cg = cooperative_groups;

#ifndef ONE_LAUNCH
#define ONE_LAUNCH 1
#endif
#ifndef PHASE_ONLY
#define PHASE_ONLY -1
#endif
#define PH_ON(n) (PHASE_ONLY < 0 || PHASE_ONLY == (n))
#ifndef DUP_MASK
#define DUP_MASK 0
#endif
#define DUP(n) ((DUP_MASK >> (n)) & 1)

#define LAS __attribute__((address_space(3)))
typedef unsigned short u16;
typedef __attribute__((ext_vector_type(8))) short bf16x8;
typedef __attribute__((ext_vector_type(4))) float f32x4;

constexpr int D = 1024;
constexpr int TP = 2064;
constexpr int MP = 8 * TP;
constexpr int MS = 512;
constexpr int M = MP + MS;
constexpr int NPJ = 4376;
constexpr int LDT = 72;
constexpr float ALPHA = 1.4142135623730951f;
constexpr int NPHASE = 17;
constexpr int SPLIT_ROW0 = 128 * 128;

constexpr int LDA = 1088;
constexpr int LDY = 576;
constexpr int LDH = 4160;
constexpr size_t WS_WIN = 0;
constexpr size_t WS_WGATE = 9748480;
constexpr size_t WS_WOUT = 16433152;
constexpr size_t WS_WO = 19972096;
constexpr size_t WS_WFF1 = 22200320;
constexpr size_t WS_WFF2 = 31113216;
constexpr size_t WS_ACT = 39632896;
constexpr size_t WS_SSQ = 76677120;
constexpr size_t WS_A = 77221888;
constexpr size_t WS_B = 226215936;
constexpr size_t WS_BAR = 295946240;
constexpr size_t WS_W2 = WS_BAR + 16384;
constexpr size_t WS_G1X = WS_W2 + 22200320;
constexpr size_t WS_END = WS_G1X + 524288;
constexpr int G1_SPLIT = 16768;
constexpr size_t A_PRE = 37044224;

constexpr size_t O_YP = 0, O_YS = 16777216, O_SGP = 17301504, O_SGS = 17825792, O_SSP = 26214400, O_SSS = 26738688,
                 O_SCP = 35127296, O_SCS = 35164160, O_SRP = 35753984, O_SRS = 36278272;

constexpr int LDS_BYTES = 76032;

struct Params { const float* in[31]; float* out; unsigned char* ws; };

__device__ __forceinline__ unsigned f2bf(float f) {
  unsigned u = __float_as_uint(f);
  u += 0x7fffu + ((u >> 16) & 1u);
  return u >> 16;
}
__device__ __forceinline__ float bf2f(u16 h) { return __uint_as_float(((unsigned)h) << 16); }
__device__ __forceinline__ unsigned pack2(float a, float b) { return f2bf(a) | (f2bf(b) << 16); }
__device__ __forceinline__ void unpack8(uint4 v, float (&f)[8]) {
  f[0] = __uint_as_float(v.x << 16); f[1] = __uint_as_float(v.x & 0xffff0000u);
  f[2] = __uint_as_float(v.y << 16); f[3] = __uint_as_float(v.y & 0xffff0000u);
  f[4] = __uint_as_float(v.z << 16); f[5] = __uint_as_float(v.z & 0xffff0000u);
  f[6] = __uint_as_float(v.w << 16); f[7] = __uint_as_float(v.w & 0xffff0000u);
}
__device__ __forceinline__ uint4 pack8(const float (&f)[8]) {
  return make_uint4(pack2(f[0], f[1]), pack2(f[2], f[3]), pack2(f[4], f[5]), pack2(f[6], f[7]));
}
__device__ __forceinline__ int tsw(int row, int col) { return row * LDT + (col ^ (((row >> 3) & 7) << 3)); }
__device__ __forceinline__ int otid() { int t = threadIdx.x; asm volatile("" : "+v"(t)); return t; }
__device__ __forceinline__ float silu_f(float x) { return x / (1.f + __expf(-x)); }
__device__ __forceinline__ float sigmoid_f(float x) { return 1.f / (1.f + __expf(-x)); }
__device__ __forceinline__ float softplus_f(float x) { return fmaxf(x, 0.f) + log1pf(__expf(-fabsf(x))); }

__device__ __forceinline__ void conv_tile64(const float* __restrict__ src, int ld, int ldk, int ncol0, int nvalid, u16* __restrict__ dst,
                            int kt, int nt, const float* __restrict__ kscale, float* tile, int blocked_nkt = 0) {
  const int tid = otid();
  const int c = tid & 63, r4 = tid >> 6;
  const int n = nt * 64 + c;
  const bool ok = n < nvalid;
#pragma unroll
  for (int i = 0; i < 16; ++i) {
    int k = r4 + 4 * i;
    int kg = kt * 64 + k;
    float v = ok ? src[(size_t)kg * ld + ncol0 + n] : 0.f;
    if (kscale) v *= kscale[kg];
    tile[k * 65 + c] = v;
  }
  __syncthreads();
#pragma unroll
  for (int it = 0; it < 2; ++it) {
    int id = tid + 256 * it;
    int nn = id >> 3, kc = id & 7;
    unsigned w0 = pack2(tile[(kc * 8 + 0) * 65 + nn], tile[(kc * 8 + 1) * 65 + nn]);
    unsigned w1 = pack2(tile[(kc * 8 + 2) * 65 + nn], tile[(kc * 8 + 3) * 65 + nn]);
    unsigned w2 = pack2(tile[(kc * 8 + 4) * 65 + nn], tile[(kc * 8 + 5) * 65 + nn]);
    unsigned w3 = pack2(tile[(kc * 8 + 6) * 65 + nn], tile[(kc * 8 + 7) * 65 + nn]);
    const int n_ = nt * 64 + nn;
    const size_t di = blocked_nkt ? ((size_t)((n_ >> 7) * blocked_nkt + kt) * 8192 + (n_ & 127) * 64 + kc * 8)
                                  : ((size_t)n_ * ldk + kt * 64 + kc * 8);
    *(uint4*)(dst + di) = make_uint4(w0, w1, w2, w3);
  }
  __syncthreads();
}

__device__ __forceinline__ void convert_layer(const Params& P, int l, unsigned char* lds, int t_lo, int t_hi, int wb, int nwb) {
  float* tile = (float*)lds;
  unsigned char* ws = P.ws;
  const size_t wsel = (l == 0) ? 0 : WS_W2;
  for (int t = t_lo + wb; t < t_hi; t += nwb) {
    int idx = t;
    if (idx < 1120) {
      conv_tile64(P.in[9] + (size_t)l * 1024 * 7448, 7448, LDA, 0, NPJ, (u16*)(ws + wsel + WS_WIN), idx % 16, idx / 16, nullptr, tile);
      continue;
    }
    idx -= 1120;
    if (idx < 768) {
      conv_tile64(P.in[9] + (size_t)l * 1024 * 7448, 7448, LDA, NPJ, 3072, (u16*)(ws + wsel + WS_WGATE), idx % 16, idx / 16, nullptr, tile);
      continue;
    }
    idx -= 768;
    if (idx < 384) {
      int br = idx / 128, r = idx % 128;
      conv_tile64(P.in[19 + br] + (size_t)l * 512 * 1024, 1024, LDY, 0, 1024, (u16*)(ws + wsel + WS_WOUT) + (size_t)br * 1024 * LDY,
                  r % 8, r / 8, br == 1 ? P.in[18] + l * 512 : nullptr, tile);
      continue;
    }
    idx -= 384;
    if (idx < 256) {
      conv_tile64(P.in[22] + (size_t)l * 1024 * 1024, 1024, LDA, 0, 1024, (u16*)(ws + wsel + WS_WO), idx % 16, idx / 16, nullptr, tile);
      continue;
    }
    idx -= 256;
    if (idx < 1024) {
      conv_tile64(P.in[25] + (size_t)l * 1024 * 4096, 4096, LDA, 0, 4096, (u16*)(ws + WS_WFF1), idx % 16, idx / 16, nullptr, tile);
      continue;
    }
    idx -= 1024;
    conv_tile64(P.in[27] + (size_t)l * 4096 * 1024, 1024, LDH, 0, 1024, (u16*)(ws + WS_WFF2), idx % 64, idx / 64, nullptr, tile, 64);
  }
}

__device__ __forceinline__ void ln_phase(const Params& P, int mode, int l) {
  const int tid_ = otid();
  const int lane = tid_ & 63;
  const int gw = blockIdx.x * 4 + (tid_ >> 6);
  const int nw = gridDim.x * 4;
  const float* wv = mode == 0 ? P.in[7] : (mode == 1 ? P.in[23] + l * D : P.in[29] + l * D);
  const float* bv = mode == 0 ? P.in[8] : (mode == 1 ? P.in[24] + l * D : P.in[30] + l * D);
  u16* act = (u16*)(P.ws + WS_ACT);
  const bool final_out = (mode == 2 && l == 1);
  for (int row = gw; row < M; row += nw) {
    const float* s;
    int b = 0, t = 0;
    if (row < MP) { b = row / TP; t = row - b * TP; }
    if (mode == 0) {
      if (row < MP) s = (t < 16) ? P.in[6] + (size_t)t * D : P.in[0] + ((size_t)b * 2048 + (t - 16)) * D;
      else s = P.in[1] + (size_t)(row - MP) * D;
    } else if (mode == 1) {
      s = (const float*)(P.ws + WS_A + A_PRE) + (size_t)row * D;
    } else {
      s = (const float*)(P.ws + WS_B) + (size_t)row * D;
    }
    float4 v[4];
#pragma unroll
    for (int i = 0; i < 4; ++i) v[i] = *(const float4*)(s + i * 256 + lane * 4);
    float sum = 0.f;
#pragma unroll
    for (int i = 0; i < 4; ++i) sum += v[i].x + v[i].y + v[i].z + v[i].w;
#pragma unroll
    for (int o = 32; o >= 1; o >>= 1) sum += __shfl_xor(sum, o);
    const float mean = sum * (1.f / 1024.f);
    float sq = 0.f;
#pragma unroll
    for (int i = 0; i < 4; ++i) {
      v[i].x -= mean; v[i].y -= mean; v[i].z -= mean; v[i].w -= mean;
      sq += v[i].x * v[i].x + v[i].y * v[i].y + v[i].z * v[i].z + v[i].w * v[i].w;
    }
#pragma unroll
    for (int o = 32; o >= 1; o >>= 1) sq += __shfl_xor(sq, o);
    const float rstd = rsqrtf(sq * (1.f / 1024.f) + 1e-5f);
    float* od = nullptr;
    if (final_out) {
      if (row < MP) { if (t >= 16) od = P.out + O_YP + ((size_t)b * 2048 + (t - 16)) * D; }
      else od = P.out + O_YS + (size_t)(row - MP) * D;
    }
#pragma unroll
    for (int i = 0; i < 4; ++i) {
      const int c = i * 256 + lane * 4;
      float4 w4 = *(const float4*)(wv + c), b4 = *(const float4*)(bv + c);
      float y0 = v[i].x * rstd * w4.x + b4.x, y1 = v[i].y * rstd * w4.y + b4.y;
      float y2 = v[i].z * rstd * w4.z + b4.z, y3 = v[i].w * rstd * w4.w + b4.w;
      if (final_out) {
        if (od) *(float4*)(od + c) = make_float4(y0, y1, y2, y3);
      } else {
        const unsigned p0 = pack2(y0, y1), p1 = pack2(y2, y3);
        *(uint2*)(act + (size_t)row * LDA + c) = make_uint2(p0, p1);
        if (mode == 1 && row >= SPLIT_ROW0) {
          const float4 bb = *(const float4*)(P.in[28] + l * D + c);
          float* pz = (float*)(P.ws + WS_B) + (size_t)row * D + c;
          *(float4*)pz = make_float4(ALPHA * __uint_as_float(p0 << 16) + bb.x, ALPHA * __uint_as_float(p0 & 0xffff0000u) + bb.y,
                                     ALPHA * __uint_as_float(p1 << 16) + bb.z, ALPHA * __uint_as_float(p1 & 0xffff0000u) + bb.w);
        }
      }
    }
  }
}

#define G_LOAD4(R, k0)                                                                    \
  R##a0 = *(const uint4*)(ap + (k0)); R##a1 = *(const uint4*)(ap + sa + (k0));            \
  R##a2 = *(const uint4*)(ap + 2 * sa + (k0)); R##a3 = *(const uint4*)(ap + 3 * sa + (k0)); \
  R##b0 = *(const uint4*)(bp + (k0)); R##b1 = *(const uint4*)(bp + sb + (k0));
#define G_LOADB(R, k0)                                                                    \
  R##b2 = *(const uint4*)(bp + 2 * sb + (k0)); R##b3 = *(const uint4*)(bp + 3 * sb + (k0));
#define L_STORE4(R, buf)                                                                  \
  { u16* ad = As + (buf) * 128 * LDT + crow * LDT + cck;                                  \
    u16* bd = Bs + (buf) * BN * LDT + crow * LDT + cck;                                   \
    *(uint4*)(ad) = R##a0; *(uint4*)(ad + 32 * LDT) = R##a1; *(uint4*)(ad + 64 * LDT) = R##a2; *(uint4*)(ad + 96 * LDT) = R##a3; \
    *(uint4*)(bd) = R##b0; *(uint4*)(bd + 32 * LDT) = R##b1;                              \
    if (NF == 4) { *(uint4*)(bd + 64 * LDT) = R##b2; *(uint4*)(bd + 96 * LDT) = R##b3; } }
#define MMA_TILE(buf)                                                                     \
  { const u16* as = As + (buf) * 128 * LDT + (wm * 64 + r) * LDT + q * 8;                 \
    const u16* bs = Bs + (buf) * BN * LDT + (wn * NF * 16 + r) * LDT + q * 8;             \
    _Pragma("unroll") for (int kk = 0; kk < 2; ++kk) {                                    \
      bf16x8 af[4], bfr[NF];                                                              \
      _Pragma("unroll") for (int mf = 0; mf < 4; ++mf) af[mf] = *(const bf16x8*)(as + mf * 16 * LDT + kk * 32); \
      _Pragma("unroll") for (int nf = 0; nf < NF; ++nf) bfr[nf] = *(const bf16x8*)(bs + nf * 16 * LDT + kk * 32); \
      _Pragma("unroll") for (int mf = 0; mf < 4; ++mf)                                    \
        _Pragma("unroll") for (int nf = 0; nf < NF; ++nf)                                 \
          acc[mf][nf] = __builtin_amdgcn_mfma_f32_16x16x32_bf16(af[mf], bfr[nf], acc[mf][nf], 0, 0, 0); \
    } }

__device__ __forceinline__ int lds_byte(int r, int c) {
  int st = (r >> 4) * 2 + (c >> 5), rr = r & 15, cc = c & 31, ob = rr * 64 + cc * 2;
  return st * 1024 + (ob ^ (((ob >> 9) & 1) << 5));
}
__device__ __forceinline__ void stage_rc(int b, int& R, int& C) {
  int st = b >> 10, sb = b & 1023, swz = sb ^ (((sb >> 9) & 1) << 5);
  R = (st >> 1) * 16 + (swz >> 6);
  C = (st & 1) * 32 + ((swz & 63) >> 1);
}

template <int NF>
__device__ __forceinline__ void gemm_core(f32x4 (&acc)[4][NF], const u16* __restrict__ A, int lda,
                                          const u16* __restrict__ B, int ldb, int K, u16* lds, int kadv = 64) {
  constexpr int BN = 32 * NF;
  constexpr int ABYTES = 128 * 64 * 2;
  constexpr int BBYTES = BN * 64 * 2;
  constexpr int BUF = ABYTES + BBYTES;
  unsigned char* base = (unsigned char*)lds;
  const int tid = otid(), lane = tid & 63, w = tid >> 6, wm = w >> 1, wn = w & 1, r = lane & 15, q = lane >> 4;
  const u16* ga[4]; const u16* gb[NF];
#pragma unroll
  for (int i = 0; i < 4; ++i) { int R, C; stage_rc(tid * 16 + i * 4096, R, C); ga[i] = A + (size_t)R * lda + C; }
#pragma unroll
  for (int i = 0; i < NF; ++i) { int R, C; stage_rc(tid * 16 + i * 4096, R, C); gb[i] = B + (size_t)R * ldb + C; }
  int oa[4][2], ob[NF][2];
#pragma unroll
  for (int mf = 0; mf < 4; ++mf)
#pragma unroll
    for (int kk = 0; kk < 2; ++kk) oa[mf][kk] = lds_byte(wm * 64 + mf * 16 + r, kk * 32 + q * 8);
#pragma unroll
  for (int nf = 0; nf < NF; ++nf)
#pragma unroll
    for (int kk = 0; kk < 2; ++kk) ob[nf][kk] = lds_byte(wn * NF * 16 + nf * 16 + r, kk * 32 + q * 8);
#define STAGE_TILE(buf, k0)                                                                              \
  {                                                                                                      \
    _Pragma("unroll") for (int i = 0; i < 4; ++i)                                                        \
      __builtin_amdgcn_global_load_lds((const unsigned*)(ga[i] + (k0)),                                  \
        (LAS unsigned*)(base + (buf) * BUF + tid * 16 + i * 4096), 16, 0, 0);                            \
    _Pragma("unroll") for (int i = 0; i < NF; ++i)                                                       \
      __builtin_amdgcn_global_load_lds((const unsigned*)(gb[i] + (k0)),                                  \
        (LAS unsigned*)(base + (buf) * BUF + ABYTES + tid * 16 + i * 4096), 16, 0, 0);                   \
  }
  const int nk = K >> 6;
  STAGE_TILE(0, 0)
  asm volatile("s_waitcnt vmcnt(0)" ::: "memory");
  __syncthreads();
  for (int kt = 0; kt < nk; ++kt) {
    const int buf = kt & 1;
    if (kt + 1 < nk) STAGE_TILE(buf ^ 1, (size_t)(kt + 1) * kadv)
    const unsigned char* as = base + buf * BUF;
    const unsigned char* bs = as + ABYTES;
    bf16x8 af0[4], bf0[NF], af1[4], bf1[NF];
#pragma unroll
    for (int mf = 0; mf < 4; ++mf) af0[mf] = *(const bf16x8*)(as + oa[mf][0]);
#pragma unroll
    for (int nf = 0; nf < NF; ++nf) bf0[nf] = *(const bf16x8*)(bs + ob[nf][0]);
    __builtin_amdgcn_s_setprio(1);
#pragma unroll
    for (int nf = 0; nf < NF / 2; ++nf)
#pragma unroll
      for (int mf = 0; mf < 4; ++mf)
        acc[mf][nf] = __builtin_amdgcn_mfma_f32_16x16x32_bf16(af0[mf], bf0[nf], acc[mf][nf], 0, 0, 0);
    __builtin_amdgcn_s_setprio(0);
#pragma unroll
    for (int mf = 0; mf < 4; ++mf) af1[mf] = *(const bf16x8*)(as + oa[mf][1]);
#pragma unroll
    for (int nf = 0; nf < NF; ++nf) bf1[nf] = *(const bf16x8*)(bs + ob[nf][1]);
    __builtin_amdgcn_s_setprio(1);
#pragma unroll
    for (int nf = NF / 2; nf < NF; ++nf)
#pragma unroll
      for (int mf = 0; mf < 4; ++mf)
        acc[mf][nf] = __builtin_amdgcn_mfma_f32_16x16x32_bf16(af0[mf], bf0[nf], acc[mf][nf], 0, 0, 0);
#pragma unroll
    for (int nf = 0; nf < NF; ++nf)
#pragma unroll
      for (int mf = 0; mf < 4; ++mf)
        acc[mf][nf] = __builtin_amdgcn_mfma_f32_16x16x32_bf16(af1[mf], bf1[nf], acc[mf][nf], 0, 0, 0);
    __builtin_amdgcn_s_setprio(0);
    asm volatile("s_waitcnt vmcnt(0)" ::: "memory");
    __syncthreads();
  }
#undef STAGE_TILE
}

#define TILE_LOOP(total)                                                                      \
  const int _nx = (gridDim.x % 8 == 0) ? 8 : 1;                                              \
  const int _ns = gridDim.x / _nx;                                                           \
  const int _x = blockIdx.x % _nx, _s = blockIdx.x / _nx;                                    \
  const int _per = ((total) + _nx - 1) / _nx;                                                \
  const int _lo = _x * _per;                                                                 \
  const int _hi = min((total), _lo + _per);                                                  \
  for (int t = _lo + _s; t < _hi; t += _ns)

__device__ __forceinline__ void tile_decode(int t, int MT, int NT, int& mt, int& nt) {
  int g = t / (8 * NT), r = t - g * 8 * NT;
  int gs = min(8, MT - g * 8);
  mt = g * 8 + r % gs;
  nt = r / gs;
}

template <int NF>
__device__ __forceinline__ void zero_acc(f32x4 (&acc)[4][NF]) {
#pragma unroll
  for (int i = 0; i < 4; ++i)
#pragma unroll
    for (int j = 0; j < NF; ++j) acc[i][j] = (f32x4){0.f, 0.f, 0.f, 0.f};
}

__device__ __forceinline__ void phase_proj(const Params& P, int l, unsigned char* ldsb) {
  const u16* act = (const u16*)(P.ws + WS_ACT);
  const u16* W = (const u16*)(P.ws + (l == 0 ? 0 : WS_W2) + WS_WIN);
  u16* proj = (u16*)(P.ws + WS_A);
  constexpr int MT = 133, NT = 35;
  TILE_LOOP(MT * NT) {
    int mt, nt; tile_decode(t, MT, NT, mt, nt);
    const int tid_ = otid(), lane = tid_ & 63, w = tid_ >> 6, wm = w >> 1, wn = w & 1, r = lane & 15, q = lane >> 4;
    f32x4 acc[4][4]; zero_acc<4>(acc);
    gemm_core<4>(acc, act + (size_t)mt * 128 * LDA, LDA, W + (size_t)nt * 128 * LDA, LDA, D, (u16*)ldsb);
#pragma unroll
    for (int mf = 0; mf < 4; ++mf)
#pragma unroll
      for (int nf = 0; nf < 4; ++nf) {
        const int col = nt * 128 + wn * 64 + nf * 16 + r;
        if (col < NPJ) {
#pragma unroll
          for (int e = 0; e < 4; ++e) {
            const int row = mt * 128 + wm * 64 + mf * 16 + q * 4 + e;
            proj[(size_t)row * NPJ + col] = (u16)f2bf(acc[mf][nf][e]);
          }
        }
      }
  }
}

__device__ __forceinline__ u16* gate_row(const Params& P, int br, int row) {
  if (br == 0) return (u16*)P.out + (size_t)row * D;
  if (row < G1_SPLIT) return (u16*)P.out + (size_t)M * D + (size_t)row * D;
  return (u16*)(P.ws + WS_G1X) + (size_t)(row - G1_SPLIT) * D;
}

__device__ __forceinline__ void phase_gates(const Params& P, int l, int wb, int nwb, unsigned char* ldsb) {
  const u16* act = (const u16*)(P.ws + WS_ACT);
  const u16* Wg = (const u16*)(P.ws + (l == 0 ? 0 : WS_W2) + WS_WGATE);
  constexpr int MT = 133, NT = 8;
  for (int t = wb; t < 2 * MT * NT; t += nwb) {
    const int br = t / (MT * NT);
    int mt, nt; tile_decode(t - br * MT * NT, MT, NT, mt, nt);
    const int tid_ = otid(), lane = tid_ & 63, w = tid_ >> 6, wm = w >> 1, wn = w & 1, r = lane & 15, q = lane >> 4;
    f32x4 acc[4][4]; zero_acc<4>(acc);
    gemm_core<4>(acc, act + (size_t)mt * 128 * LDA, LDA, Wg + ((size_t)br * 1024 + nt * 128) * LDA, LDA, D, (u16*)ldsb);
#pragma unroll
    for (int mf = 0; mf < 4; ++mf)
#pragma unroll
      for (int e = 0; e < 4; ++e) {
        const int row = mt * 128 + wm * 64 + mf * 16 + q * 4 + e;
        u16* gr = gate_row(P, br, row);
#pragma unroll
        for (int nf = 0; nf < 4; ++nf) gr[nt * 128 + wn * 64 + nf * 16 + r] = (u16)f2bf(sigmoid_f(acc[mf][nf][e]));
      }
  }
}

__device__ __forceinline__ void phase_merge(const Params& P, int l, unsigned char* ldsb) {
  const u16* act = (const u16*)(P.ws + WS_ACT);
  const u16* Wg = (const u16*)(P.ws + (l == 0 ? 0 : WS_W2) + WS_WGATE);
  const u16* Wo = (const u16*)(P.ws + (l == 0 ? 0 : WS_W2) + WS_WOUT);
  const u16* ybr = (const u16*)(P.ws + WS_B);
  const float* ssq = (const float*)(P.ws + WS_SSQ);
  u16* merged = (u16*)(P.ws + WS_A);
  constexpr int MT = 133, NT = 16;
  {
    float* pre = (float*)(P.ws + WS_A + A_PRE);
    for (int i = blockIdx.x * 256 + otid(); i < (M - SPLIT_ROW0) * (D / 4); i += gridDim.x * 256) {
      const int row = SPLIT_ROW0 + i / (D / 4), c = (i % (D / 4)) * 4;
      const uint2 xv = *(const uint2*)(act + (size_t)row * LDA + c);
      *(float4*)(pre + (size_t)row * D + c) = make_float4(ALPHA * __uint_as_float(xv.x << 16), ALPHA * __uint_as_float(xv.x & 0xffff0000u),
                                                          ALPHA * __uint_as_float(xv.y << 16), ALPHA * __uint_as_float(xv.y & 0xffff0000u));
    }
  }
  TILE_LOOP(MT * NT) {
    int mt, nt; tile_decode(t, MT, NT, mt, nt);
    const int tid_ = otid(), lane = tid_ & 63, w = tid_ >> 6, wm = w >> 1, wn = w & 1, r = lane & 15, q = lane >> 4;
    f32x4 fin[4][2]; zero_acc<2>(fin);
#pragma unroll 1
    for (int br = 0; br < 3; ++br) {
      f32x4 g[4][2]; zero_acc<2>(g);
      if (br == 2) {
        gemm_core<2>(g, act + (size_t)mt * 128 * LDA, LDA, Wg + ((size_t)br * 1024 + nt * 64) * LDA, LDA, D, (u16*)ldsb);
#pragma unroll
        for (int mf = 0; mf < 4; ++mf)
#pragma unroll
          for (int nf = 0; nf < 2; ++nf)
#pragma unroll
            for (int e = 0; e < 4; ++e) g[mf][nf][e] = sigmoid_f(g[mf][nf][e]);
      } else {
#pragma unroll
        for (int mf = 0; mf < 4; ++mf)
#pragma unroll
          for (int e = 0; e < 4; ++e) {
            const u16* gr = gate_row(P, br, mt * 128 + wm * 64 + mf * 16 + q * 4 + e) + nt * 64 + wn * 32 + r;
#pragma unroll
            for (int nf = 0; nf < 2; ++nf) g[mf][nf][e] = bf2f(gr[nf * 16]);
          }
      }
      const u16* yb = ybr + (size_t)br * M * LDY + (size_t)mt * 128 * LDY;
      const u16* wb = Wo + (size_t)br * 1024 * LDY + (size_t)nt * 64 * LDY;
      if (br != 1) {
        f32x4 acc[4][2]; zero_acc<2>(acc);
        gemm_core<2>(acc, yb, LDY, wb, LDY, 512, (u16*)ldsb);
#pragma unroll
        for (int mf = 0; mf < 4; ++mf)
#pragma unroll
          for (int nf = 0; nf < 2; ++nf)
#pragma unroll
            for (int e = 0; e < 4; ++e) fin[mf][nf][e] += g[mf][nf][e] * acc[mf][nf][e];
      } else {
#pragma unroll 1
        for (int grp = 0; grp < 2; ++grp) {
          f32x4 acc[4][2]; zero_acc<2>(acc);
          gemm_core<2>(acc, yb + grp * 256, LDY, wb + grp * 256, LDY, 256, (u16*)ldsb);
#pragma unroll
          for (int mf = 0; mf < 4; ++mf)
#pragma unroll
            for (int e = 0; e < 4; ++e) {
              const int row = mt * 128 + wm * 64 + mf * 16 + q * 4 + e;
              float4 s4 = *(const float4*)(ssq + (size_t)row * 8 + grp * 4);
              float rs = rsqrtf((s4.x + s4.y + s4.z + s4.w) * (1.f / 256.f) + 1e-6f);
#pragma unroll
              for (int nf = 0; nf < 2; ++nf) fin[mf][nf][e] += g[mf][nf][e] * rs * acc[mf][nf][e];
            }
        }
      }
    }
#pragma unroll
    for (int mf = 0; mf < 4; ++mf)
#pragma unroll
      for (int nf = 0; nf < 2; ++nf)
#pragma unroll
        for (int e = 0; e < 4; ++e) {
          const int row = mt * 128 + wm * 64 + mf * 16 + q * 4 + e;
          const int col = nt * 64 + wn * 32 + nf * 16 + r;
          merged[(size_t)row * LDA + col] = (u16)f2bf(fin[mf][nf][e]);
        }
  }
}

__device__ __forceinline__ void phase_resid(const Params& P, int mode, int l, unsigned char* ldsb) {
  const u16* act = (const u16*)(P.ws + WS_ACT);
  const u16* A = (const u16*)(P.ws + WS_A);
  const int K = mode == 0 ? 1024 : 4096;
  const int ldk = mode == 0 ? LDA : LDH;
  const u16* W = (const u16*)(P.ws + (mode == 0 ? (l == 0 ? 0 : WS_W2) + WS_WO : WS_WFF2));
  float* dst = mode == 0 ? (float*)(P.ws + WS_A + A_PRE) : (float*)(P.ws + WS_B);
  const float* bias = P.in[28] + l * D;
  constexpr int MT = 128, NT = 8;
  TILE_LOOP(MT * NT) {
    int mt, nt; tile_decode(t, MT, NT, mt, nt);
    const int tid_ = otid(), lane = tid_ & 63, w = tid_ >> 6, wm = w >> 1, wn = w & 1, r = lane & 15, q = lane >> 4;
    f32x4 acc[4][4]; zero_acc<4>(acc);
    if (mode == 0) gemm_core<4>(acc, A + (size_t)mt * 128 * ldk, ldk, W + (size_t)nt * 128 * ldk, ldk, K, (u16*)ldsb);
    else gemm_core<4>(acc, A + (size_t)mt * 64 * 8192, 64, W + (size_t)nt * 64 * 8192, 64, K, (u16*)ldsb, 8192);
#pragma unroll
    for (int mf = 0; mf < 4; ++mf)
#pragma unroll
      for (int nf = 0; nf < 4; ++nf) {
        const int col = nt * 128 + wn * 64 + nf * 16 + r;
        const float bb = mode == 1 ? bias[col] : 0.f;
#pragma unroll
        for (int e = 0; e < 4; ++e) {
          const int row = mt * 128 + wm * 64 + mf * 16 + q * 4 + e;
          dst[(size_t)row * D + col] = ALPHA * bf2f(act[(size_t)row * LDA + col]) + acc[mf][nf][e] + bb;
        }
      }
  }
  {
    constexpr int S = 8;
    const int KS = K / S;
    for (int li = blockIdx.x; li < 40 * S; li += gridDim.x) {
      const int sl = li % S, tl = li / S;
      const int mt = 128 + tl / 8, nt = tl % 8;
      const int tid_ = otid(), lane = tid_ & 63, w = tid_ >> 6, wm = w >> 1, wn = w & 1, r = lane & 15, q = lane >> 4;
      f32x4 acc[4][4]; zero_acc<4>(acc);
      if (mode == 0) gemm_core<4>(acc, A + (size_t)mt * 128 * ldk + sl * KS, ldk, W + (size_t)nt * 128 * ldk + sl * KS, ldk, KS, (u16*)ldsb);
      else gemm_core<4>(acc, A + ((size_t)mt * 64 + sl * (KS / 64)) * 8192, 64, W + ((size_t)nt * 64 + sl * (KS / 64)) * 8192, 64, KS, (u16*)ldsb, 8192);
#pragma unroll
      for (int mf = 0; mf < 4; ++mf)
#pragma unroll
        for (int nf = 0; nf < 4; ++nf) {
          const int col = nt * 128 + wn * 64 + nf * 16 + r;
#pragma unroll
          for (int e = 0; e < 4; ++e) {
            const int row = mt * 128 + wm * 64 + mf * 16 + q * 4 + e;
            (void)__hip_atomic_fetch_add(dst + (size_t)row * D + col, acc[mf][nf][e], __ATOMIC_RELAXED, __HIP_MEMORY_SCOPE_AGENT);
          }
        }
    }
  }
}

__device__ __forceinline__ void phase_ff1(const Params& P, int l, unsigned char* ldsb) {
  const u16* act = (const u16*)(P.ws + WS_ACT);
  const u16* W = (const u16*)(P.ws + WS_WFF1);
  u16* hid = (u16*)(P.ws + WS_A);
  const float* bias = P.in[26] + l * 4096;
  constexpr int MT = 133, NT = 32;
  TILE_LOOP(MT * NT) {
    int mt, nt; tile_decode(t, MT, NT, mt, nt);
    const int tid_ = otid(), lane = tid_ & 63, w = tid_ >> 6, wm = w >> 1, wn = w & 1, r = lane & 15, q = lane >> 4;
    f32x4 acc[4][4]; zero_acc<4>(acc);
    gemm_core<4>(acc, act + (size_t)mt * 128 * LDA, LDA, W + (size_t)nt * 128 * LDA, LDA, D, (u16*)ldsb);
#pragma unroll
    for (int mf = 0; mf < 4; ++mf)
#pragma unroll
      for (int nf = 0; nf < 4; ++nf) {
        const int col = nt * 128 + wn * 64 + nf * 16 + r;
        const float bb = bias[col];
#pragma unroll
        for (int e = 0; e < 4; ++e) {
          const int row = mt * 128 + wm * 64 + mf * 16 + q * 4 + e;
          float v = fmaxf(acc[mf][nf][e] + bb, 0.f);
          hid[((size_t)(row >> 7) * 64 + (col >> 6)) * 8192 + (row & 127) * 64 + (col & 63)] = (u16)f2bf(v * v);
        }
      }
  }
}

template <int BR>
__device__ __forceinline__ void rec_item(const Params& P, int l, int b, int h, int sample, unsigned char* ldsb) {
  constexpr int DV = (BR == 1) ? 64 : 128;
  constexpr int NFV = DV / 16;
  constexpr int NH = (BR == 1) ? 8 : 4;
  constexpr int OLD = DV + 4;
  constexpr int NEP = DV / 32;
  u16* QA = (u16*)ldsb;
  u16* KB = QA + 64 * LDT;
  u16* KT = KB + 64 * LDT;
  u16* ATT = KT + 64 * LDT;
  u16* VT = ATT + 64 * LDT;
  u16* ST = VT + 128 * LDT;
  float* Gsc = (float*)(ST + 128 * LDT);
  float* dec = Gsc + 64;
  float* dtv = dec + 64;
  float* psum = dtv + 64;
  float* invf = psum + 256;
  float* Gl = (float*)ST;
  float* AL = (float*)ATT;
  float* OST = (float*)ldsb;
  u16* XH = VT + 64 * LDT;

  const int tid = otid(), lane = tid & 63, w = tid >> 6, r = lane & 15, q = lane >> 4;
  const int T = sample ? 4 : TP;
  const int row0 = sample ? MP + b * 4 : b * TP;
  const int pos0 = sample ? 16384 : 0;
  const u16* proj = (const u16*)(P.ws + WS_A);
  u16* ybr = (u16*)(P.ws + WS_B) + (size_t)BR * M * LDY;
  float* ssq = (float*)(P.ws + WS_SSQ);

  float lg = 0.f, aneg = 0.f, dtb = 0.f, dsk = 0.f;
  if (BR == 2) {
    lg = log1pf(-exp2f(-5.f - (float)h));
    if (tid < 32) invf[tid] = exp2f(-(float)tid * (13.287712379549449f / 32.0f));
  }
  if (BR == 1) {
    aneg = -__expf(P.in[16][l * 8 + h]);
    dtb = P.in[15][l * 8 + h];
    dsk = P.in[17][l * 8 + h];
  }
  const int grp = h >> 2;

  f32x4 S[NFV];
  {
    const float* sin_ = P.in[2];
    if (sample) {
      const float* base = BR == 0 ? P.in[2] : (BR == 1 ? P.in[3] : P.in[5]);
      sin_ = base + ((size_t)(l * 128 + b) * NH + h) * 64 * DV;
    }
#pragma unroll
    for (int nf = 0; nf < NFV; ++nf)
#pragma unroll
      for (int e = 0; e < 4; ++e) {
        float v = sin_[(size_t)(16 * w + q * 4 + e) * DV + nf * 16 + r];
        S[nf][e] = sample ? v : 0.f;
      }
  }
  __syncthreads();

  uint4 Rg[NEP], RgN[NEP];
  uint4 Rq[2], Rk[2], Rv[4], Ral;
  uint4 Rq1, Rq2, Rk1, Rk2;
  uint4 Rx[11];
  float dtraw = 0.f;
  const int ci = tid & 63, part = tid >> 6;
  float w2r[16];
  float bias = 0.f;
  if (BR == 0) {
#pragma unroll
    for (int rr = 0; rr < 16; ++rr) w2r[rr] = P.in[10][(size_t)(l * 16 + rr) * 256 + h * 64 + ci];
    bias = P.in[11][l * 256 + h * 64 + ci];
  }
  const int cc = tid >> 3, ts = tid & 7;
  const bool act = tid < 192;
  const int seg = cc >> 3, c8 = (cc & 7) * 8;
  const int chan = seg == 0 ? h * 64 + c8 : (seg == 1 ? 512 + grp * 64 + c8 : 640 + grp * 64 + c8);
  float cwv[4][8], cbv[8];
  if (BR == 1 && act) {
    const float* cw = P.in[13] + (size_t)l * 4 * 768 + chan;
    const float* cb = P.in[14] + (size_t)l * 768 + chan;
#pragma unroll
    for (int i = 0; i < 4; ++i) {
      *(float4*)&cwv[i][0] = *(const float4*)(cw + i * 768);
      *(float4*)&cwv[i][4] = *(const float4*)(cw + i * 768 + 4);
    }
    *(float4*)&cbv[0] = *(const float4*)cb;
    *(float4*)&cbv[4] = *(const float4*)(cb + 4);
  }
#define REC_LOAD(CB, RGD)                                                                                     \
  {                                                                                                           \
    const int goff_ = BR == 0 ? 1024 + h * 128 : (BR == 1 ? 1552 + h * 64 : 3864 + h * 128);                  \
    _Pragma("unroll") for (int it = 0; it < NEP; ++it) {                                                      \
      const int id = tid + 256 * it;                                                                          \
      const int t = (DV == 128) ? (id >> 4) : (id >> 3);                                                      \
      const int j0 = (DV == 128) ? (id & 15) * 8 : (id & 7) * 8;                                              \
      RGD[it] = *(const uint4*)(proj + (size_t)(row0 + min((CB) + t, T - 1)) * NPJ + goff_ + j0);             \
    }                                                                                                         \
    if (BR == 0) {                                                                                            \
      _Pragma("unroll") for (int it = 0; it < 2; ++it) {                                                      \
        const int id = tid + 256 * it;                                                                        \
        const int t = id >> 3, i0 = (id & 7) * 8;                                                             \
        const u16* rp = proj + (size_t)(row0 + min((CB) + t, T - 1)) * NPJ + h * 64 + i0;                     \
        Rq[it] = *(const uint4*)rp;                                                                           \
        Rk[it] = *(const uint4*)(rp + 256);                                                                   \
      }                                                                                                       \
      { const int t = (tid & 127) >> 1, hf = tid & 1;                                                         \
        Ral = *(const uint4*)(proj + (size_t)(row0 + min((CB) + t, T - 1)) * NPJ + 1536 + hf * 8); }          \
    }                                                                                                         \
    if (BR == 2) {                                                                                            \
      const int t = tid >> 2, i0 = (tid & 3) * 8;                                                             \
      const u16* rp = proj + (size_t)(row0 + min((CB) + t, T - 1)) * NPJ + 2840 + h * 64 + i0;                \
      Rq1 = *(const uint4*)rp; Rq2 = *(const uint4*)(rp + 32);                                                \
      Rk1 = *(const uint4*)(rp + 256); Rk2 = *(const uint4*)(rp + 288);                                       \
    }                                                                                                         \
    if (BR == 1) {                                                                                            \
      if (act) {                                                                                              \
        _Pragma("unroll") for (int k = 0; k < 11; ++k) {                                                      \
          int tau = (CB) + ts * 8 - 3 + k;                                                                    \
          tau = min(max(tau, 0), T - 1);                                                                      \
          Rx[k] = *(const uint4*)(proj + (size_t)(row0 + tau) * NPJ + 2064 + chan);                           \
        }                                                                                                     \
      }                                                                                                       \
      if (w == 0) dtraw = bf2f(proj[(size_t)(row0 + min((CB) + lane, T - 1)) * NPJ + 2832 + h]);              \
    }                                                                                                         \
  }
  REC_LOAD(0, Rg)

  for (int c0 = 0; c0 < T; c0 += 64) {
    const int nvalid = min(64, T - c0);
    if (BR == 0 || BR == 2) {
      const int voff_ = (BR == 0 ? 512 : 3352) + h * 128;
#pragma unroll
      for (int it = 0; it < 4; ++it) {
        const int id = tid + 256 * it;
        const int t = id >> 4, j0 = (id & 15) * 8;
        Rv[it] = *(const uint4*)(proj + (size_t)(row0 + min(c0 + t, T - 1)) * NPJ + voff_ + j0);
      }
    }
    if (BR == 0) {
      if (tid < 128) {
        const int t = tid >> 1, hf = tid & 1;
        float a8[8];
        unpack8(Ral, a8);
        *(float4*)(AL + t * 16 + hf * 8) = make_float4(a8[0], a8[1], a8[2], a8[3]);
        *(float4*)(AL + t * 16 + hf * 8 + 4) = make_float4(a8[4], a8[5], a8[6], a8[7]);
      }
      __syncthreads();
      {
        float run = 0.f;
#pragma unroll 4
        for (int tt = 0; tt < 16; ++tt) {
          const int t = part * 16 + tt;
          const float4 x0 = *(const float4*)(AL + t * 16), x1 = *(const float4*)(AL + t * 16 + 4);
          const float4 x2 = *(const float4*)(AL + t * 16 + 8), x3 = *(const float4*)(AL + t * 16 + 12);
          float a = bias;
          a += x0.x * w2r[0] + x0.y * w2r[1] + x0.z * w2r[2] + x0.w * w2r[3];
          a += x1.x * w2r[4] + x1.y * w2r[5] + x1.z * w2r[6] + x1.w * w2r[7];
          a += x2.x * w2r[8] + x2.y * w2r[9] + x2.z * w2r[10] + x2.w * w2r[11];
          a += x3.x * w2r[12] + x3.y * w2r[13] + x3.z * w2r[14] + x3.w * w2r[15];
          float g = (fminf(a, 0.f) - log1pf(__expf(-fabsf(a)))) * (1.f / 16.f);
          if (t >= nvalid) g = 0.f;
          run += g;
          Gl[t * 64 + ci] = run;
        }
        psum[part * 64 + ci] = run;
      }
      __syncthreads();
      {
        float off = 0.f;
        for (int p = 0; p < part; ++p) off += psum[p * 64 + ci];
#pragma unroll 4
        for (int tt = 0; tt < 16; ++tt) Gl[(part * 16 + tt) * 64 + ci] += off;
      }
      __syncthreads();
#pragma unroll
      for (int it = 0; it < 2; ++it) {
        const int id = tid + 256 * it;
        const int t = id >> 3, i0 = (id & 7) * 8;
        const bool valid = t < nvalid;
        float qf[8], kf[8], G[8], Ge[8], qa[8], kb[8];
        unpack8(Rq[it], qf); unpack8(Rk[it], kf);
        *(float4*)&G[0] = *(const float4*)(Gl + t * 64 + i0);
        *(float4*)&G[4] = *(const float4*)(Gl + t * 64 + i0 + 4);
        *(float4*)&Ge[0] = *(const float4*)(Gl + 63 * 64 + i0);
        *(float4*)&Ge[4] = *(const float4*)(Gl + 63 * 64 + i0 + 4);
#pragma unroll
        for (int e = 0; e < 8; ++e) {
          const float qv = valid ? qf[e] : 0.f, kv = valid ? kf[e] : 0.f;
          qa[e] = qv * 0.125f * __expf(G[e]);
          kb[e] = kv * __expf(-G[e]);
          KT[tsw(i0 + e, t)] = (u16)f2bf(kv * __expf(Ge[e] - G[e]));
        }
        *(uint4*)(QA + t * LDT + i0) = pack8(qa);
        *(uint4*)(KB + t * LDT + i0) = pack8(kb);
        if (t == 63) {
#pragma unroll
          for (int e = 0; e < 8; ++e) dec[i0 + e] = __expf(Ge[e]);
        }
        __builtin_amdgcn_sched_barrier(0);
      }
#pragma unroll
      for (int it = 0; it < 4; ++it) {
        const int id = tid + 256 * it;
        const int t = id >> 4, j0 = (id & 15) * 8;
        uint4 v4 = Rv[it];
        if (t >= nvalid) v4 = make_uint4(0, 0, 0, 0);
        VT[tsw(j0 + 0, t)] = (u16)(v4.x & 0xffffu); VT[tsw(j0 + 1, t)] = (u16)(v4.x >> 16);
        VT[tsw(j0 + 2, t)] = (u16)(v4.y & 0xffffu); VT[tsw(j0 + 3, t)] = (u16)(v4.y >> 16);
        VT[tsw(j0 + 4, t)] = (u16)(v4.z & 0xffffu); VT[tsw(j0 + 5, t)] = (u16)(v4.z >> 16);
        VT[tsw(j0 + 6, t)] = (u16)(v4.w & 0xffffu); VT[tsw(j0 + 7, t)] = (u16)(v4.w >> 16);
      }
      if (tid < 64) Gsc[tid] = 0.f;
    }
    if (BR == 2) {
      {
        const int t = tid >> 2, i0 = (tid & 3) * 8;
        const bool valid = t < nvalid;
        float q1f[8], q2f[8], k1f[8], k2f[8], o1[8], o2[8], p1[8], p2[8];
        unpack8(Rq1, q1f); unpack8(Rq2, q2f); unpack8(Rk1, k1f); unpack8(Rk2, k2f);
        const float pos = (float)(pos0 + c0 + t);
        const float ed = __expf(lg * (float)(nvalid - min(t + 1, nvalid)));
#pragma unroll
        for (int e = 0; e < 8; ++e) {
          const float ang = pos * invf[i0 + e];
          double rev = (double)ang * 0.15915494309189535;
          rev -= floor(rev);
          const float rf = (float)rev;
          const float sn = __builtin_amdgcn_sinf(rf), cs = __builtin_amdgcn_cosf(rf);
          const float a1 = valid ? q1f[e] : 0.f, a2 = valid ? q2f[e] : 0.f;
          const float b1 = valid ? k1f[e] : 0.f, b2 = valid ? k2f[e] : 0.f;
          o1[e] = a1 * cs - a2 * sn;
          o2[e] = a1 * sn + a2 * cs;
          p1[e] = (b1 * cs - b2 * sn) * 0.125f;
          p2[e] = (b1 * sn + b2 * cs) * 0.125f;
          KT[tsw(i0 + e, t)] = (u16)f2bf(p1[e] * ed);
          KT[tsw(32 + i0 + e, t)] = (u16)f2bf(p2[e] * ed);
        }
        *(uint4*)(QA + t * LDT + i0) = pack8(o1);
        *(uint4*)(QA + t * LDT + 32 + i0) = pack8(o2);
        *(uint4*)(KB + t * LDT + i0) = pack8(p1);
        *(uint4*)(KB + t * LDT + 32 + i0) = pack8(p2);
      }
#pragma unroll
      for (int it = 0; it < 4; ++it) {
        const int id = tid + 256 * it;
        const int t = id >> 4, j0 = (id & 15) * 8;
        uint4 v4 = Rv[it];
        if (t >= nvalid) v4 = make_uint4(0, 0, 0, 0);
        VT[tsw(j0 + 0, t)] = (u16)(v4.x & 0xffffu); VT[tsw(j0 + 1, t)] = (u16)(v4.x >> 16);
        VT[tsw(j0 + 2, t)] = (u16)(v4.y & 0xffffu); VT[tsw(j0 + 3, t)] = (u16)(v4.y >> 16);
        VT[tsw(j0 + 4, t)] = (u16)(v4.z & 0xffffu); VT[tsw(j0 + 5, t)] = (u16)(v4.z >> 16);
        VT[tsw(j0 + 6, t)] = (u16)(v4.w & 0xffffu); VT[tsw(j0 + 7, t)] = (u16)(v4.w >> 16);
      }
      if (tid < 64) {
        Gsc[tid] = lg * (float)min(tid + 1, nvalid);
        dec[tid] = __expf(lg * (float)nvalid);
      }
    }
    if (BR == 1) {
      if (w == 0) {
        float dt = 0.f, g = 0.f;
        if (lane < nvalid) {
          dt = softplus_f(dtraw + dtb);
          g = dt * aneg;
        }
        float x = g;
#pragma unroll
        for (int o = 1; o < 64; o <<= 1) {
          float y = __shfl_up(x, o);
          if (lane >= o) x += y;
        }
        const float ge = __shfl(x, 63);
        Gsc[lane] = x; dtv[lane] = dt; dec[lane] = __expf(ge); psum[lane] = __expf(ge - x);
      }
      __syncthreads();
      if (act) {
        const bool first = (c0 == 0 && ts == 0);
        const float* cst = P.in[4] + (size_t)(l * 128 + b) * 3 * 768 + chan;
#pragma unroll
        for (int p = 0; p < 4; ++p) {
          float x0[11], x1[11];
#pragma unroll
          for (int k = 0; k < 11; ++k) {
            const unsigned wd = p == 0 ? Rx[k].x : (p == 1 ? Rx[k].y : (p == 2 ? Rx[k].z : Rx[k].w));
            x0[k] = __uint_as_float(wd << 16);
            x1[k] = __uint_as_float(wd & 0xffff0000u);
          }
          if (first) {
#pragma unroll
            for (int k = 0; k < 3; ++k) {
              const float2 sv = *(const float2*)(cst + k * 768 + 2 * p);
              x0[k] = sample ? sv.x : 0.f;
              x1[k] = sample ? sv.y : 0.f;
            }
          }
          float o0[8], o1[8];
#pragma unroll
          for (int tt = 0; tt < 8; ++tt) {
            const bool valid = (ts * 8 + tt) < nvalid;
            float a0 = cbv[2 * p], a1 = cbv[2 * p + 1];
#pragma unroll
            for (int i = 0; i < 4; ++i) { a0 += cwv[i][2 * p] * x0[tt + i]; a1 += cwv[i][2 * p + 1] * x1[tt + i]; }
            o0[tt] = valid ? silu_f(a0) : 0.f;
            o1[tt] = valid ? silu_f(a1) : 0.f;
          }
          u16* rowdst = seg == 0 ? XH : (seg == 1 ? KB : QA);
#pragma unroll
          for (int tt = 0; tt < 8; ++tt) *(unsigned*)(rowdst + (ts * 8 + tt) * LDT + c8 + 2 * p) = pack2(o0[tt], o1[tt]);
          if (seg < 2) {
            const float* sc = seg == 0 ? dtv : psum;
            u16* cdst = seg == 0 ? VT : KT;
            float c0v[8], c1v[8];
#pragma unroll
            for (int tt = 0; tt < 8; ++tt) { const float f = sc[ts * 8 + tt]; c0v[tt] = o0[tt] * f; c1v[tt] = o1[tt] * f; }
            *(uint4*)(cdst + tsw(c8 + 2 * p, ts * 8)) = pack8(c0v);
            *(uint4*)(cdst + tsw(c8 + 2 * p + 1, ts * 8)) = pack8(c1v);
          }
          __builtin_amdgcn_sched_barrier(0);
        }
      }
    }
    __syncthreads();
    if (c0 + 64 < T) { REC_LOAD(c0 + 64, RgN) }

#pragma unroll
    for (int nf = 0; nf < NFV; ++nf)
      *(uint2*)(ST + (nf * 16 + r) * LDT + 16 * w + q * 4) = make_uint2(pack2(S[nf][0], S[nf][1]), pack2(S[nf][2], S[nf][3]));

    bf16x8 aq[2];
    aq[0] = *(const bf16x8*)(QA + (16 * w + r) * LDT + q * 8);
    aq[1] = *(const bf16x8*)(QA + (16 * w + r) * LDT + 32 + q * 8);
    float gt[4];
#pragma unroll
    for (int e = 0; e < 4; ++e) gt[e] = Gsc[16 * w + q * 4 + e];
#pragma unroll
    for (int n = 0; n < 4; ++n) {
      f32x4 a = (f32x4){0.f, 0.f, 0.f, 0.f};
      if (n <= w) {
#pragma unroll
        for (int kk = 0; kk < 2; ++kk) {
          bf16x8 bk = *(const bf16x8*)(KB + (16 * n + r) * LDT + kk * 32 + q * 8);
          a = __builtin_amdgcn_mfma_f32_16x16x32_bf16(aq[kk], bk, a, 0, 0, 0);
        }
      }
      const int s = 16 * n + r;
      const float gs = Gsc[s];
#pragma unroll
      for (int e = 0; e < 4; ++e) {
        const int t = 16 * w + q * 4 + e;
        float v = (s <= t) ? a[e] * __expf(gt[e] - gs) : 0.f;
        ATT[t * LDT + s] = (u16)f2bf(v);
      }
    }
    __syncthreads();

    f32x4 O[NFV];
#pragma unroll
    for (int nf = 0; nf < NFV; ++nf) O[nf] = (f32x4){0.f, 0.f, 0.f, 0.f};
#pragma unroll
    for (int kk = 0; kk < 2; ++kk)
#pragma unroll
      for (int nf = 0; nf < NFV; ++nf) {
        bf16x8 bs = *(const bf16x8*)(ST + (nf * 16 + r) * LDT + kk * 32 + q * 8);
        O[nf] = __builtin_amdgcn_mfma_f32_16x16x32_bf16(aq[kk], bs, O[nf], 0, 0, 0);
      }
    if (BR != 0) {
#pragma unroll
      for (int e = 0; e < 4; ++e) {
        const float sc = __expf(gt[e]);
#pragma unroll
        for (int nf = 0; nf < NFV; ++nf) O[nf][e] *= sc;
      }
    }
    {
      float dc[4];
#pragma unroll
      for (int e = 0; e < 4; ++e) dc[e] = dec[16 * w + q * 4 + e];
#pragma unroll
      for (int nf = 0; nf < NFV; ++nf)
#pragma unroll
        for (int e = 0; e < 4; ++e) S[nf][e] *= dc[e];
    }
    int vtb[2], ktb[2];
    vtb[0] = r * LDT + ((q ^ (r >> 3)) << 3);
    vtb[1] = r * LDT + ((q ^ (2 + (r >> 3))) << 3);
    ktb[0] = tsw(16 * w + r, q * 8);
    ktb[1] = tsw(16 * w + r, 32 + q * 8);
#pragma unroll
    for (int kk = 0; kk < 2; ++kk) {
      bf16x8 at = *(const bf16x8*)(ATT + (16 * w + r) * LDT + kk * 32 + q * 8);
      bf16x8 ak = *(const bf16x8*)(KT + ktb[kk]);
#pragma unroll
      for (int nf = 0; nf < NFV; ++nf) {
        bf16x8 bv = *(const bf16x8*)(VT + vtb[nf & 1] + nf * 16 * LDT + ((kk ^ ((nf >> 1) & 1)) * 32));
        O[nf] = __builtin_amdgcn_mfma_f32_16x16x32_bf16(at, bv, O[nf], 0, 0, 0);
        S[nf] = __builtin_amdgcn_mfma_f32_16x16x32_bf16(ak, bv, S[nf], 0, 0, 0);
      }
    }
    __syncthreads();
#pragma unroll
    for (int nf = 0; nf < NFV; ++nf)
#pragma unroll
      for (int e = 0; e < 4; ++e) OST[(16 * w + q * 4 + e) * OLD + nf * 16 + r] = O[nf][e];
    __syncthreads();

#pragma unroll
    for (int it = 0; it < NEP; ++it) {
      const int id = tid + 256 * it;
      const int t = (DV == 128) ? (id >> 4) : (id >> 3);
      const int j0 = (DV == 128) ? (id & 15) * 8 : (id & 7) * 8;
      const bool valid = t < nvalid;
      const size_t row = (size_t)(row0 + c0 + t);
      float ov[8], gv[8], y[8];
      *(float4*)&ov[0] = *(const float4*)(OST + t * OLD + j0);
      *(float4*)&ov[4] = *(const float4*)(OST + t * OLD + j0 + 4);
      unpack8(Rg[it], gv);
      if (BR == 1) {
        float xh[8];
        unpack8(*(const uint4*)(XH + t * LDT + j0), xh);
        float ss = 0.f;
#pragma unroll
        for (int e = 0; e < 8; ++e) { y[e] = (ov[e] + dsk * xh[e]) * silu_f(gv[e]); ss += y[e] * y[e]; }
        ss += __shfl_xor(ss, 1); ss += __shfl_xor(ss, 2); ss += __shfl_xor(ss, 4);
        if (valid) {
          *(uint4*)(ybr + row * LDY + h * 64 + j0) = pack8(y);
          if ((tid & 7) == 0) ssq[row * 8 + h] = ss;
        }
      } else {
        float ss = 0.f;
#pragma unroll
        for (int e = 0; e < 8; ++e) ss += ov[e] * ov[e];
        ss += __shfl_xor(ss, 1); ss += __shfl_xor(ss, 2); ss += __shfl_xor(ss, 4); ss += __shfl_xor(ss, 8);
        const float rs = rsqrtf(ss * (1.f / 128.f) + 1e-6f);
        if (BR == 0) {
          const float* wn = P.in[12] + l * 128 + j0;
          const float4 w0 = *(const float4*)wn, w1 = *(const float4*)(wn + 4);
          const float wv[8] = {w0.x, w0.y, w0.z, w0.w, w1.x, w1.y, w1.z, w1.w};
#pragma unroll
          for (int e = 0; e < 8; ++e) y[e] = silu_f(gv[e]) * ov[e] * rs * wv[e];
        } else {
#pragma unroll
          for (int e = 0; e < 8; ++e) y[e] = silu_f(gv[e]) * ov[e] * rs;
        }
        if (valid) *(uint4*)(ybr + row * LDY + h * 128 + j0) = pack8(y);
      }
      __builtin_amdgcn_sched_barrier(0);
    }
#pragma unroll
    for (int it = 0; it < NEP; ++it) Rg[it] = RgN[it];
    __syncthreads();
  }
#undef REC_LOAD

  {
    float* so;
    if (sample) so = P.out + (BR == 0 ? O_SGS : (BR == 1 ? O_SSS : O_SRS)) + ((size_t)(l * 128 + b) * NH + h) * 64 * DV;
    else so = P.out + (BR == 0 ? O_SGP : (BR == 1 ? O_SSP : O_SRP)) + ((size_t)(l * 8 + b) * NH + h) * 64 * DV;
#pragma unroll
    for (int nf = 0; nf < NFV; ++nf)
#pragma unroll
      for (int e = 0; e < 4; ++e) so[(size_t)(16 * w + q * 4 + e) * DV + nf * 16 + r] = S[nf][e];
  }
}

#ifndef REC_ONLY
#define REC_ONLY -1
#endif
template <int BR>
__device__ __forceinline__ void rec_branch(const Params& P, int l, bool split, int wb, int nwb, int lb0, unsigned char* ldsb) {
  if (!(REC_ONLY < 0 || REC_ONLY == BR)) return;
  constexpr int NH = (BR == 1) ? 8 : 4;
  constexpr int nl = 8 * NH;
  const int end = nl + 128 * NH;
  int it, step;
  if (split) {
    const int bx = blockIdx.x;
    if (bx >= lb0 && bx < lb0 + nl) { it = bx - lb0; step = 1 << 20; }
    else if (bx >= 128) { it = nl + wb; step = nwb; }
    else { it = end; step = 1; }
  } else { it = blockIdx.x; step = gridDim.x; }
  for (; it < end; it += step) {
    const int sample = it >= nl;
    const int idx = sample ? it - nl : it;
    int ll = l;
    asm volatile("" : "+s"(ll));
    if (!sample) __builtin_amdgcn_s_setprio(2);
    rec_item<BR>(P, ll, idx / NH, idx % NH, sample, ldsb);
    if (!sample) __builtin_amdgcn_s_setprio(0);
  }
}

__device__ __forceinline__ void phase_rec(const Params& P, int l, unsigned char* ldsb) {
  const int G = gridDim.x;
  const u16* proj = (const u16*)(P.ws + WS_A);
  const bool split = (G >= 256);
  const int wb = split ? (int)blockIdx.x - 128 : (int)blockIdx.x;
  int nwb = split ? G - 128 : G;
  asm volatile("" : "+s"(nwb));
  if (wb >= 0) {
    for (int i = wb * 256 + otid(); i < (8 + 128) * 3 * 768; i += nwb * 256) {
      const bool pr = i < 8 * 3 * 768;
      const int j = pr ? i : i - 8 * 3 * 768;
      const int b = j / (3 * 768), rem = j - b * 3 * 768, rr = rem / 768, c = rem - rr * 768;
      const size_t row = pr ? (size_t)(b * TP + 2061 + rr) : (size_t)(MP + b * 4 + 1 + rr);
      const size_t oo = pr ? O_SCP + (size_t)l * 8 * 3 * 768 + j : O_SCS + (size_t)l * 128 * 3 * 768 + j;
      P.out[oo] = bf2f(proj[row * NPJ + 2064 + c]);
    }
  }
  rec_branch<0>(P, l, split, wb, nwb, 0, ldsb);
  rec_branch<1>(P, l, split, wb, nwb, 32, ldsb);
  rec_branch<2>(P, l, split, wb, nwb, 96, ldsb);
  if (wb >= 0) {
    __syncthreads();
    if (l == 0) {
      convert_layer(P, 0, ldsb, 1888, 4576, wb, nwb);
      convert_layer(P, 1, ldsb, 0, 2528, wb, nwb);
    } else {
      convert_layer(P, 1, ldsb, 2528, 4576, wb, nwb);
    }
    phase_gates(P, l, wb, nwb, ldsb);
  }
}


#define XB_TMO      128
#define XB_XCNT(j)  (256  + 64 * (j))
#define XB_XSUB(j)  (1280 + 64 * (j))
#define XB_XGEN(j)  (2304 + 64 * (j))
#define XB_TOP      3328
#define XB_TOPGEN   3392
#define XCD_BAR_WORDS 3456
#define XB_SPIN_CAP (1u << 22)
__device__ __forceinline__ unsigned xb_ld(unsigned* p) { return __hip_atomic_load(p, __ATOMIC_RELAXED, __HIP_MEMORY_SCOPE_AGENT); }
__device__ __forceinline__ unsigned xb_add(unsigned* p, unsigned v) { return __hip_atomic_fetch_add(p, v, __ATOMIC_RELAXED, __HIP_MEMORY_SCOPE_AGENT); }
__device__ __forceinline__ unsigned xb_xcc_id() { return (unsigned)__builtin_amdgcn_s_getreg((3 << 11) | 20) & 0xFu; }
#define XB_SPIN(cond, bar) do { unsigned _sp = 0; while (cond) { __builtin_amdgcn_s_sleep(1); \
    if ((++_sp & 255u) == 0u) { if (xb_ld(&(bar)[XB_TMO])) break; if (_sp > XB_SPIN_CAP) { atomicAdd(&(bar)[XB_TMO], 1u); break; } } } } while (0)
struct XcdBarrier { unsigned* bar; unsigned x; volatile LAS unsigned* st; };
__device__ __forceinline__ XcdBarrier xcd_barrier_post(unsigned* bar, volatile LAS unsigned* st) {
  XcdBarrier b; b.bar = bar; b.x = xb_xcc_id(); b.st = st;
  if (threadIdx.x == 0) (void)xb_add(&bar[XB_XCNT(b.x)], 1u);
  return b;
}
__device__ __forceinline__ void xcd_barrier_complete(unsigned* bar, unsigned x, unsigned& nloc, unsigned& nx) {
  const unsigned G = gridDim.x * gridDim.y * gridDim.z;
  unsigned sum, cnt, mine, sp = 0u;
  for (;;) {
    sum = 0u; cnt = 0u; mine = 0u;
#pragma unroll
    for (unsigned j = 0; j < 16; ++j) { const unsigned c = xb_ld(&bar[XB_XCNT(j)]); sum += c; cnt += (c > 0u) ? 1u : 0u; mine = (j == x) ? c : mine; }
    if (sum == G) break;
    __builtin_amdgcn_s_sleep(1);
    if ((++sp & 255u) == 0u) { if (xb_ld(&bar[XB_TMO])) break; if (sp > XB_SPIN_CAP) { atomicAdd(&bar[XB_TMO], 1u); break; } }
  }
  nloc = mine > 0u ? mine : 1u; nx = cnt > 0u ? cnt : 1u;
}
__device__ __forceinline__ void xcd_barrier(const XcdBarrier& b) {
  asm volatile("s_waitcnt vmcnt(0)" ::: "memory");
  __syncthreads();
  if (threadIdx.x == 0) {
    unsigned* bar = b.bar;
    __builtin_amdgcn_s_waitcnt(0);
    unsigned nloc = b.st[0], nx = b.st[1];
    if (nloc == 0u) { xcd_barrier_complete(bar, b.x, nloc, nx); b.st[0] = nloc; b.st[1] = nx; }
    const unsigned old = xb_add(&bar[XB_XSUB(b.x)], 1u);
    const unsigned gen = old / nloc;
    if (old + 1u == (gen + 1u) * nloc) {
      __builtin_amdgcn_fence(__ATOMIC_RELEASE, "agent");
      asm volatile("s_waitcnt vmcnt(0)" ::: "memory");
      const unsigned og = xb_add(&bar[XB_TOP], 1u);
      const unsigned tg = og / nx;
      if (og + 1u == (tg + 1u) * nx) xb_add(&bar[XB_TOPGEN], 1u);
      else XB_SPIN(xb_ld(&bar[XB_TOPGEN]) == tg, bar);
      __builtin_amdgcn_fence(__ATOMIC_ACQUIRE, "agent");
      xb_add(&bar[XB_XGEN(b.x)], 1u);
      asm volatile("s_waitcnt vmcnt(0)" ::: "memory");
    } else {
      XB_SPIN(xb_ld(&bar[XB_XGEN(b.x)]) == gen, bar);
      __builtin_amdgcn_fence(__ATOMIC_ACQUIRE, "agent");
      asm volatile("s_waitcnt vmcnt(0)" ::: "memory");
    }
  }
  __syncthreads();
}

__global__ void __launch_bounds__(256, 2) fwd_kernel(Params P, int ph_lo, int ph_hi) {
  extern __shared__ __attribute__((aligned(16))) unsigned char ldsb[];
  cg::grid_group grid = cg::this_grid();
  volatile LAS unsigned* xst = (volatile LAS unsigned*)(ldsb + 75904);
  if (threadIdx.x == 0) { xst[0] = 0u; xst[1] = 0u; xst[2] = 0u; xst[3] = 0u; }
  __syncthreads();
  XcdBarrier xb = xcd_barrier_post((unsigned*)(P.ws + WS_BAR), xst);
  if (ph_hi > 1000) grid.sync();
  for (int ph = ph_lo; ph < ph_hi; ++ph) {
    if (ph > ph_lo) xcd_barrier(xb);
    if (ph == 0) {
      if (PH_ON(0)) { convert_layer(P, 0, ldsb, 0, 1888, blockIdx.x, gridDim.x); ln_phase(P, 0, 0); }
      continue;
    }
    int phl = ph;
    asm volatile("" : "+s"(phl));
    const int l = (phl - 1) >> 3, s = (phl - 1) & 7;
    switch (s) {
      case 0: if (PH_ON(1)) { phase_proj(P, l, ldsb); if (DUP(1)) phase_proj(P, l, ldsb); } break;
      case 1: if (PH_ON(2)) { phase_rec(P, l, ldsb); if (DUP(2)) { __syncthreads(); phase_rec(P, l, ldsb); } } break;
      case 2: if (PH_ON(3)) { phase_merge(P, l, ldsb); if (DUP(3)) phase_merge(P, l, ldsb); } break;
      case 3: if (PH_ON(4)) { phase_resid(P, 0, l, ldsb); if (DUP(4)) phase_resid(P, 0, l, ldsb); } break;
      case 4: if (PH_ON(5)) { ln_phase(P, 1, l); if (DUP(5)) ln_phase(P, 1, l); } break;
      case 5: if (PH_ON(6)) { phase_ff1(P, l, ldsb); if (DUP(6)) phase_ff1(P, l, ldsb); } break;
      case 6: if (PH_ON(7)) { phase_resid(P, 1, l, ldsb); if (DUP(7)) phase_resid(P, 1, l, ldsb); } break;
      case 7:
        if (PH_ON(8)) { ln_phase(P, 2, l); }
        break;
    }
  }
}

extern "C" void kernel_launch(void* const* d_in, const int* in_sizes, int n_in, void* d_out, int out_size, void* d_ws,
                              size_t ws_size, hipStream_t stream) {
  static int grid_blocks = 0;
  if (grid_blocks == 0) {
    if (n_in != 31 || ws_size < WS_END || out_size != 44666880) {
      fprintf(stderr, "kernel_launch: unexpected problem (n_in %d, ws %zu, out %d)\n", n_in, ws_size, out_size);
      grid_blocks = -1;
      return;
    }
    int dev = 0, cus = 0, per_cu = 0;
    hipGetDevice(&dev);
    hipDeviceGetAttribute(&cus, hipDeviceAttributeMultiprocessorCount, dev);
    hipFuncSetAttribute((const void*)fwd_kernel, hipFuncAttributeMaxDynamicSharedMemorySize, LDS_BYTES);
    hipOccupancyMaxActiveBlocksPerMultiprocessor(&per_cu, (const void*)fwd_kernel, 256, LDS_BYTES);
    if (per_cu < 1) { fprintf(stderr, "kernel_launch: occupancy query says 0 blocks per CU\n"); grid_blocks = -1; return; }
    if (per_cu > 2) per_cu = 2;
    grid_blocks = cus * per_cu;
    grid_blocks -= grid_blocks % 8;
  }
  if (grid_blocks < 0) return;
  Params p{};
  for (int i = 0; i < 31; ++i) p.in[i] = (const float*)d_in[i];
  p.out = (float*)d_out;
  p.ws = (unsigned char*)d_ws;
  if (hipMemsetAsync((char*)d_ws + WS_BAR, 0, XCD_BAR_WORDS * 4, stream) != hipSuccess) { fprintf(stderr, "memset failed\n"); return; }
#if ONE_LAUNCH
  int lo = 0, hi = NPHASE;
  void* args[] = {&p, &lo, &hi};
  hipError_t e = hipLaunchCooperativeKernel((const void*)fwd_kernel, dim3(grid_blocks), dim3(256), args, LDS_BYTES, stream);
  if (e != hipSuccess) fprintf(stderr, "cooperative launch failed: %s (grid %d)\n", hipGetErrorString(e), grid_blocks);
#else
  for (int ph = 0; ph < NPHASE; ++ph) {
    hipLaunchKernelGGL(fwd_kernel, dim3(grid_blocks), dim3(256), LDS_BYTES, stream, p, ph, ph + 1);
  }
#endif
}
```

```cpp
#include <hip/hip_runtime.h>
#include <hip/hip_cooperative_groups.h>
#include <stdint.h>
#include <stdio.h>
namespace cg = cooperative_groups;

#ifndef ONE_LAUNCH
#define ONE_LAUNCH 1
#endif
#ifndef PHASE_ONLY
#define PHASE_ONLY -1
#endif
#define PH_ON(n) (PHASE_ONLY < 0 || PHASE_ONLY == (n))
#ifndef DUP_MASK
#define DUP_MASK 0
#endif
#define DUP(n) ((DUP_MASK >> (n)) & 1)

#define LAS __attribute__((address_space(3)))
typedef unsigned short u16;
typedef __attribute__((ext_vector_type(8))) short bf16x8;
typedef __attribute__((ext_vector_type(4))) float f32x4;

constexpr int D = 1024;
constexpr int TP = 2064;
constexpr int MP = 8 * TP;
constexpr int MS = 512;
constexpr int M = MP + MS;
constexpr int NPJ = 4376;
constexpr int LDT = 72;
constexpr float ALPHA = 1.4142135623730951f;
constexpr int NPHASE = 17;
constexpr int SPLIT_ROW0 = 128 * 128;

constexpr int LDA = 1088;
constexpr int LDY = 576;
constexpr int LDH = 4160;
constexpr size_t WS_WIN = 0;
constexpr size_t WS_WGATE = 9748480;
constexpr size_t WS_WOUT = 16433152;
constexpr size_t WS_WO = 19972096;
constexpr size_t WS_WFF1 = 22200320;
constexpr size_t WS_WFF2 = 31113216;
constexpr size_t WS_ACT = 39632896;
constexpr size_t WS_SSQ = 76677120;
constexpr size_t WS_A = 77221888;
constexpr size_t WS_B = 226215936;
constexpr size_t WS_BAR = 295946240;
constexpr size_t WS_W2 = WS_BAR + 16384;
constexpr size_t WS_G1X = WS_W2 + 22200320;
constexpr size_t WS_END = WS_G1X + 524288;
constexpr int G1_SPLIT = 16768;
constexpr size_t A_PRE = 37044224;

constexpr size_t O_YP = 0, O_YS = 16777216, O_SGP = 17301504, O_SGS = 17825792, O_SSP = 26214400, O_SSS = 26738688,
                 O_SCP = 35127296, O_SCS = 35164160, O_SRP = 35753984, O_SRS = 36278272;

constexpr int LDS_BYTES = 76032;

struct Params { const float* in[31]; float* out; unsigned char* ws; };

__device__ __forceinline__ unsigned f2bf(float f) {
  unsigned u = __float_as_uint(f);
  u += 0x7fffu + ((u >> 16) & 1u);
  return u >> 16;
}
__device__ __forceinline__ float bf2f(u16 h) { return __uint_as_float(((unsigned)h) << 16); }
__device__ __forceinline__ unsigned pack2(float a, float b) { return f2bf(a) | (f2bf(b) << 16); }
__device__ __forceinline__ void unpack8(uint4 v, float (&f)[8]) {
  f[0] = __uint_as_float(v.x << 16); f[1] = __uint_as_float(v.x & 0xffff0000u);
  f[2] = __uint_as_float(v.y << 16); f[3] = __uint_as_float(v.y & 0xffff0000u);
  f[4] = __uint_as_float(v.z << 16); f[5] = __uint_as_float(v.z & 0xffff0000u);
  f[6] = __uint_as_float(v.w << 16); f[7] = __uint_as_float(v.w & 0xffff0000u);
}
__device__ __forceinline__ uint4 pack8(const float (&f)[8]) {
  return make_uint4(pack2(f[0], f[1]), pack2(f[2], f[3]), pack2(f[4], f[5]), pack2(f[6], f[7]));
}
__device__ __forceinline__ int tsw(int row, int col) { return row * LDT + (col ^ (((row >> 3) & 7) << 3)); }
__device__ __forceinline__ int otid() { int t = threadIdx.x; asm volatile("" : "+v"(t)); return t; }
__device__ __forceinline__ float silu_f(float x) { return x / (1.f + __expf(-x)); }
__device__ __forceinline__ float sigmoid_f(float x) { return 1.f / (1.f + __expf(-x)); }
__device__ __forceinline__ float softplus_f(float x) { return fmaxf(x, 0.f) + log1pf(__expf(-fabsf(x))); }

__device__ __forceinline__ void conv_tile64(const float* __restrict__ src, int ld, int ldk, int ncol0, int nvalid, u16* __restrict__ dst,
                            int kt, int nt, const float* __restrict__ kscale, float* tile, int blocked_nkt = 0) {
  const int tid = otid();
  const int c = tid & 63, r4 = tid >> 6;
  const int n = nt * 64 + c;
  const bool ok = n < nvalid;
#pragma unroll
  for (int i = 0; i < 16; ++i) {
    int k = r4 + 4 * i;
    int kg = kt * 64 + k;
    float v = ok ? src[(size_t)kg * ld + ncol0 + n] : 0.f;
    if (kscale) v *= kscale[kg];
    tile[k * 65 + c] = v;
  }
  __syncthreads();
#pragma unroll
  for (int it = 0; it < 2; ++it) {
    int id = tid + 256 * it;
    int nn = id >> 3, kc = id & 7;
    unsigned w0 = pack2(tile[(kc * 8 + 0) * 65 + nn], tile[(kc * 8 + 1) * 65 + nn]);
    unsigned w1 = pack2(tile[(kc * 8 + 2) * 65 + nn], tile[(kc * 8 + 3) * 65 + nn]);
    unsigned w2 = pack2(tile[(kc * 8 + 4) * 65 + nn], tile[(kc * 8 + 5) * 65 + nn]);
    unsigned w3 = pack2(tile[(kc * 8 + 6) * 65 + nn], tile[(kc * 8 + 7) * 65 + nn]);
    const int n_ = nt * 64 + nn;
    const size_t di = blocked_nkt ? ((size_t)((n_ >> 7) * blocked_nkt + kt) * 8192 + (n_ & 127) * 64 + kc * 8)
                                  : ((size_t)n_ * ldk + kt * 64 + kc * 8);
    *(uint4*)(dst + di) = make_uint4(w0, w1, w2, w3);
  }
  __syncthreads();
}

__device__ __forceinline__ void convert_layer(const Params& P, int l, unsigned char* lds, int t_lo, int t_hi, int wb, int nwb) {
  float* tile = (float*)lds;
  unsigned char* ws = P.ws;
  const size_t wsel = (l == 0) ? 0 : WS_W2;
  for (int t = t_lo + wb; t < t_hi; t += nwb) {
    int idx = t;
    if (idx < 1120) {
      conv_tile64(P.in[9] + (size_t)l * 1024 * 7448, 7448, LDA, 0, NPJ, (u16*)(ws + wsel + WS_WIN), idx % 16, idx / 16, nullptr, tile);
      continue;
    }
    idx -= 1120;
    if (idx < 768) {
      conv_tile64(P.in[9] + (size_t)l * 1024 * 7448, 7448, LDA, NPJ, 3072, (u16*)(ws + wsel + WS_WGATE), idx % 16, idx / 16, nullptr, tile);
      continue;
    }
    idx -= 768;
    if (idx < 384) {
      int br = idx / 128, r = idx % 128;
      conv_tile64(P.in[19 + br] + (size_t)l * 512 * 1024, 1024, LDY, 0, 1024, (u16*)(ws + wsel + WS_WOUT) + (size_t)br * 1024 * LDY,
                  r % 8, r / 8, br == 1 ? P.in[18] + l * 512 : nullptr, tile);
      continue;
    }
    idx -= 384;
    if (idx < 256) {
      conv_tile64(P.in[22] + (size_t)l * 1024 * 1024, 1024, LDA, 0, 1024, (u16*)(ws + wsel + WS_WO), idx % 16, idx / 16, nullptr, tile);
      continue;
    }
    idx -= 256;
    if (idx < 1024) {
      conv_tile64(P.in[25] + (size_t)l * 1024 * 4096, 4096, LDA, 0, 4096, (u16*)(ws + WS_WFF1), idx % 16, idx / 16, nullptr, tile);
      continue;
    }
    idx -= 1024;
    conv_tile64(P.in[27] + (size_t)l * 4096 * 1024, 1024, LDH, 0, 1024, (u16*)(ws + WS_WFF2), idx % 64, idx / 64, nullptr, tile, 64);
  }
}

__device__ __forceinline__ void ln_phase(const Params& P, int mode, int l) {
  const int tid_ = otid();
  const int lane = tid_ & 63;
  const int gw = blockIdx.x * 4 + (tid_ >> 6);
  const int nw = gridDim.x * 4;
  const float* wv = mode == 0 ? P.in[7] : (mode == 1 ? P.in[23] + l * D : P.in[29] + l * D);
  const float* bv = mode == 0 ? P.in[8] : (mode == 1 ? P.in[24] + l * D : P.in[30] + l * D);
  u16* act = (u16*)(P.ws + WS_ACT);
  const bool final_out = (mode == 2 && l == 1);
  for (int row = gw; row < M; row += nw) {
    const float* s;
    int b = 0, t = 0;
    if (row < MP) { b = row / TP; t = row - b * TP; }
    if (mode == 0) {
      if (row < MP) s = (t < 16) ? P.in[6] + (size_t)t * D : P.in[0] + ((size_t)b * 2048 + (t - 16)) * D;
      else s = P.in[1] + (size_t)(row - MP) * D;
    } else if (mode == 1) {
      s = (const float*)(P.ws + WS_A + A_PRE) + (size_t)row * D;
    } else {
      s = (const float*)(P.ws + WS_B) + (size_t)row * D;
    }
    float4 v[4];
#pragma unroll
    for (int i = 0; i < 4; ++i) v[i] = *(const float4*)(s + i * 256 + lane * 4);
    float sum = 0.f;
#pragma unroll
    for (int i = 0; i < 4; ++i) sum += v[i].x + v[i].y + v[i].z + v[i].w;
#pragma unroll
    for (int o = 32; o >= 1; o >>= 1) sum += __shfl_xor(sum, o);
    const float mean = sum * (1.f / 1024.f);
    float sq = 0.f;
#pragma unroll
    for (int i = 0; i < 4; ++i) {
      v[i].x -= mean; v[i].y -= mean; v[i].z -= mean; v[i].w -= mean;
      sq += v[i].x * v[i].x + v[i].y * v[i].y + v[i].z * v[i].z + v[i].w * v[i].w;
    }
#pragma unroll
    for (int o = 32; o >= 1; o >>= 1) sq += __shfl_xor(sq, o);
    const float rstd = rsqrtf(sq * (1.f / 1024.f) + 1e-5f);
    float* od = nullptr;
    if (final_out) {
      if (row < MP) { if (t >= 16) od = P.out + O_YP + ((size_t)b * 2048 + (t - 16)) * D; }
      else od = P.out + O_YS + (size_t)(row - MP) * D;
    }
#pragma unroll
    for (int i = 0; i < 4; ++i) {
      const int c = i * 256 + lane * 4;
      float4 w4 = *(const float4*)(wv + c), b4 = *(const float4*)(bv + c);
      float y0 = v[i].x * rstd * w4.x + b4.x, y1 = v[i].y * rstd * w4.y + b4.y;
      float y2 = v[i].z * rstd * w4.z + b4.z, y3 = v[i].w * rstd * w4.w + b4.w;
      if (final_out) {
        if (od) *(float4*)(od + c) = make_float4(y0, y1, y2, y3);
      } else {
        const unsigned p0 = pack2(y0, y1), p1 = pack2(y2, y3);
        *(uint2*)(act + (size_t)row * LDA + c) = make_uint2(p0, p1);
        if (mode == 1 && row >= SPLIT_ROW0) {
          const float4 bb = *(const float4*)(P.in[28] + l * D + c);
          float* pz = (float*)(P.ws + WS_B) + (size_t)row * D + c;
          *(float4*)pz = make_float4(ALPHA * __uint_as_float(p0 << 16) + bb.x, ALPHA * __uint_as_float(p0 & 0xffff0000u) + bb.y,
                                     ALPHA * __uint_as_float(p1 << 16) + bb.z, ALPHA * __uint_as_float(p1 & 0xffff0000u) + bb.w);
        }
      }
    }
  }
}

#define G_LOAD4(R, k0)                                                                    \
  R##a0 = *(const uint4*)(ap + (k0)); R##a1 = *(const uint4*)(ap + sa + (k0));            \
  R##a2 = *(const uint4*)(ap + 2 * sa + (k0)); R##a3 = *(const uint4*)(ap + 3 * sa + (k0)); \
  R##b0 = *(const uint4*)(bp + (k0)); R##b1 = *(const uint4*)(bp + sb + (k0));
#define G_LOADB(R, k0)                                                                    \
  R##b2 = *(const uint4*)(bp + 2 * sb + (k0)); R##b3 = *(const uint4*)(bp + 3 * sb + (k0));
#define L_STORE4(R, buf)                                                                  \
  { u16* ad = As + (buf) * 128 * LDT + crow * LDT + cck;                                  \
    u16* bd = Bs + (buf) * BN * LDT + crow * LDT + cck;                                   \
    *(uint4*)(ad) = R##a0; *(uint4*)(ad + 32 * LDT) = R##a1; *(uint4*)(ad + 64 * LDT) = R##a2; *(uint4*)(ad + 96 * LDT) = R##a3; \
    *(uint4*)(bd) = R##b0; *(uint4*)(bd + 32 * LDT) = R##b1;                              \
    if (NF == 4) { *(uint4*)(bd + 64 * LDT) = R##b2; *(uint4*)(bd + 96 * LDT) = R##b3; } }
#define MMA_TILE(buf)                                                                     \
  { const u16* as = As + (buf) * 128 * LDT + (wm * 64 + r) * LDT + q * 8;                 \
    const u16* bs = Bs + (buf) * BN * LDT + (wn * NF * 16 + r) * LDT + q * 8;             \
    _Pragma("unroll") for (int kk = 0; kk < 2; ++kk) {                                    \
      bf16x8 af[4], bfr[NF];                                                              \
      _Pragma("unroll") for (int mf = 0; mf < 4; ++mf) af[mf] = *(const bf16x8*)(as + mf * 16 * LDT + kk * 32); \
      _Pragma("unroll") for (int nf = 0; nf < NF; ++nf) bfr[nf] = *(const bf16x8*)(bs + nf * 16 * LDT + kk * 32); \
      _Pragma("unroll") for (int mf = 0; mf < 4; ++mf)                                    \
        _Pragma("unroll") for (int nf = 0; nf < NF; ++nf)                                 \
          acc[mf][nf] = __builtin_amdgcn_mfma_f32_16x16x32_bf16(af[mf], bfr[nf], acc[mf][nf], 0, 0, 0); \
    } }

__device__ __forceinline__ int lds_byte(int r, int c) {
  int st = (r >> 4) * 2 + (c >> 5), rr = r & 15, cc = c & 31, ob = rr * 64 + cc * 2;
  return st * 1024 + (ob ^ (((ob >> 9) & 1) << 5));
}
__device__ __forceinline__ void stage_rc(int b, int& R, int& C) {
  int st = b >> 10, sb = b & 1023, swz = sb ^ (((sb >> 9) & 1) << 5);
  R = (st >> 1) * 16 + (swz >> 6);
  C = (st & 1) * 32 + ((swz & 63) >> 1);
}

template <int NF>
__device__ __forceinline__ void gemm_core(f32x4 (&acc)[4][NF], const u16* __restrict__ A, int lda,
                                          const u16* __restrict__ B, int ldb, int K, u16* lds, int kadv = 64) {
  constexpr int BN = 32 * NF;
  constexpr int ABYTES = 128 * 64 * 2;
  constexpr int BBYTES = BN * 64 * 2;
  constexpr int BUF = ABYTES + BBYTES;
  unsigned char* base = (unsigned char*)lds;
  const int tid = otid(), lane = tid & 63, w = tid >> 6, wm = w >> 1, wn = w & 1, r = lane & 15, q = lane >> 4;
  const u16* ga[4]; const u16* gb[NF];
#pragma unroll
  for (int i = 0; i < 4; ++i) { int R, C; stage_rc(tid * 16 + i * 4096, R, C); ga[i] = A + (size_t)R * lda + C; }
#pragma unroll
  for (int i = 0; i < NF; ++i) { int R, C; stage_rc(tid * 16 + i * 4096, R, C); gb[i] = B + (size_t)R * ldb + C; }
  int oa[4][2], ob[NF][2];
#pragma unroll
  for (int mf = 0; mf < 4; ++mf)
#pragma unroll
    for (int kk = 0; kk < 2; ++kk) oa[mf][kk] = lds_byte(wm * 64 + mf * 16 + r, kk * 32 + q * 8);
#pragma unroll
  for (int nf = 0; nf < NF; ++nf)
#pragma unroll
    for (int kk = 0; kk < 2; ++kk) ob[nf][kk] = lds_byte(wn * NF * 16 + nf * 16 + r, kk * 32 + q * 8);
#define STAGE_TILE(buf, k0)                                                                              \
  {                                                                                                      \
    _Pragma("unroll") for (int i = 0; i < 4; ++i)                                                        \
      __builtin_amdgcn_global_load_lds((const unsigned*)(ga[i] + (k0)),                                  \
        (LAS unsigned*)(base + (buf) * BUF + tid * 16 + i * 4096), 16, 0, 0);                            \
    _Pragma("unroll") for (int i = 0; i < NF; ++i)                                                       \
      __builtin_amdgcn_global_load_lds((const unsigned*)(gb[i] + (k0)),                                  \
        (LAS unsigned*)(base + (buf) * BUF + ABYTES + tid * 16 + i * 4096), 16, 0, 0);                   \
  }
  const int nk = K >> 6;
  STAGE_TILE(0, 0)
  asm volatile("s_waitcnt vmcnt(0)" ::: "memory");
  __syncthreads();
  for (int kt = 0; kt < nk; ++kt) {
    const int buf = kt & 1;
    if (kt + 1 < nk) STAGE_TILE(buf ^ 1, (size_t)(kt + 1) * kadv)
    const unsigned char* as = base + buf * BUF;
    const unsigned char* bs = as + ABYTES;
    bf16x8 af0[4], bf0[NF], af1[4], bf1[NF];
#pragma unroll
    for (int mf = 0; mf < 4; ++mf) af0[mf] = *(const bf16x8*)(as + oa[mf][0]);
#pragma unroll
    for (int nf = 0; nf < NF; ++nf) bf0[nf] = *(const bf16x8*)(bs + ob[nf][0]);
    __builtin_amdgcn_s_setprio(1);
#pragma unroll
    for (int nf = 0; nf < NF / 2; ++nf)
#pragma unroll
      for (int mf = 0; mf < 4; ++mf)
        acc[mf][nf] = __builtin_amdgcn_mfma_f32_16x16x32_bf16(af0[mf], bf0[nf], acc[mf][nf], 0, 0, 0);
    __builtin_amdgcn_sched_barrier(0);
#pragma unroll
    for (int mf = 0; mf < 4; ++mf) af1[mf] = *(const bf16x8*)(as + oa[mf][1]);
#pragma unroll
    for (int nf = 0; nf < NF; ++nf) bf1[nf] = *(const bf16x8*)(bs + ob[nf][1]);
    __builtin_amdgcn_sched_barrier(0);
#pragma unroll
    for (int nf = NF / 2; nf < NF; ++nf)
#pragma unroll
      for (int mf = 0; mf < 4; ++mf)
        acc[mf][nf] = __builtin_amdgcn_mfma_f32_16x16x32_bf16(af0[mf], bf0[nf], acc[mf][nf], 0, 0, 0);
#pragma unroll
    for (int nf = 0; nf < NF; ++nf)
#pragma unroll
      for (int mf = 0; mf < 4; ++mf)
        acc[mf][nf] = __builtin_amdgcn_mfma_f32_16x16x32_bf16(af1[mf], bf1[nf], acc[mf][nf], 0, 0, 0);
    __builtin_amdgcn_s_setprio(0);
    asm volatile("s_waitcnt vmcnt(0)" ::: "memory");
    __syncthreads();
  }
#undef STAGE_TILE
}

#define TILE_LOOP(total)                                                                      \
  const int _nx = (gridDim.x % 8 == 0) ? 8 : 1;                                              \
  const int _ns = gridDim.x / _nx;                                                           \
  const int _x = blockIdx.x % _nx, _s = blockIdx.x / _nx;                                    \
  const int _per = ((total) + _nx - 1) / _nx;                                                \
  const int _lo = _x * _per;                                                                 \
  const int _hi = min((total), _lo + _per);                                                  \
  for (int t = _lo + _s; t < _hi; t += _ns)

__device__ __forceinline__ void tile_decode(int t, int MT, int NT, int& mt, int& nt) {
  int g = t / (8 * NT), r = t - g * 8 * NT;
  int gs = min(8, MT - g * 8);
  mt = g * 8 + r % gs;
  nt = r / gs;
}

template <int NF>
__device__ __forceinline__ void zero_acc(f32x4 (&acc)[4][NF]) {
#pragma unroll
  for (int i = 0; i < 4; ++i)
#pragma unroll
    for (int j = 0; j < NF; ++j) acc[i][j] = (f32x4){0.f, 0.f, 0.f, 0.f};
}

__device__ __forceinline__ void phase_proj(const Params& P, int l, unsigned char* ldsb) {
  const u16* act = (const u16*)(P.ws + WS_ACT);
  const u16* W = (const u16*)(P.ws + (l == 0 ? 0 : WS_W2) + WS_WIN);
  u16* proj = (u16*)(P.ws + WS_A);
  constexpr int MT = 133, NT = 35;
  TILE_LOOP(MT * NT) {
    int mt, nt; tile_decode(t, MT, NT, mt, nt);
    const int tid_ = otid(), lane = tid_ & 63, w = tid_ >> 6, wm = w >> 1, wn = w & 1, r = lane & 15, q = lane >> 4;
    f32x4 acc[4][4]; zero_acc<4>(acc);
    gemm_core<4>(acc, act + (size_t)mt * 128 * LDA, LDA, W + (size_t)nt * 128 * LDA, LDA, D, (u16*)ldsb);
#pragma unroll
    for (int mf = 0; mf < 4; ++mf)
#pragma unroll
      for (int nf = 0; nf < 4; ++nf) {
        const int col = nt * 128 + wn * 64 + nf * 16 + r;
        if (col < NPJ) {
#pragma unroll
          for (int e = 0; e < 4; ++e) {
            const int row = mt * 128 + wm * 64 + mf * 16 + q * 4 + e;
            proj[(size_t)row * NPJ + col] = (u16)f2bf(acc[mf][nf][e]);
          }
        }
      }
  }
}

__device__ __forceinline__ u16* gate_row(const Params& P, int br, int row) {
  if (br == 0) return (u16*)P.out + (size_t)row * D;
  if (row < G1_SPLIT) return (u16*)P.out + (size_t)M * D + (size_t)row * D;
  return (u16*)(P.ws + WS_G1X) + (size_t)(row - G1_SPLIT) * D;
}

__device__ __forceinline__ void phase_gates(const Params& P, int l, int wb, int nwb, unsigned char* ldsb) {
  const u16* act = (const u16*)(P.ws + WS_ACT);
  const u16* Wg = (const u16*)(P.ws + (l == 0 ? 0 : WS_W2) + WS_WGATE);
  constexpr int MT = 133, NT = 8;
  for (int t = wb; t < 2 * MT * NT; t += nwb) {
    const int br = t / (MT * NT);
    int mt, nt; tile_decode(t - br * MT * NT, MT, NT, mt, nt);
    const int tid_ = otid(), lane = tid_ & 63, w = tid_ >> 6, wm = w >> 1, wn = w & 1, r = lane & 15, q = lane >> 4;
    f32x4 acc[4][4]; zero_acc<4>(acc);
    gemm_core<4>(acc, act + (size_t)mt * 128 * LDA, LDA, Wg + ((size_t)br * 1024 + nt * 128) * LDA, LDA, D, (u16*)ldsb);
#pragma unroll
    for (int mf = 0; mf < 4; ++mf)
#pragma unroll
      for (int e = 0; e < 4; ++e) {
        const int row = mt * 128 + wm * 64 + mf * 16 + q * 4 + e;
        u16* gr = gate_row(P, br, row);
#pragma unroll
        for (int nf = 0; nf < 4; ++nf) gr[nt * 128 + wn * 64 + nf * 16 + r] = (u16)f2bf(sigmoid_f(acc[mf][nf][e]));
      }
  }
}

__device__ __forceinline__ void phase_merge(const Params& P, int l, unsigned char* ldsb) {
  const u16* act = (const u16*)(P.ws + WS_ACT);
  const u16* Wg = (const u16*)(P.ws + (l == 0 ? 0 : WS_W2) + WS_WGATE);
  const u16* Wo = (const u16*)(P.ws + (l == 0 ? 0 : WS_W2) + WS_WOUT);
  const u16* ybr = (const u16*)(P.ws + WS_B);
  const float* ssq = (const float*)(P.ws + WS_SSQ);
  u16* merged = (u16*)(P.ws + WS_A);
  constexpr int MT = 133, NT = 16;
  {
    float* pre = (float*)(P.ws + WS_A + A_PRE);
    for (int i = blockIdx.x * 256 + otid(); i < (M - SPLIT_ROW0) * (D / 4); i += gridDim.x * 256) {
      const int row = SPLIT_ROW0 + i / (D / 4), c = (i % (D / 4)) * 4;
      const uint2 xv = *(const uint2*)(act + (size_t)row * LDA + c);
      *(float4*)(pre + (size_t)row * D + c) = make_float4(ALPHA * __uint_as_float(xv.x << 16), ALPHA * __uint_as_float(xv.x & 0xffff0000u),
                                                          ALPHA * __uint_as_float(xv.y << 16), ALPHA * __uint_as_float(xv.y & 0xffff0000u));
    }
  }
  TILE_LOOP(MT * NT) {
    int mt, nt; tile_decode(t, MT, NT, mt, nt);
    const int tid_ = otid(), lane = tid_ & 63, w = tid_ >> 6, wm = w >> 1, wn = w & 1, r = lane & 15, q = lane >> 4;
    f32x4 fin[4][2]; zero_acc<2>(fin);
#pragma unroll 1
    for (int br = 0; br < 3; ++br) {
      f32x4 g[4][2]; zero_acc<2>(g);
      if (br == 2) {
        gemm_core<2>(g, act + (size_t)mt * 128 * LDA, LDA, Wg + ((size_t)br * 1024 + nt * 64) * LDA, LDA, D, (u16*)ldsb);
#pragma unroll
        for (int mf = 0; mf < 4; ++mf)
#pragma unroll
          for (int nf = 0; nf < 2; ++nf)
#pragma unroll
            for (int e = 0; e < 4; ++e) g[mf][nf][e] = sigmoid_f(g[mf][nf][e]);
      } else {
#pragma unroll
        for (int mf = 0; mf < 4; ++mf)
#pragma unroll
          for (int e = 0; e < 4; ++e) {
            const u16* gr = gate_row(P, br, mt * 128 + wm * 64 + mf * 16 + q * 4 + e) + nt * 64 + wn * 32 + r;
#pragma unroll
            for (int nf = 0; nf < 2; ++nf) g[mf][nf][e] = bf2f(gr[nf * 16]);
          }
      }
      const u16* yb = ybr + (size_t)br * M * LDY + (size_t)mt * 128 * LDY;
      const u16* wb = Wo + (size_t)br * 1024 * LDY + (size_t)nt * 64 * LDY;
      if (br != 1) {
        f32x4 acc[4][2]; zero_acc<2>(acc);
        gemm_core<2>(acc, yb, LDY, wb, LDY, 512, (u16*)ldsb);
#pragma unroll
        for (int mf = 0; mf < 4; ++mf)
#pragma unroll
          for (int nf = 0; nf < 2; ++nf)
#pragma unroll
            for (int e = 0; e < 4; ++e) fin[mf][nf][e] += g[mf][nf][e] * acc[mf][nf][e];
      } else {
#pragma unroll 1
        for (int grp = 0; grp < 2; ++grp) {
          f32x4 acc[4][2]; zero_acc<2>(acc);
          gemm_core<2>(acc, yb + grp * 256, LDY, wb + grp * 256, LDY, 256, (u16*)ldsb);
#pragma unroll
          for (int mf = 0; mf < 4; ++mf)
#pragma unroll
            for (int e = 0; e < 4; ++e) {
              const int row = mt * 128 + wm * 64 + mf * 16 + q * 4 + e;
              float4 s4 = *(const float4*)(ssq + (size_t)row * 8 + grp * 4);
              float rs = rsqrtf((s4.x + s4.y + s4.z + s4.w) * (1.f / 256.f) + 1e-6f);
#pragma unroll
              for (int nf = 0; nf < 2; ++nf) fin[mf][nf][e] += g[mf][nf][e] * rs * acc[mf][nf][e];
            }
        }
      }
    }
#pragma unroll
    for (int mf = 0; mf < 4; ++mf)
#pragma unroll
      for (int nf = 0; nf < 2; ++nf)
#pragma unroll
        for (int e = 0; e < 4; ++e) {
          const int row = mt * 128 + wm * 64 + mf * 16 + q * 4 + e;
          const int col = nt * 64 + wn * 32 + nf * 16 + r;
          merged[(size_t)row * LDA + col] = (u16)f2bf(fin[mf][nf][e]);
        }
  }
}

__device__ __forceinline__ void phase_resid(const Params& P, int mode, int l, unsigned char* ldsb) {
  const u16* act = (const u16*)(P.ws + WS_ACT);
  const u16* A = (const u16*)(P.ws + WS_A);
  const int K = mode == 0 ? 1024 : 4096;
  const int ldk = mode == 0 ? LDA : LDH;
  const u16* W = (const u16*)(P.ws + (mode == 0 ? (l == 0 ? 0 : WS_W2) + WS_WO : WS_WFF2));
  float* dst = mode == 0 ? (float*)(P.ws + WS_A + A_PRE) : (float*)(P.ws + WS_B);
  const float* bias = P.in[28] + l * D;
  constexpr int MT = 128, NT = 8;
  TILE_LOOP(MT * NT) {
    int mt, nt; tile_decode(t, MT, NT, mt, nt);
    const int tid_ = otid(), lane = tid_ & 63, w = tid_ >> 6, wm = w >> 1, wn = w & 1, r = lane & 15, q = lane >> 4;
    f32x4 acc[4][4]; zero_acc<4>(acc);
    if (mode == 0) gemm_core<4>(acc, A + (size_t)mt * 128 * ldk, ldk, W + (size_t)nt * 128 * ldk, ldk, K, (u16*)ldsb);
    else gemm_core<4>(acc, A + (size_t)mt * 64 * 8192, 64, W + (size_t)nt * 64 * 8192, 64, K, (u16*)ldsb, 8192);
#pragma unroll
    for (int mf = 0; mf < 4; ++mf)
#pragma unroll
      for (int nf = 0; nf < 4; ++nf) {
        const int col = nt * 128 + wn * 64 + nf * 16 + r;
        const float bb = mode == 1 ? bias[col] : 0.f;
#pragma unroll
        for (int e = 0; e < 4; ++e) {
          const int row = mt * 128 + wm * 64 + mf * 16 + q * 4 + e;
          dst[(size_t)row * D + col] = ALPHA * bf2f(act[(size_t)row * LDA + col]) + acc[mf][nf][e] + bb;
        }
      }
  }
  {
    constexpr int S = 8;
    const int KS = K / S;
    for (int li = blockIdx.x; li < 40 * S; li += gridDim.x) {
      const int sl = li % S, tl = li / S;
      const int mt = 128 + tl / 8, nt = tl % 8;
      const int tid_ = otid(), lane = tid_ & 63, w = tid_ >> 6, wm = w >> 1, wn = w & 1, r = lane & 15, q = lane >> 4;
      f32x4 acc[4][4]; zero_acc<4>(acc);
      if (mode == 0) gemm_core<4>(acc, A + (size_t)mt * 128 * ldk + sl * KS, ldk, W + (size_t)nt * 128 * ldk + sl * KS, ldk, KS, (u16*)ldsb);
      else gemm_core<4>(acc, A + ((size_t)mt * 64 + sl * (KS / 64)) * 8192, 64, W + ((size_t)nt * 64 + sl * (KS / 64)) * 8192, 64, KS, (u16*)ldsb, 8192);
#pragma unroll
      for (int mf = 0; mf < 4; ++mf)
#pragma unroll
        for (int nf = 0; nf < 4; ++nf) {
          const int col = nt * 128 + wn * 64 + nf * 16 + r;
#pragma unroll
          for (int e = 0; e < 4; ++e) {
            const int row = mt * 128 + wm * 64 + mf * 16 + q * 4 + e;
            (void)__hip_atomic_fetch_add(dst + (size_t)row * D + col, acc[mf][nf][e], __ATOMIC_RELAXED, __HIP_MEMORY_SCOPE_AGENT);
          }
        }
    }
  }
}

__device__ __forceinline__ void phase_ff1(const Params& P, int l, unsigned char* ldsb) {
  const u16* act = (const u16*)(P.ws + WS_ACT);
  const u16* W = (const u16*)(P.ws + WS_WFF1);
  u16* hid = (u16*)(P.ws + WS_A);
  const float* bias = P.in[26] + l * 4096;
  constexpr int MT = 133, NT = 32;
  TILE_LOOP(MT * NT) {
    int mt, nt; tile_decode(t, MT, NT, mt, nt);
    const int tid_ = otid(), lane = tid_ & 63, w = tid_ >> 6, wm = w >> 1, wn = w & 1, r = lane & 15, q = lane >> 4;
    f32x4 acc[4][4]; zero_acc<4>(acc);
    gemm_core<4>(acc, act + (size_t)mt * 128 * LDA, LDA, W + (size_t)nt * 128 * LDA, LDA, D, (u16*)ldsb);
#pragma unroll
    for (int mf = 0; mf < 4; ++mf)
#pragma unroll
      for (int nf = 0; nf < 4; ++nf) {
        const int col = nt * 128 + wn * 64 + nf * 16 + r;
        const float bb = bias[col];
#pragma unroll
        for (int e = 0; e < 4; ++e) {
          const int row = mt * 128 + wm * 64 + mf * 16 + q * 4 + e;
          float v = fmaxf(acc[mf][nf][e] + bb, 0.f);
          hid[((size_t)(row >> 7) * 64 + (col >> 6)) * 8192 + (row & 127) * 64 + (col & 63)] = (u16)f2bf(v * v);
        }
      }
  }
}

template <int BR>
__device__ __forceinline__ void rec_item(const Params& P, int l, int b, int h, int sample, unsigned char* ldsb) {
  constexpr int DV = (BR == 1) ? 64 : 128;
  constexpr int NFV = DV / 16;
  constexpr int NH = (BR == 1) ? 8 : 4;
  constexpr int OLD = DV + 4;
  constexpr int NEP = DV / 32;
  u16* QA = (u16*)ldsb;
  u16* KB = QA + 64 * LDT;
  u16* KT = KB + 64 * LDT;
  u16* ATT = KT + 64 * LDT;
  u16* VT = ATT + 64 * LDT;
  u16* ST = VT + 128 * LDT;
  float* Gsc = (float*)(ST + 128 * LDT);
  float* dec = Gsc + 64;
  float* dtv = dec + 64;
  float* psum = dtv + 64;
  float* invf = psum + 256;
  float* Gl = (float*)ST;
  float* AL = (float*)ATT;
  float* OST = (float*)ldsb;
  u16* XH = VT + 64 * LDT;

  const int tid = otid(), lane = tid & 63, w = tid >> 6, r = lane & 15, q = lane >> 4;
  const int T = sample ? 4 : TP;
  const int row0 = sample ? MP + b * 4 : b * TP;
  const int pos0 = sample ? 16384 : 0;
  const u16* proj = (const u16*)(P.ws + WS_A);
  u16* ybr = (u16*)(P.ws + WS_B) + (size_t)BR * M * LDY;
  float* ssq = (float*)(P.ws + WS_SSQ);

  float lg = 0.f, aneg = 0.f, dtb = 0.f, dsk = 0.f;
  if (BR == 2) {
    lg = log1pf(-exp2f(-5.f - (float)h));
    if (tid < 32) invf[tid] = exp2f(-(float)tid * (13.287712379549449f / 32.0f));
  }
  if (BR == 1) {
    aneg = -__expf(P.in[16][l * 8 + h]);
    dtb = P.in[15][l * 8 + h];
    dsk = P.in[17][l * 8 + h];
  }
  const int grp = h >> 2;

  f32x4 S[NFV];
  {
    const float* sin_ = P.in[2];
    if (sample) {
      const float* base = BR == 0 ? P.in[2] : (BR == 1 ? P.in[3] : P.in[5]);
      sin_ = base + ((size_t)(l * 128 + b) * NH + h) * 64 * DV;
    }
#pragma unroll
    for (int nf = 0; nf < NFV; ++nf)
#pragma unroll
      for (int e = 0; e < 4; ++e) {
        float v = sin_[(size_t)(16 * w + q * 4 + e) * DV + nf * 16 + r];
        S[nf][e] = sample ? v : 0.f;
      }
  }
  __syncthreads();

  uint4 Rg[NEP], RgN[NEP];
  uint4 Rq[2], Rk[2], Rv[4], Ral;
  uint4 Rq1, Rq2, Rk1, Rk2;
  uint4 Rx[11];
  float dtraw = 0.f;
  const int ci = tid & 63, part = tid >> 6;
  float w2r[16];
  float bias = 0.f;
  if (BR == 0) {
#pragma unroll
    for (int rr = 0; rr < 16; ++rr) w2r[rr] = P.in[10][(size_t)(l * 16 + rr) * 256 + h * 64 + ci];
    bias = P.in[11][l * 256 + h * 64 + ci];
  }
  const int cc = tid >> 3, ts = tid & 7;
  const bool act = tid < 192;
  const int seg = cc >> 3, c8 = (cc & 7) * 8;
  const int chan = seg == 0 ? h * 64 + c8 : (seg == 1 ? 512 + grp * 64 + c8 : 640 + grp * 64 + c8);
  float cwv[4][8], cbv[8];
  if (BR == 1 && act) {
    const float* cw = P.in[13] + (size_t)l * 4 * 768 + chan;
    const float* cb = P.in[14] + (size_t)l * 768 + chan;
#pragma unroll
    for (int i = 0; i < 4; ++i) {
      *(float4*)&cwv[i][0] = *(const float4*)(cw + i * 768);
      *(float4*)&cwv[i][4] = *(const float4*)(cw + i * 768 + 4);
    }
    *(float4*)&cbv[0] = *(const float4*)cb;
    *(float4*)&cbv[4] = *(const float4*)(cb + 4);
  }
#define REC_LOAD(CB, RGD)                                                                                     \
  {                                                                                                           \
    const int goff_ = BR == 0 ? 1024 + h * 128 : (BR == 1 ? 1552 + h * 64 : 3864 + h * 128);                  \
    _Pragma("unroll") for (int it = 0; it < NEP; ++it) {                                                      \
      const int id = tid + 256 * it;                                                                          \
      const int t = (DV == 128) ? (id >> 4) : (id >> 3);                                                      \
      const int j0 = (DV == 128) ? (id & 15) * 8 : (id & 7) * 8;                                              \
      RGD[it] = *(const uint4*)(proj + (size_t)(row0 + min((CB) + t, T - 1)) * NPJ + goff_ + j0);             \
    }                                                                                                         \
    if (BR == 0) {                                                                                            \
      _Pragma("unroll") for (int it = 0; it < 2; ++it) {                                                      \
        const int id = tid + 256 * it;                                                                        \
        const int t = id >> 3, i0 = (id & 7) * 8;                                                             \
        const u16* rp = proj + (size_t)(row0 + min((CB) + t, T - 1)) * NPJ + h * 64 + i0;                     \
        Rq[it] = *(const uint4*)rp;                                                                           \
        Rk[it] = *(const uint4*)(rp + 256);                                                                   \
      }                                                                                                       \
      { const int t = (tid & 127) >> 1, hf = tid & 1;                                                         \
        Ral = *(const uint4*)(proj + (size_t)(row0 + min((CB) + t, T - 1)) * NPJ + 1536 + hf * 8); }          \
    }                                                                                                         \
    if (BR == 2) {                                                                                            \
      const int t = tid >> 2, i0 = (tid & 3) * 8;                                                             \
      const u16* rp = proj + (size_t)(row0 + min((CB) + t, T - 1)) * NPJ + 2840 + h * 64 + i0;                \
      Rq1 = *(const uint4*)rp; Rq2 = *(const uint4*)(rp + 32);                                                \
      Rk1 = *(const uint4*)(rp + 256); Rk2 = *(const uint4*)(rp + 288);                                       \
    }                                                                                                         \
    if (BR == 1) {                                                                                            \
      if (act) {                                                                                              \
        _Pragma("unroll") for (int k = 0; k < 11; ++k) {                                                      \
          int tau = (CB) + ts * 8 - 3 + k;                                                                    \
          tau = min(max(tau, 0), T - 1);                                                                      \
          Rx[k] = *(const uint4*)(proj + (size_t)(row0 + tau) * NPJ + 2064 + chan);                           \
        }                                                                                                     \
      }                                                                                                       \
      if (w == 0) dtraw = bf2f(proj[(size_t)(row0 + min((CB) + lane, T - 1)) * NPJ + 2832 + h]);              \
    }                                                                                                         \
  }
  REC_LOAD(0, Rg)

  for (int c0 = 0; c0 < T; c0 += 64) {
    const int nvalid = min(64, T - c0);
    if (BR == 0 || BR == 2) {
      const int voff_ = (BR == 0 ? 512 : 3352) + h * 128;
#pragma unroll
      for (int it = 0; it < 4; ++it) {
        const int id = tid + 256 * it;
        const int t = id >> 4, j0 = (id & 15) * 8;
        Rv[it] = *(const uint4*)(proj + (size_t)(row0 + min(c0 + t, T - 1)) * NPJ + voff_ + j0);
      }
    }
    if (BR == 0) {
      if (tid < 128) {
        const int t = tid >> 1, hf = tid & 1;
        float a8[8];
        unpack8(Ral, a8);
        *(float4*)(AL + t * 16 + hf * 8) = make_float4(a8[0], a8[1], a8[2], a8[3]);
        *(float4*)(AL + t * 16 + hf * 8 + 4) = make_float4(a8[4], a8[5], a8[6], a8[7]);
      }
      __syncthreads();
      {
        float run = 0.f;
#pragma unroll 4
        for (int tt = 0; tt < 16; ++tt) {
          const int t = part * 16 + tt;
          const float4 x0 = *(const float4*)(AL + t * 16), x1 = *(const float4*)(AL + t * 16 + 4);
          const float4 x2 = *(const float4*)(AL + t * 16 + 8), x3 = *(const float4*)(AL + t * 16 + 12);
          float a = bias;
          a += x0.x * w2r[0] + x0.y * w2r[1] + x0.z * w2r[2] + x0.w * w2r[3];
          a += x1.x * w2r[4] + x1.y * w2r[5] + x1.z * w2r[6] + x1.w * w2r[7];
          a += x2.x * w2r[8] + x2.y * w2r[9] + x2.z * w2r[10] + x2.w * w2r[11];
          a += x3.x * w2r[12] + x3.y * w2r[13] + x3.z * w2r[14] + x3.w * w2r[15];
          float g = (fminf(a, 0.f) - log1pf(__expf(-fabsf(a)))) * (1.f / 16.f);
          if (t >= nvalid) g = 0.f;
          run += g;
          Gl[t * 64 + ci] = run;
        }
        psum[part * 64 + ci] = run;
      }
      __syncthreads();
      {
        float off = 0.f;
        for (int p = 0; p < part; ++p) off += psum[p * 64 + ci];
#pragma unroll 4
        for (int tt = 0; tt < 16; ++tt) Gl[(part * 16 + tt) * 64 + ci] += off;
      }
      __syncthreads();
#pragma unroll
      for (int it = 0; it < 2; ++it) {
        const int id = tid + 256 * it;
        const int t = id >> 3, i0 = (id & 7) * 8;
        const bool valid = t < nvalid;
        float qf[8], kf[8], G[8], Ge[8], qa[8], kb[8];
        unpack8(Rq[it], qf); unpack8(Rk[it], kf);
        *(float4*)&G[0] = *(const float4*)(Gl + t * 64 + i0);
        *(float4*)&G[4] = *(const float4*)(Gl + t * 64 + i0 + 4);
        *(float4*)&Ge[0] = *(const float4*)(Gl + 63 * 64 + i0);
        *(float4*)&Ge[4] = *(const float4*)(Gl + 63 * 64 + i0 + 4);
#pragma unroll
        for (int e = 0; e < 8; ++e) {
          const float qv = valid ? qf[e] : 0.f, kv = valid ? kf[e] : 0.f;
          qa[e] = qv * 0.125f * __expf(G[e]);
          kb[e] = kv * __expf(-G[e]);
          KT[tsw(i0 + e, t)] = (u16)f2bf(kv * __expf(Ge[e] - G[e]));
        }
        *(uint4*)(QA + t * LDT + i0) = pack8(qa);
        *(uint4*)(KB + t * LDT + i0) = pack8(kb);
        if (t == 63) {
#pragma unroll
          for (int e = 0; e < 8; ++e) dec[i0 + e] = __expf(Ge[e]);
        }
        __builtin_amdgcn_sched_barrier(0);
      }
#pragma unroll
      for (int it = 0; it < 4; ++it) {
        const int id = tid + 256 * it;
        const int t = id >> 4, j0 = (id & 15) * 8;
        uint4 v4 = Rv[it];
        if (t >= nvalid) v4 = make_uint4(0, 0, 0, 0);
        VT[tsw(j0 + 0, t)] = (u16)(v4.x & 0xffffu); VT[tsw(j0 + 1, t)] = (u16)(v4.x >> 16);
        VT[tsw(j0 + 2, t)] = (u16)(v4.y & 0xffffu); VT[tsw(j0 + 3, t)] = (u16)(v4.y >> 16);
        VT[tsw(j0 + 4, t)] = (u16)(v4.z & 0xffffu); VT[tsw(j0 + 5, t)] = (u16)(v4.z >> 16);
        VT[tsw(j0 + 6, t)] = (u16)(v4.w & 0xffffu); VT[tsw(j0 + 7, t)] = (u16)(v4.w >> 16);
      }
      if (tid < 64) Gsc[tid] = 0.f;
    }
    if (BR == 2) {
      {
        const int t = tid >> 2, i0 = (tid & 3) * 8;
        const bool valid = t < nvalid;
        float q1f[8], q2f[8], k1f[8], k2f[8], o1[8], o2[8], p1[8], p2[8];
        unpack8(Rq1, q1f); unpack8(Rq2, q2f); unpack8(Rk1, k1f); unpack8(Rk2, k2f);
        const float pos = (float)(pos0 + c0 + t);
        const float ed = __expf(lg * (float)(nvalid - min(t + 1, nvalid)));
#pragma unroll
        for (int e = 0; e < 8; ++e) {
          const float ang = pos * invf[i0 + e];
          double rev = (double)ang * 0.15915494309189535;
          rev -= floor(rev);
          const float rf = (float)rev;
          const float sn = __builtin_amdgcn_sinf(rf), cs = __builtin_amdgcn_cosf(rf);
          const float a1 = valid ? q1f[e] : 0.f, a2 = valid ? q2f[e] : 0.f;
          const float b1 = valid ? k1f[e] : 0.f, b2 = valid ? k2f[e] : 0.f;
          o1[e] = a1 * cs - a2 * sn;
          o2[e] = a1 * sn + a2 * cs;
          p1[e] = (b1 * cs - b2 * sn) * 0.125f;
          p2[e] = (b1 * sn + b2 * cs) * 0.125f;
          KT[tsw(i0 + e, t)] = (u16)f2bf(p1[e] * ed);
          KT[tsw(32 + i0 + e, t)] = (u16)f2bf(p2[e] * ed);
        }
        *(uint4*)(QA + t * LDT + i0) = pack8(o1);
        *(uint4*)(QA + t * LDT + 32 + i0) = pack8(o2);
        *(uint4*)(KB + t * LDT + i0) = pack8(p1);
        *(uint4*)(KB + t * LDT + 32 + i0) = pack8(p2);
      }
#pragma unroll
      for (int it = 0; it < 4; ++it) {
        const int id = tid + 256 * it;
        const int t = id >> 4, j0 = (id & 15) * 8;
        uint4 v4 = Rv[it];
        if (t >= nvalid) v4 = make_uint4(0, 0, 0, 0);
        VT[tsw(j0 + 0, t)] = (u16)(v4.x & 0xffffu); VT[tsw(j0 + 1, t)] = (u16)(v4.x >> 16);
        VT[tsw(j0 + 2, t)] = (u16)(v4.y & 0xffffu); VT[tsw(j0 + 3, t)] = (u16)(v4.y >> 16);
        VT[tsw(j0 + 4, t)] = (u16)(v4.z & 0xffffu); VT[tsw(j0 + 5, t)] = (u16)(v4.z >> 16);
        VT[tsw(j0 + 6, t)] = (u16)(v4.w & 0xffffu); VT[tsw(j0 + 7, t)] = (u16)(v4.w >> 16);
      }
      if (tid < 64) {
        Gsc[tid] = lg * (float)min(tid + 1, nvalid);
        dec[tid] = __expf(lg * (float)nvalid);
      }
    }
    if (BR == 1) {
      if (w == 0) {
        float dt = 0.f, g = 0.f;
        if (lane < nvalid) {
          dt = softplus_f(dtraw + dtb);
          g = dt * aneg;
        }
        float x = g;
#pragma unroll
        for (int o = 1; o < 64; o <<= 1) {
          float y = __shfl_up(x, o);
          if (lane >= o) x += y;
        }
        const float ge = __shfl(x, 63);
        Gsc[lane] = x; dtv[lane] = dt; dec[lane] = __expf(ge); psum[lane] = __expf(ge - x);
      }
      __syncthreads();
      if (act) {
        const bool first = (c0 == 0 && ts == 0);
        const float* cst = P.in[4] + (size_t)(l * 128 + b) * 3 * 768 + chan;
#pragma unroll
        for (int p = 0; p < 4; ++p) {
          float x0[11], x1[11];
#pragma unroll
          for (int k = 0; k < 11; ++k) {
            const unsigned wd = p == 0 ? Rx[k].x : (p == 1 ? Rx[k].y : (p == 2 ? Rx[k].z : Rx[k].w));
            x0[k] = __uint_as_float(wd << 16);
            x1[k] = __uint_as_float(wd & 0xffff0000u);
          }
          if (first) {
#pragma unroll
            for (int k = 0; k < 3; ++k) {
              const float2 sv = *(const float2*)(cst + k * 768 + 2 * p);
              x0[k] = sample ? sv.x : 0.f;
              x1[k] = sample ? sv.y : 0.f;
            }
          }
          float o0[8], o1[8];
#pragma unroll
          for (int tt = 0; tt < 8; ++tt) {
            const bool valid = (ts * 8 + tt) < nvalid;
            float a0 = cbv[2 * p], a1 = cbv[2 * p + 1];
#pragma unroll
            for (int i = 0; i < 4; ++i) { a0 += cwv[i][2 * p] * x0[tt + i]; a1 += cwv[i][2 * p + 1] * x1[tt + i]; }
            o0[tt] = valid ? silu_f(a0) : 0.f;
            o1[tt] = valid ? silu_f(a1) : 0.f;
          }
          u16* rowdst = seg == 0 ? XH : (seg == 1 ? KB : QA);
#pragma unroll
          for (int tt = 0; tt < 8; ++tt) *(unsigned*)(rowdst + (ts * 8 + tt) * LDT + c8 + 2 * p) = pack2(o0[tt], o1[tt]);
          if (seg < 2) {
            const float* sc = seg == 0 ? dtv : psum;
            u16* cdst = seg == 0 ? VT : KT;
            float c0v[8], c1v[8];
#pragma unroll
            for (int tt = 0; tt < 8; ++tt) { const float f = sc[ts * 8 + tt]; c0v[tt] = o0[tt] * f; c1v[tt] = o1[tt] * f; }
            *(uint4*)(cdst + tsw(c8 + 2 * p, ts * 8)) = pack8(c0v);
            *(uint4*)(cdst + tsw(c8 + 2 * p + 1, ts * 8)) = pack8(c1v);
          }
          __builtin_amdgcn_sched_barrier(0);
        }
      }
    }
    __syncthreads();
    if (c0 + 64 < T) { REC_LOAD(c0 + 64, RgN) }

#pragma unroll
    for (int nf = 0; nf < NFV; ++nf)
      *(uint2*)(ST + (nf * 16 + r) * LDT + 16 * w + q * 4) = make_uint2(pack2(S[nf][0], S[nf][1]), pack2(S[nf][2], S[nf][3]));

    bf16x8 aq[2];
    aq[0] = *(const bf16x8*)(QA + (16 * w + r) * LDT + q * 8);
    aq[1] = *(const bf16x8*)(QA + (16 * w + r) * LDT + 32 + q * 8);
    float gt[4];
#pragma unroll
    for (int e = 0; e < 4; ++e) gt[e] = Gsc[16 * w + q * 4 + e];
#pragma unroll
    for (int n = 0; n < 4; ++n) {
      f32x4 a = (f32x4){0.f, 0.f, 0.f, 0.f};
      if (n <= w) {
#pragma unroll
        for (int kk = 0; kk < 2; ++kk) {
          bf16x8 bk = *(const bf16x8*)(KB + (16 * n + r) * LDT + kk * 32 + q * 8);
          a = __builtin_amdgcn_mfma_f32_16x16x32_bf16(aq[kk], bk, a, 0, 0, 0);
        }
      }
      const int s = 16 * n + r;
      const float gs = Gsc[s];
#pragma unroll
      for (int e = 0; e < 4; ++e) {
        const int t = 16 * w + q * 4 + e;
        float v = (s <= t) ? a[e] * __expf(gt[e] - gs) : 0.f;
        ATT[t * LDT + s] = (u16)f2bf(v);
      }
    }
    __syncthreads();

    f32x4 O[NFV];
#pragma unroll
    for (int nf = 0; nf < NFV; ++nf) O[nf] = (f32x4){0.f, 0.f, 0.f, 0.f};
#pragma unroll
    for (int kk = 0; kk < 2; ++kk)
#pragma unroll
      for (int nf = 0; nf < NFV; ++nf) {
        bf16x8 bs = *(const bf16x8*)(ST + (nf * 16 + r) * LDT + kk * 32 + q * 8);
        O[nf] = __builtin_amdgcn_mfma_f32_16x16x32_bf16(aq[kk], bs, O[nf], 0, 0, 0);
      }
    if (BR != 0) {
#pragma unroll
      for (int e = 0; e < 4; ++e) {
        const float sc = __expf(gt[e]);
#pragma unroll
        for (int nf = 0; nf < NFV; ++nf) O[nf][e] *= sc;
      }
    }
    {
      float dc[4];
#pragma unroll
      for (int e = 0; e < 4; ++e) dc[e] = dec[16 * w + q * 4 + e];
#pragma unroll
      for (int nf = 0; nf < NFV; ++nf)
#pragma unroll
        for (int e = 0; e < 4; ++e) S[nf][e] *= dc[e];
    }
    int vtb[2], ktb[2];
    vtb[0] = r * LDT + ((q ^ (r >> 3)) << 3);
    vtb[1] = r * LDT + ((q ^ (2 + (r >> 3))) << 3);
    ktb[0] = tsw(16 * w + r, q * 8);
    ktb[1] = tsw(16 * w + r, 32 + q * 8);
#pragma unroll
    for (int kk = 0; kk < 2; ++kk) {
      bf16x8 at = *(const bf16x8*)(ATT + (16 * w + r) * LDT + kk * 32 + q * 8);
      bf16x8 ak = *(const bf16x8*)(KT + ktb[kk]);
#pragma unroll
      for (int nf = 0; nf < NFV; ++nf) {
        bf16x8 bv = *(const bf16x8*)(VT + vtb[nf & 1] + nf * 16 * LDT + ((kk ^ ((nf >> 1) & 1)) * 32));
        O[nf] = __builtin_amdgcn_mfma_f32_16x16x32_bf16(at, bv, O[nf], 0, 0, 0);
        S[nf] = __builtin_amdgcn_mfma_f32_16x16x32_bf16(ak, bv, S[nf], 0, 0, 0);
      }
    }
    __syncthreads();
#pragma unroll
    for (int nf = 0; nf < NFV; ++nf)
#pragma unroll
      for (int e = 0; e < 4; ++e) OST[(16 * w + q * 4 + e) * OLD + nf * 16 + r] = O[nf][e];
    __syncthreads();

#pragma unroll
    for (int it = 0; it < NEP; ++it) {
      const int id = tid + 256 * it;
      const int t = (DV == 128) ? (id >> 4) : (id >> 3);
      const int j0 = (DV == 128) ? (id & 15) * 8 : (id & 7) * 8;
      const bool valid = t < nvalid;
      const size_t row = (size_t)(row0 + c0 + t);
      float ov[8], gv[8], y[8];
      *(float4*)&ov[0] = *(const float4*)(OST + t * OLD + j0);
      *(float4*)&ov[4] = *(const float4*)(OST + t * OLD + j0 + 4);
      unpack8(Rg[it], gv);
      if (BR == 1) {
        float xh[8];
        unpack8(*(const uint4*)(XH + t * LDT + j0), xh);
        float ss = 0.f;
#pragma unroll
        for (int e = 0; e < 8; ++e) { y[e] = (ov[e] + dsk * xh[e]) * silu_f(gv[e]); ss += y[e] * y[e]; }
        ss += __shfl_xor(ss, 1); ss += __shfl_xor(ss, 2); ss += __shfl_xor(ss, 4);
        if (valid) {
          *(uint4*)(ybr + row * LDY + h * 64 + j0) = pack8(y);
          if ((tid & 7) == 0) ssq[row * 8 + h] = ss;
        }
      } else {
        float ss = 0.f;
#pragma unroll
        for (int e = 0; e < 8; ++e) ss += ov[e] * ov[e];
        ss += __shfl_xor(ss, 1); ss += __shfl_xor(ss, 2); ss += __shfl_xor(ss, 4); ss += __shfl_xor(ss, 8);
        const float rs = rsqrtf(ss * (1.f / 128.f) + 1e-6f);
        if (BR == 0) {
          const float* wn = P.in[12] + l * 128 + j0;
          const float4 w0 = *(const float4*)wn, w1 = *(const float4*)(wn + 4);
          const float wv[8] = {w0.x, w0.y, w0.z, w0.w, w1.x, w1.y, w1.z, w1.w};
#pragma unroll
          for (int e = 0; e < 8; ++e) y[e] = silu_f(gv[e]) * ov[e] * rs * wv[e];
        } else {
#pragma unroll
          for (int e = 0; e < 8; ++e) y[e] = silu_f(gv[e]) * ov[e] * rs;
        }
        if (valid) *(uint4*)(ybr + row * LDY + h * 128 + j0) = pack8(y);
      }
      __builtin_amdgcn_sched_barrier(0);
    }
#pragma unroll
    for (int it = 0; it < NEP; ++it) Rg[it] = RgN[it];
    __syncthreads();
  }
#undef REC_LOAD

  {
    float* so;
    if (sample) so = P.out + (BR == 0 ? O_SGS : (BR == 1 ? O_SSS : O_SRS)) + ((size_t)(l * 128 + b) * NH + h) * 64 * DV;
    else so = P.out + (BR == 0 ? O_SGP : (BR == 1 ? O_SSP : O_SRP)) + ((size_t)(l * 8 + b) * NH + h) * 64 * DV;
#pragma unroll
    for (int nf = 0; nf < NFV; ++nf)
#pragma unroll
      for (int e = 0; e < 4; ++e) so[(size_t)(16 * w + q * 4 + e) * DV + nf * 16 + r] = S[nf][e];
  }
}

#ifndef REC_ONLY
#define REC_ONLY -1
#endif
template <int BR>
__device__ __forceinline__ void rec_branch(const Params& P, int l, bool split, int wb, int nwb, int lb0, unsigned char* ldsb) {
  if (!(REC_ONLY < 0 || REC_ONLY == BR)) return;
  constexpr int NH = (BR == 1) ? 8 : 4;
  constexpr int nl = 8 * NH;
  const int end = nl + 128 * NH;
  int it, step;
  if (split) {
    const int bx = blockIdx.x;
    if (bx >= lb0 && bx < lb0 + nl) { it = bx - lb0; step = 1 << 20; }
    else if (bx >= 128) { it = nl + wb; step = nwb; }
    else { it = end; step = 1; }
  } else { it = blockIdx.x; step = gridDim.x; }
  for (; it < end; it += step) {
    const int sample = it >= nl;
    const int idx = sample ? it - nl : it;
    int ll = l;
    asm volatile("" : "+s"(ll));
    rec_item<BR>(P, ll, idx / NH, idx % NH, sample, ldsb);
  }
}

__device__ __forceinline__ void phase_rec(const Params& P, int l, unsigned char* ldsb) {
  const int G = gridDim.x;
  const u16* proj = (const u16*)(P.ws + WS_A);
  const bool split = (G >= 256);
  const int wb = split ? (int)blockIdx.x - 128 : (int)blockIdx.x;
  int nwb = split ? G - 128 : G;
  asm volatile("" : "+s"(nwb));
  if (wb >= 0) {
    for (int i = wb * 256 + otid(); i < (8 + 128) * 3 * 768; i += nwb * 256) {
      const bool pr = i < 8 * 3 * 768;
      const int j = pr ? i : i - 8 * 3 * 768;
      const int b = j / (3 * 768), rem = j - b * 3 * 768, rr = rem / 768, c = rem - rr * 768;
      const size_t row = pr ? (size_t)(b * TP + 2061 + rr) : (size_t)(MP + b * 4 + 1 + rr);
      const size_t oo = pr ? O_SCP + (size_t)l * 8 * 3 * 768 + j : O_SCS + (size_t)l * 128 * 3 * 768 + j;
      P.out[oo] = bf2f(proj[row * NPJ + 2064 + c]);
    }
  }
  rec_branch<0>(P, l, split, wb, nwb, 0, ldsb);
  rec_branch<1>(P, l, split, wb, nwb, 32, ldsb);
  rec_branch<2>(P, l, split, wb, nwb, 96, ldsb);
  if (wb >= 0) {
    __syncthreads();
    if (l == 0) {
      convert_layer(P, 0, ldsb, 1888, 4576, wb, nwb);
      convert_layer(P, 1, ldsb, 0, 2528, wb, nwb);
    } else {
      convert_layer(P, 1, ldsb, 2528, 4576, wb, nwb);
    }
    phase_gates(P, l, wb, nwb, ldsb);
  }
}


#define XB_TMO      128
#define XB_XCNT(j)  (256  + 64 * (j))
#define XB_XSUB(j)  (1280 + 64 * (j))
#define XB_XGEN(j)  (2304 + 64 * (j))
#define XB_TOP      3328
#define XB_TOPGEN   3392
#define XCD_BAR_WORDS 3456
#define XB_SPIN_CAP (1u << 22)
__device__ __forceinline__ unsigned xb_ld(unsigned* p) { return __hip_atomic_load(p, __ATOMIC_RELAXED, __HIP_MEMORY_SCOPE_AGENT); }
__device__ __forceinline__ unsigned xb_add(unsigned* p, unsigned v) { return __hip_atomic_fetch_add(p, v, __ATOMIC_RELAXED, __HIP_MEMORY_SCOPE_AGENT); }
__device__ __forceinline__ unsigned xb_xcc_id() { return (unsigned)__builtin_amdgcn_s_getreg((3 << 11) | 20) & 0xFu; }
#define XB_SPIN(cond, bar) do { unsigned _sp = 0; while (cond) { __builtin_amdgcn_s_sleep(1); \
    if ((++_sp & 255u) == 0u) { if (xb_ld(&(bar)[XB_TMO])) break; if (_sp > XB_SPIN_CAP) { atomicAdd(&(bar)[XB_TMO], 1u); break; } } } } while (0)
struct XcdBarrier { unsigned* bar; unsigned x; volatile LAS unsigned* st; };
__device__ __forceinline__ XcdBarrier xcd_barrier_post(unsigned* bar, volatile LAS unsigned* st) {
  XcdBarrier b; b.bar = bar; b.x = xb_xcc_id(); b.st = st;
  if (threadIdx.x == 0) (void)xb_add(&bar[XB_XCNT(b.x)], 1u);
  return b;
}
__device__ __forceinline__ void xcd_barrier_complete(unsigned* bar, unsigned x, unsigned& nloc, unsigned& nx) {
  const unsigned G = gridDim.x * gridDim.y * gridDim.z;
  unsigned sum, cnt, mine, sp = 0u;
  for (;;) {
    sum = 0u; cnt = 0u; mine = 0u;
#pragma unroll
    for (unsigned j = 0; j < 16; ++j) { const unsigned c = xb_ld(&bar[XB_XCNT(j)]); sum += c; cnt += (c > 0u) ? 1u : 0u; mine = (j == x) ? c : mine; }
    if (sum == G) break;
    __builtin_amdgcn_s_sleep(1);
    if ((++sp & 255u) == 0u) { if (xb_ld(&bar[XB_TMO])) break; if (sp > XB_SPIN_CAP) { atomicAdd(&bar[XB_TMO], 1u); break; } }
  }
  nloc = mine > 0u ? mine : 1u; nx = cnt > 0u ? cnt : 1u;
}
__device__ __forceinline__ void xcd_barrier(const XcdBarrier& b) {
  asm volatile("s_waitcnt vmcnt(0)" ::: "memory");
  __syncthreads();
  if (threadIdx.x == 0) {
    unsigned* bar = b.bar;
    __builtin_amdgcn_s_waitcnt(0);
    unsigned nloc = b.st[0], nx = b.st[1];
    if (nloc == 0u) { xcd_barrier_complete(bar, b.x, nloc, nx); b.st[0] = nloc; b.st[1] = nx; }
    const unsigned old = xb_add(&bar[XB_XSUB(b.x)], 1u);
    const unsigned gen = old / nloc;
    if (old + 1u == (gen + 1u) * nloc) {
      __builtin_amdgcn_fence(__ATOMIC_RELEASE, "agent");
      asm volatile("s_waitcnt vmcnt(0)" ::: "memory");
      const unsigned og = xb_add(&bar[XB_TOP], 1u);
      const unsigned tg = og / nx;
      if (og + 1u == (tg + 1u) * nx) xb_add(&bar[XB_TOPGEN], 1u);
      else XB_SPIN(xb_ld(&bar[XB_TOPGEN]) == tg, bar);
      __builtin_amdgcn_fence(__ATOMIC_ACQUIRE, "agent");
      xb_add(&bar[XB_XGEN(b.x)], 1u);
      asm volatile("s_waitcnt vmcnt(0)" ::: "memory");
    } else {
      XB_SPIN(xb_ld(&bar[XB_XGEN(b.x)]) == gen, bar);
      __builtin_amdgcn_fence(__ATOMIC_ACQUIRE, "agent");
      asm volatile("s_waitcnt vmcnt(0)" ::: "memory");
    }
  }
  __syncthreads();
}

__global__ void __launch_bounds__(256, 2) fwd_kernel(Params P, int ph_lo, int ph_hi) {
  extern __shared__ __attribute__((aligned(16))) unsigned char ldsb[];
  cg::grid_group grid = cg::this_grid();
  volatile LAS unsigned* xst = (volatile LAS unsigned*)(ldsb + 75904);
  if (threadIdx.x == 0) { xst[0] = 0u; xst[1] = 0u; xst[2] = 0u; xst[3] = 0u; }
  __syncthreads();
  XcdBarrier xb = xcd_barrier_post((unsigned*)(P.ws + WS_BAR), xst);
  if (ph_hi > 1000) grid.sync();
  for (int ph = ph_lo; ph < ph_hi; ++ph) {
    if (ph > ph_lo) xcd_barrier(xb);
    if (ph == 0) {
      if (PH_ON(0)) { convert_layer(P, 0, ldsb, 0, 1888, blockIdx.x, gridDim.x); ln_phase(P, 0, 0); }
      continue;
    }
    int phl = ph;
    asm volatile("" : "+s"(phl));
    const int l = (phl - 1) >> 3, s = (phl - 1) & 7;
    switch (s) {
      case 0: if (PH_ON(1)) { phase_proj(P, l, ldsb); if (DUP(1)) phase_proj(P, l, ldsb); } break;
      case 1: if (PH_ON(2)) { phase_rec(P, l, ldsb); if (DUP(2)) { __syncthreads(); phase_rec(P, l, ldsb); } } break;
      case 2: if (PH_ON(3)) { phase_merge(P, l, ldsb); if (DUP(3)) phase_merge(P, l, ldsb); } break;
      case 3: if (PH_ON(4)) { phase_resid(P, 0, l, ldsb); if (DUP(4)) phase_resid(P, 0, l, ldsb); } break;
      case 4: if (PH_ON(5)) { ln_phase(P, 1, l); if (DUP(5)) ln_phase(P, 1, l); } break;
      case 5: if (PH_ON(6)) { phase_ff1(P, l, ldsb); if (DUP(6)) phase_ff1(P, l, ldsb); } break;
      case 6: if (PH_ON(7)) { phase_resid(P, 1, l, ldsb); if (DUP(7)) phase_resid(P, 1, l, ldsb); } break;
      case 7:
        if (PH_ON(8)) { ln_phase(P, 2, l); }
        break;
    }
  }
}

extern "C" void kernel_launch(void* const* d_in, const int* in_sizes, int n_in, void* d_out, int out_size, void* d_ws,
                              size_t ws_size, hipStream_t stream) {
  static int grid_blocks = 0;
  if (grid_blocks == 0) {
    if (n_in != 31 || ws_size < WS_END || out_size != 44666880) {
      fprintf(stderr, "kernel_launch: unexpected problem (n_in %d, ws %zu, out %d)\n", n_in, ws_size, out_size);
      grid_blocks = -1;
      return;
    }
    int dev = 0, cus = 0, per_cu = 0;
    hipGetDevice(&dev);
    hipDeviceGetAttribute(&cus, hipDeviceAttributeMultiprocessorCount, dev);
    hipFuncSetAttribute((const void*)fwd_kernel, hipFuncAttributeMaxDynamicSharedMemorySize, LDS_BYTES);
    hipOccupancyMaxActiveBlocksPerMultiprocessor(&per_cu, (const void*)fwd_kernel, 256, LDS_BYTES);
    if (per_cu < 1) { fprintf(stderr, "kernel_launch: occupancy query says 0 blocks per CU\n"); grid_blocks = -1; return; }
    if (per_cu > 2) per_cu = 2;
    grid_blocks = cus * per_cu;
    grid_blocks -= grid_blocks % 8;
  }
  if (grid_blocks < 0) return;
  Params p{};
  for (int i = 0; i < 31; ++i) p.in[i] = (const float*)d_in[i];
  p.out = (float*)d_out;
  p.ws = (unsigned char*)d_ws;
  if (hipMemsetAsync((char*)d_ws + WS_BAR, 0, XCD_BAR_WORDS * 4, stream) != hipSuccess) { fprintf(stderr, "memset failed\n"); return; }
#if ONE_LAUNCH
  int lo = 0, hi = NPHASE;
  void* args[] = {&p, &lo, &hi};
  hipError_t e = hipLaunchCooperativeKernel((const void*)fwd_kernel, dim3(grid_blocks), dim3(256), args, LDS_BYTES, stream);
  if (e != hipSuccess) fprintf(stderr, "cooperative launch failed: %s (grid %d)\n", hipGetErrorString(e), grid_blocks);
#else
  for (int ph = 0; ph < NPHASE; ++ph) {
    hipLaunchKernelGGL(fwd_kernel, dim3(grid_blocks), dim3(256), LDS_BYTES, stream, p, ph, ph + 1);
  }
#endif
}
```

```cpp
#include <hip/hip_runtime.h>
#include <hip/hip_cooperative_groups.h>
#include <stdint.h>
#include <stdio.h>
namespace cg = cooperative_groups;

#ifndef ONE_LAUNCH
#define ONE_LAUNCH 1
#endif
#ifndef PHASE_ONLY
#define PHASE_ONLY -1
#endif
#define PH_ON(n) (PHASE_ONLY < 0 || PHASE_ONLY == (n))
#ifndef DUP_MASK
#define DUP_MASK 0
#endif
#define DUP(n) ((DUP_MASK >> (n)) & 1)

#define LAS __attribute__((address_space(3)))
typedef unsigned short u16;
typedef __attribute__((ext_vector_type(8))) short bf16x8;
typedef __attribute__((ext_vector_type(4))) float f32x4;

constexpr int D = 1024;
constexpr int TP = 2064;
constexpr int MP = 8 * TP;
constexpr int MS = 512;
constexpr int M = MP + MS;
constexpr int NPJ = 4376;
constexpr int LDT = 72;
constexpr float ALPHA = 1.4142135623730951f;
constexpr int NPHASE = 17;
constexpr int SPLIT_ROW0 = 128 * 128;

constexpr int LDA = 1088;
constexpr int LDY = 576;
constexpr int LDH = 4160;
constexpr size_t WS_WIN = 0;
constexpr size_t WS_WGATE = 9748480;
constexpr size_t WS_WOUT = 16433152;
constexpr size_t WS_WO = 19972096;
constexpr size_t WS_WFF1 = 22200320;
constexpr size_t WS_WFF2 = 31113216;
constexpr size_t WS_ACT = 39632896;
constexpr size_t WS_SSQ = 76677120;
constexpr size_t WS_A = 77221888;
constexpr size_t WS_B = 226215936;
constexpr size_t WS_BAR = 295946240;
constexpr size_t WS_W2 = WS_BAR + 16384;
constexpr size_t WS_G1X = WS_W2 + 22200320;
constexpr size_t WS_END = WS_G1X + 524288;
constexpr int G1_SPLIT = 16768;
constexpr size_t A_PRE = 37044224;

constexpr size_t O_YP = 0, O_YS = 16777216, O_SGP = 17301504, O_SGS = 17825792, O_SSP = 26214400, O_SSS = 26738688,
                 O_SCP = 35127296, O_SCS = 35164160, O_SRP = 35753984, O_SRS = 36278272;

constexpr int LDS_BYTES = 76032;

struct Params { const float* in[31]; float* out; unsigned char* ws; };

__device__ __forceinline__ unsigned f2bf(float f) {
  unsigned u = __float_as_uint(f);
  u += 0x7fffu + ((u >> 16) & 1u);
  return u >> 16;
}
__device__ __forceinline__ float bf2f(u16 h) { return __uint_as_float(((unsigned)h) << 16); }
__device__ __forceinline__ unsigned pack2(float a, float b) { return f2bf(a) | (f2bf(b) << 16); }
__device__ __forceinline__ void unpack8(uint4 v, float (&f)[8]) {
  f[0] = __uint_as_float(v.x << 16); f[1] = __uint_as_float(v.x & 0xffff0000u);
  f[2] = __uint_as_float(v.y << 16); f[3] = __uint_as_float(v.y & 0xffff0000u);
  f[4] = __uint_as_float(v.z << 16); f[5] = __uint_as_float(v.z & 0xffff0000u);
  f[6] = __uint_as_float(v.w << 16); f[7] = __uint_as_float(v.w & 0xffff0000u);
}
__device__ __forceinline__ uint4 pack8(const float (&f)[8]) {
  return make_uint4(pack2(f[0], f[1]), pack2(f[2], f[3]), pack2(f[4], f[5]), pack2(f[6], f[7]));
}
__device__ __forceinline__ int tsw(int row, int col) { return row * LDT + (col ^ (((row >> 3) & 7) << 3)); }
__device__ __forceinline__ int otid() { int t = threadIdx.x; asm volatile("" : "+v"(t)); return t; }
__device__ __forceinline__ float silu_f(float x) { return x / (1.f + __expf(-x)); }
__device__ __forceinline__ float sigmoid_f(float x) { return 1.f / (1.f + __expf(-x)); }
__device__ __forceinline__ float softplus_f(float x) { return fmaxf(x, 0.f) + log1pf(__expf(-fabsf(x))); }

struct ConvPend { u16* dst; int ldk, kt, nt, blocked_nkt, valid; };

__device__ __forceinline__ void conv_flush(ConvPend& pd, const float (&pend)[16], float* tile, int tid) {
  if (!pd.valid) return;
  const int c = tid & 63, r4 = tid >> 6;
#pragma unroll
  for (int i = 0; i < 16; ++i) tile[(r4 + 4 * i) * 65 + c] = pend[i];
  __syncthreads();
#pragma unroll
  for (int it = 0; it < 2; ++it) {
    const int id = tid + 256 * it;
    const int nn = id >> 3, kc = id & 7;
    const unsigned w0 = pack2(tile[(kc * 8 + 0) * 65 + nn], tile[(kc * 8 + 1) * 65 + nn]);
    const unsigned w1 = pack2(tile[(kc * 8 + 2) * 65 + nn], tile[(kc * 8 + 3) * 65 + nn]);
    const unsigned w2 = pack2(tile[(kc * 8 + 4) * 65 + nn], tile[(kc * 8 + 5) * 65 + nn]);
    const unsigned w3 = pack2(tile[(kc * 8 + 6) * 65 + nn], tile[(kc * 8 + 7) * 65 + nn]);
    const int n_ = pd.nt * 64 + nn;
    const size_t di = pd.blocked_nkt ? ((size_t)((n_ >> 7) * pd.blocked_nkt + pd.kt) * 8192 + (n_ & 127) * 64 + kc * 8)
                                     : ((size_t)n_ * pd.ldk + pd.kt * 64 + kc * 8);
    *(uint4*)(pd.dst + di) = make_uint4(w0, w1, w2, w3);
  }
  __syncthreads();
  pd.valid = 0;
}

__device__ __forceinline__ void conv_tile64(const float* __restrict__ src, int ld, int ldk, int ncol0, int nvalid, u16* __restrict__ dst,
                            int kt, int nt, const float* __restrict__ kscale, float* tile, ConvPend& pd, float (&pend)[16],
                            int blocked_nkt = 0) {
  const int tid = otid();
  const int c = tid & 63, r4 = tid >> 6;
  const int n = nt * 64 + c;
  const bool ok = n < nvalid;
  float v[16];
#pragma unroll
  for (int i = 0; i < 16; ++i) {
    const int kg = kt * 64 + r4 + 4 * i;
    float x = ok ? src[(size_t)kg * ld + ncol0 + n] : 0.f;
    if (kscale) x *= kscale[kg];
    v[i] = x;
  }
  conv_flush(pd, pend, tile, tid);
#pragma unroll
  for (int i = 0; i < 16; ++i) pend[i] = v[i];
  pd.dst = dst; pd.ldk = ldk; pd.kt = kt; pd.nt = nt; pd.blocked_nkt = blocked_nkt; pd.valid = 1;
}

__device__ __forceinline__ void convert_layer(const Params& P, int l, unsigned char* lds, int t_lo, int t_hi, int wb, int nwb) {
  float* tile = (float*)lds;
  unsigned char* ws = P.ws;
  const size_t wsel = (l == 0) ? 0 : WS_W2;
  ConvPend pd; pd.dst = nullptr; pd.ldk = 0; pd.kt = 0; pd.nt = 0; pd.blocked_nkt = 0; pd.valid = 0;
  float pend[16];
#pragma unroll
  for (int i = 0; i < 16; ++i) pend[i] = 0.f;
  for (int t = t_lo + wb; t < t_hi; t += nwb) {
    int idx = t;
    if (idx < 1120) {
      conv_tile64(P.in[9] + (size_t)l * 1024 * 7448, 7448, LDA, 0, NPJ, (u16*)(ws + wsel + WS_WIN), idx % 16, idx / 16, nullptr, tile, pd, pend);
      continue;
    }
    idx -= 1120;
    if (idx < 768) {
      conv_tile64(P.in[9] + (size_t)l * 1024 * 7448, 7448, LDA, NPJ, 3072, (u16*)(ws + wsel + WS_WGATE), idx % 16, idx / 16, nullptr, tile, pd, pend);
      continue;
    }
    idx -= 768;
    if (idx < 384) {
      int br = idx / 128, r = idx % 128;
      conv_tile64((br == 0 ? P.in[19] : (br == 1 ? P.in[20] : P.in[21])) + (size_t)l * 512 * 1024, 1024, LDY, 0, 1024,
                  (u16*)(ws + wsel + WS_WOUT) + (size_t)br * 1024 * LDY, r % 8, r / 8, br == 1 ? P.in[18] + l * 512 : nullptr, tile, pd, pend);
      continue;
    }
    idx -= 384;
    if (idx < 256) {
      conv_tile64(P.in[22] + (size_t)l * 1024 * 1024, 1024, LDA, 0, 1024, (u16*)(ws + wsel + WS_WO), idx % 16, idx / 16, nullptr, tile, pd, pend);
      continue;
    }
    idx -= 256;
    if (idx < 1024) {
      conv_tile64(P.in[25] + (size_t)l * 1024 * 4096, 4096, LDA, 0, 4096, (u16*)(ws + WS_WFF1), idx % 16, idx / 16, nullptr, tile, pd, pend);
      continue;
    }
    idx -= 1024;
    conv_tile64(P.in[27] + (size_t)l * 4096 * 1024, 1024, LDH, 0, 1024, (u16*)(ws + WS_WFF2), idx % 64, idx / 64, nullptr, tile, pd, pend, 64);
  }
  conv_flush(pd, pend, tile, otid());
}

__device__ __forceinline__ void ln_phase(const Params& P, int mode, int l) {
  const int tid_ = otid();
  const int lane = tid_ & 63;
  const int gw = blockIdx.x * 4 + (tid_ >> 6);
  const int nw = gridDim.x * 4;
  const float* wv = mode == 0 ? P.in[7] : (mode == 1 ? P.in[23] + l * D : P.in[29] + l * D);
  const float* bv = mode == 0 ? P.in[8] : (mode == 1 ? P.in[24] + l * D : P.in[30] + l * D);
  u16* act = (u16*)(P.ws + WS_ACT);
  const bool final_out = (mode == 2 && l == 1);
  for (int row = gw; row < M; row += nw) {
    const float* s;
    int b = 0, t = 0;
    if (row < MP) { b = row / TP; t = row - b * TP; }
    if (mode == 0) {
      if (row < MP) s = (t < 16) ? P.in[6] + (size_t)t * D : P.in[0] + ((size_t)b * 2048 + (t - 16)) * D;
      else s = P.in[1] + (size_t)(row - MP) * D;
    } else if (mode == 1) {
      s = (const float*)(P.ws + WS_A + A_PRE) + (size_t)row * D;
    } else {
      s = (const float*)(P.ws + WS_B) + (size_t)row * D;
    }
    float4 v[4];
#pragma unroll
    for (int i = 0; i < 4; ++i) v[i] = *(const float4*)(s + i * 256 + lane * 4);
    float sum = 0.f;
#pragma unroll
    for (int i = 0; i < 4; ++i) sum += v[i].x + v[i].y + v[i].z + v[i].w;
#pragma unroll
    for (int o = 32; o >= 1; o >>= 1) sum += __shfl_xor(sum, o);
    const float mean = sum * (1.f / 1024.f);
    float sq = 0.f;
#pragma unroll
    for (int i = 0; i < 4; ++i) {
      v[i].x -= mean; v[i].y -= mean; v[i].z -= mean; v[i].w -= mean;
      sq += v[i].x * v[i].x + v[i].y * v[i].y + v[i].z * v[i].z + v[i].w * v[i].w;
    }
#pragma unroll
    for (int o = 32; o >= 1; o >>= 1) sq += __shfl_xor(sq, o);
    const float rstd = rsqrtf(sq * (1.f / 1024.f) + 1e-5f);
    float* od = nullptr;
    if (final_out) {
      if (row < MP) { if (t >= 16) od = P.out + O_YP + ((size_t)b * 2048 + (t - 16)) * D; }
      else od = P.out + O_YS + (size_t)(row - MP) * D;
    }
#pragma unroll
    for (int i = 0; i < 4; ++i) {
      const int c = i * 256 + lane * 4;
      float4 w4 = *(const float4*)(wv + c), b4 = *(const float4*)(bv + c);
      float y0 = v[i].x * rstd * w4.x + b4.x, y1 = v[i].y * rstd * w4.y + b4.y;
      float y2 = v[i].z * rstd * w4.z + b4.z, y3 = v[i].w * rstd * w4.w + b4.w;
      if (final_out) {
        if (od) *(float4*)(od + c) = make_float4(y0, y1, y2, y3);
      } else {
        const unsigned p0 = pack2(y0, y1), p1 = pack2(y2, y3);
        *(uint2*)(act + (size_t)row * LDA + c) = make_uint2(p0, p1);
        if (mode == 1 && row >= SPLIT_ROW0) {
          const float4 bb = *(const float4*)(P.in[28] + l * D + c);
          float* pz = (float*)(P.ws + WS_B) + (size_t)row * D + c;
          *(float4*)pz = make_float4(ALPHA * __uint_as_float(p0 << 16) + bb.x, ALPHA * __uint_as_float(p0 & 0xffff0000u) + bb.y,
                                     ALPHA * __uint_as_float(p1 << 16) + bb.z, ALPHA * __uint_as_float(p1 & 0xffff0000u) + bb.w);
        }
      }
    }
  }
}

#define G_LOAD4(R, k0)                                                                    \
  R##a0 = *(const uint4*)(ap + (k0)); R##a1 = *(const uint4*)(ap + sa + (k0));            \
  R##a2 = *(const uint4*)(ap + 2 * sa + (k0)); R##a3 = *(const uint4*)(ap + 3 * sa + (k0)); \
  R##b0 = *(const uint4*)(bp + (k0)); R##b1 = *(const uint4*)(bp + sb + (k0));
#define G_LOADB(R, k0)                                                                    \
  R##b2 = *(const uint4*)(bp + 2 * sb + (k0)); R##b3 = *(const uint4*)(bp + 3 * sb + (k0));
#define L_STORE4(R, buf)                                                                  \
  { u16* ad = As + (buf) * 128 * LDT + crow * LDT + cck;                                  \
    u16* bd = Bs + (buf) * BN * LDT + crow * LDT + cck;                                   \
    *(uint4*)(ad) = R##a0; *(uint4*)(ad + 32 * LDT) = R##a1; *(uint4*)(ad + 64 * LDT) = R##a2; *(uint4*)(ad + 96 * LDT) = R##a3; \
    *(uint4*)(bd) = R##b0; *(uint4*)(bd + 32 * LDT) = R##b1;                              \
    if (NF == 4) { *(uint4*)(bd + 64 * LDT) = R##b2; *(uint4*)(bd + 96 * LDT) = R##b3; } }
#define MMA_TILE(buf)                                                                     \
  { const u16* as = As + (buf) * 128 * LDT + (wm * 64 + r) * LDT + q * 8;                 \
    const u16* bs = Bs + (buf) * BN * LDT + (wn * NF * 16 + r) * LDT + q * 8;             \
    _Pragma("unroll") for (int kk = 0; kk < 2; ++kk) {                                    \
      bf16x8 af[4], bfr[NF];                                                              \
      _Pragma("unroll") for (int mf = 0; mf < 4; ++mf) af[mf] = *(const bf16x8*)(as + mf * 16 * LDT + kk * 32); \
      _Pragma("unroll") for (int nf = 0; nf < NF; ++nf) bfr[nf] = *(const bf16x8*)(bs + nf * 16 * LDT + kk * 32); \
      _Pragma("unroll") for (int mf = 0; mf < 4; ++mf)                                    \
        _Pragma("unroll") for (int nf = 0; nf < NF; ++nf)                                 \
          acc[mf][nf] = __builtin_amdgcn_mfma_f32_16x16x32_bf16(af[mf], bfr[nf], acc[mf][nf], 0, 0, 0); \
    } }

__device__ __forceinline__ int lds_byte(int r, int c) {
  int st = (r >> 4) * 2 + (c >> 5), rr = r & 15, cc = c & 31, ob = rr * 64 + cc * 2;
  return st * 1024 + (ob ^ (((ob >> 9) & 1) << 5));
}
__device__ __forceinline__ void stage_rc(int b, int& R, int& C) {
  int st = b >> 10, sb = b & 1023, swz = sb ^ (((sb >> 9) & 1) << 5);
  R = (st >> 1) * 16 + (swz >> 6);
  C = (st & 1) * 32 + ((swz & 63) >> 1);
}

template <int NF>
__device__ __forceinline__ void gemm_core(f32x4 (&acc)[4][NF], const u16* __restrict__ A, int lda,
                                          const u16* __restrict__ B, int ldb, int K, u16* lds, int kadv = 64) {
  constexpr int BN = 32 * NF;
  constexpr int ABYTES = 128 * 64 * 2;
  constexpr int BBYTES = BN * 64 * 2;
  constexpr int BUF = ABYTES + BBYTES;
  unsigned char* base = (unsigned char*)lds;
  const int tid = otid(), lane = tid & 63, w = tid >> 6, wm = w >> 1, wn = w & 1, r = lane & 15, q = lane >> 4;
  const u16* ga[4]; const u16* gb[NF];
#pragma unroll
  for (int i = 0; i < 4; ++i) { int R, C; stage_rc(tid * 16 + i * 4096, R, C); ga[i] = A + (size_t)R * lda + C; }
#pragma unroll
  for (int i = 0; i < NF; ++i) { int R, C; stage_rc(tid * 16 + i * 4096, R, C); gb[i] = B + (size_t)R * ldb + C; }
  int oa[4][2], ob[NF][2];
#pragma unroll
  for (int mf = 0; mf < 4; ++mf)
#pragma unroll
    for (int kk = 0; kk < 2; ++kk) oa[mf][kk] = lds_byte(wm * 64 + mf * 16 + r, kk * 32 + q * 8);
#pragma unroll
  for (int nf = 0; nf < NF; ++nf)
#pragma unroll
    for (int kk = 0; kk < 2; ++kk) ob[nf][kk] = lds_byte(wn * NF * 16 + nf * 16 + r, kk * 32 + q * 8);
#define STAGE_TILE(buf, k0)                                                                              \
  {                                                                                                      \
    _Pragma("unroll") for (int i = 0; i < 4; ++i)                                                        \
      __builtin_amdgcn_global_load_lds((const unsigned*)(ga[i] + (k0)),                                  \
        (LAS unsigned*)(base + (buf) * BUF + tid * 16 + i * 4096), 16, 0, 0);                            \
    _Pragma("unroll") for (int i = 0; i < NF; ++i)                                                       \
      __builtin_amdgcn_global_load_lds((const unsigned*)(gb[i] + (k0)),                                  \
        (LAS unsigned*)(base + (buf) * BUF + ABYTES + tid * 16 + i * 4096), 16, 0, 0);                   \
  }
  const int nk = K >> 6;
  STAGE_TILE(0, 0)
  asm volatile("s_waitcnt vmcnt(0)" ::: "memory");
  __syncthreads();
  for (int kt = 0; kt < nk; ++kt) {
    const int buf = kt & 1;
    if (kt + 1 < nk) STAGE_TILE(buf ^ 1, (size_t)(kt + 1) * kadv)
    const unsigned char* as = base + buf * BUF;
    const unsigned char* bs = as + ABYTES;
    bf16x8 af0[4], bf0[NF], af1[4], bf1[NF];
#pragma unroll
    for (int mf = 0; mf < 4; ++mf) af0[mf] = *(const bf16x8*)(as + oa[mf][0]);
#pragma unroll
    for (int nf = 0; nf < NF; ++nf) bf0[nf] = *(const bf16x8*)(bs + ob[nf][0]);
    __builtin_amdgcn_s_setprio(1);
#pragma unroll
    for (int nf = 0; nf < NF / 2; ++nf)
#pragma unroll
      for (int mf = 0; mf < 4; ++mf)
        acc[mf][nf] = __builtin_amdgcn_mfma_f32_16x16x32_bf16(af0[mf], bf0[nf], acc[mf][nf], 0, 0, 0);
    __builtin_amdgcn_s_setprio(0);
#pragma unroll
    for (int mf = 0; mf < 4; ++mf) af1[mf] = *(const bf16x8*)(as + oa[mf][1]);
#pragma unroll
    for (int nf = 0; nf < NF; ++nf) bf1[nf] = *(const bf16x8*)(bs + ob[nf][1]);
    __builtin_amdgcn_s_setprio(1);
#pragma unroll
    for (int nf = NF / 2; nf < NF; ++nf)
#pragma unroll
      for (int mf = 0; mf < 4; ++mf)
        acc[mf][nf] = __builtin_amdgcn_mfma_f32_16x16x32_bf16(af0[mf], bf0[nf], acc[mf][nf], 0, 0, 0);
#pragma unroll
    for (int nf = 0; nf < NF; ++nf)
#pragma unroll
      for (int mf = 0; mf < 4; ++mf)
        acc[mf][nf] = __builtin_amdgcn_mfma_f32_16x16x32_bf16(af1[mf], bf1[nf], acc[mf][nf], 0, 0, 0);
    __builtin_amdgcn_s_setprio(0);
    asm volatile("s_waitcnt vmcnt(0)" ::: "memory");
    __syncthreads();
  }
#undef STAGE_TILE
}

#define TILE_LOOP(total)                                                                      \
  const int _nx = (gridDim.x % 8 == 0) ? 8 : 1;                                              \
  const int _ns = gridDim.x / _nx;                                                           \
  const int _x = blockIdx.x % _nx, _s = blockIdx.x / _nx;                                    \
  const int _per = ((total) + _nx - 1) / _nx;                                                \
  const int _lo = _x * _per;                                                                 \
  const int _hi = min((total), _lo + _per);                                                  \
  for (int t = _lo + _s; t < _hi; t += _ns)

__device__ __forceinline__ void tile_decode(int t, int MT, int NT, int& mt, int& nt) {
  int g = t / (8 * NT), r = t - g * 8 * NT;
  int gs = min(8, MT - g * 8);
  mt = g * 8 + r % gs;
  nt = r / gs;
}

template <int NF>
__device__ __forceinline__ void zero_acc(f32x4 (&acc)[4][NF]) {
#pragma unroll
  for (int i = 0; i < 4; ++i)
#pragma unroll
    for (int j = 0; j < NF; ++j) acc[i][j] = (f32x4){0.f, 0.f, 0.f, 0.f};
}

__device__ __forceinline__ void phase_proj(const Params& P, int l, unsigned char* ldsb) {
  const u16* act = (const u16*)(P.ws + WS_ACT);
  const u16* W = (const u16*)(P.ws + (l == 0 ? 0 : WS_W2) + WS_WIN);
  u16* proj = (u16*)(P.ws + WS_A);
  constexpr int MT = 133, NT = 35;
  TILE_LOOP(MT * NT) {
    int mt, nt; tile_decode(t, MT, NT, mt, nt);
    const int tid_ = otid(), lane = tid_ & 63, w = tid_ >> 6, wm = w >> 1, wn = w & 1, r = lane & 15, q = lane >> 4;
    f32x4 acc[4][4]; zero_acc<4>(acc);
    gemm_core<4>(acc, act + (size_t)mt * 128 * LDA, LDA, W + (size_t)nt * 128 * LDA, LDA, D, (u16*)ldsb);
#pragma unroll
    for (int mf = 0; mf < 4; ++mf)
#pragma unroll
      for (int nf = 0; nf < 4; ++nf) {
        const int col = nt * 128 + wn * 64 + nf * 16 + r;
        if (col < NPJ) {
#pragma unroll
          for (int e = 0; e < 4; ++e) {
            const int row = mt * 128 + wm * 64 + mf * 16 + q * 4 + e;
            proj[(size_t)row * NPJ + col] = (u16)f2bf(acc[mf][nf][e]);
          }
        }
      }
  }
}

__device__ __forceinline__ u16* gate_row(const Params& P, int br, int row) {
  if (br == 0) return (u16*)P.out + (size_t)row * D;
  if (row < G1_SPLIT) return (u16*)P.out + (size_t)M * D + (size_t)row * D;
  return (u16*)(P.ws + WS_G1X) + (size_t)(row - G1_SPLIT) * D;
}

__device__ __forceinline__ void phase_gates(const Params& P, int l, int wb, int nwb, unsigned char* ldsb) {
  const u16* act = (const u16*)(P.ws + WS_ACT);
  const u16* Wg = (const u16*)(P.ws + (l == 0 ? 0 : WS_W2) + WS_WGATE);
  constexpr int MT = 133, NT = 8;
  for (int t = wb; t < 2 * MT * NT; t += nwb) {
    const int br = t / (MT * NT);
    int mt, nt; tile_decode(t - br * MT * NT, MT, NT, mt, nt);
    const int tid_ = otid(), lane = tid_ & 63, w = tid_ >> 6, wm = w >> 1, wn = w & 1, r = lane & 15, q = lane >> 4;
    f32x4 acc[4][4]; zero_acc<4>(acc);
    gemm_core<4>(acc, act + (size_t)mt * 128 * LDA, LDA, Wg + ((size_t)br * 1024 + nt * 128) * LDA, LDA, D, (u16*)ldsb);
#pragma unroll
    for (int mf = 0; mf < 4; ++mf)
#pragma unroll
      for (int e = 0; e < 4; ++e) {
        const int row = mt * 128 + wm * 64 + mf * 16 + q * 4 + e;
        u16* gr = gate_row(P, br, row);
#pragma unroll
        for (int nf = 0; nf < 4; ++nf) gr[nt * 128 + wn * 64 + nf * 16 + r] = (u16)f2bf(sigmoid_f(acc[mf][nf][e]));
      }
  }
}

__device__ __forceinline__ void phase_merge(const Params& P, int l, unsigned char* ldsb) {
  const u16* act = (const u16*)(P.ws + WS_ACT);
  const u16* Wg = (const u16*)(P.ws + (l == 0 ? 0 : WS_W2) + WS_WGATE);
  const u16* Wo = (const u16*)(P.ws + (l == 0 ? 0 : WS_W2) + WS_WOUT);
  const u16* ybr = (const u16*)(P.ws + WS_B);
  const float* ssq = (const float*)(P.ws + WS_SSQ);
  u16* merged = (u16*)(P.ws + WS_A);
  constexpr int MT = 133, NT = 16;
  {
    float* pre = (float*)(P.ws + WS_A + A_PRE);
    for (int i = blockIdx.x * 256 + otid(); i < (M - SPLIT_ROW0) * (D / 4); i += gridDim.x * 256) {
      const int row = SPLIT_ROW0 + i / (D / 4), c = (i % (D / 4)) * 4;
      const uint2 xv = *(const uint2*)(act + (size_t)row * LDA + c);
      *(float4*)(pre + (size_t)row * D + c) = make_float4(ALPHA * __uint_as_float(xv.x << 16), ALPHA * __uint_as_float(xv.x & 0xffff0000u),
                                                          ALPHA * __uint_as_float(xv.y << 16), ALPHA * __uint_as_float(xv.y & 0xffff0000u));
    }
  }
  TILE_LOOP(MT * NT) {
    int mt, nt; tile_decode(t, MT, NT, mt, nt);
    const int tid_ = otid(), lane = tid_ & 63, w = tid_ >> 6, wm = w >> 1, wn = w & 1, r = lane & 15, q = lane >> 4;
    f32x4 fin[4][2]; zero_acc<2>(fin);
#pragma unroll 1
    for (int br = 0; br < 3; ++br) {
      f32x4 g[4][2]; zero_acc<2>(g);
      if (br == 2) {
        gemm_core<2>(g, act + (size_t)mt * 128 * LDA, LDA, Wg + ((size_t)br * 1024 + nt * 64) * LDA, LDA, D, (u16*)ldsb);
#pragma unroll
        for (int mf = 0; mf < 4; ++mf)
#pragma unroll
          for (int nf = 0; nf < 2; ++nf)
#pragma unroll
            for (int e = 0; e < 4; ++e) g[mf][nf][e] = sigmoid_f(g[mf][nf][e]);
      } else {
#pragma unroll
        for (int mf = 0; mf < 4; ++mf)
#pragma unroll
          for (int e = 0; e < 4; ++e) {
            const u16* gr = gate_row(P, br, mt * 128 + wm * 64 + mf * 16 + q * 4 + e) + nt * 64 + wn * 32 + r;
#pragma unroll
            for (int nf = 0; nf < 2; ++nf) g[mf][nf][e] = bf2f(gr[nf * 16]);
          }
      }
      const u16* yb = ybr + (size_t)br * M * LDY + (size_t)mt * 128 * LDY;
      const u16* wb = Wo + (size_t)br * 1024 * LDY + (size_t)nt * 64 * LDY;
      if (br != 1) {
        f32x4 acc[4][2]; zero_acc<2>(acc);
        gemm_core<2>(acc, yb, LDY, wb, LDY, 512, (u16*)ldsb);
#pragma unroll
        for (int mf = 0; mf < 4; ++mf)
#pragma unroll
          for (int nf = 0; nf < 2; ++nf)
#pragma unroll
            for (int e = 0; e < 4; ++e) fin[mf][nf][e] += g[mf][nf][e] * acc[mf][nf][e];
      } else {
#pragma unroll 1
        for (int grp = 0; grp < 2; ++grp) {
          f32x4 acc[4][2]; zero_acc<2>(acc);
          gemm_core<2>(acc, yb + grp * 256, LDY, wb + grp * 256, LDY, 256, (u16*)ldsb);
#pragma unroll
          for (int mf = 0; mf < 4; ++mf)
#pragma unroll
            for (int e = 0; e < 4; ++e) {
              const int row = mt * 128 + wm * 64 + mf * 16 + q * 4 + e;
              float4 s4 = *(const float4*)(ssq + (size_t)row * 8 + grp * 4);
              float rs = rsqrtf((s4.x + s4.y + s4.z + s4.w) * (1.f / 256.f) + 1e-6f);
#pragma unroll
              for (int nf = 0; nf < 2; ++nf) fin[mf][nf][e] += g[mf][nf][e] * rs * acc[mf][nf][e];
            }
        }
      }
    }
#pragma unroll
    for (int mf = 0; mf < 4; ++mf)
#pragma unroll
      for (int nf = 0; nf < 2; ++nf)
#pragma unroll
        for (int e = 0; e < 4; ++e) {
          const int row = mt * 128 + wm * 64 + mf * 16 + q * 4 + e;
          const int col = nt * 64 + wn * 32 + nf * 16 + r;
          merged[(size_t)row * LDA + col] = (u16)f2bf(fin[mf][nf][e]);
        }
  }
}

__device__ __forceinline__ void phase_resid(const Params& P, int mode, int l, unsigned char* ldsb) {
  const u16* act = (const u16*)(P.ws + WS_ACT);
  const u16* A = (const u16*)(P.ws + WS_A);
  const int K = mode == 0 ? 1024 : 4096;
  const int ldk = mode == 0 ? LDA : LDH;
  const u16* W = (const u16*)(P.ws + (mode == 0 ? (l == 0 ? 0 : WS_W2) + WS_WO : WS_WFF2));
  float* dst = mode == 0 ? (float*)(P.ws + WS_A + A_PRE) : (float*)(P.ws + WS_B);
  const float* bias = P.in[28] + l * D;
  constexpr int MT = 128, NT = 8;
  TILE_LOOP(MT * NT) {
    int mt, nt; tile_decode(t, MT, NT, mt, nt);
    const int tid_ = otid(), lane = tid_ & 63, w = tid_ >> 6, wm = w >> 1, wn = w & 1, r = lane & 15, q = lane >> 4;
    f32x4 acc[4][4]; zero_acc<4>(acc);
    if (mode == 0) gemm_core<4>(acc, A + (size_t)mt * 128 * ldk, ldk, W + (size_t)nt * 128 * ldk, ldk, K, (u16*)ldsb);
    else gemm_core<4>(acc, A + (size_t)mt * 64 * 8192, 64, W + (size_t)nt * 64 * 8192, 64, K, (u16*)ldsb, 8192);
#pragma unroll
    for (int mf = 0; mf < 4; ++mf)
#pragma unroll
      for (int nf = 0; nf < 4; ++nf) {
        const int col = nt * 128 + wn * 64 + nf * 16 + r;
        const float bb = mode == 1 ? bias[col] : 0.f;
#pragma unroll
        for (int e = 0; e < 4; ++e) {
          const int row = mt * 128 + wm * 64 + mf * 16 + q * 4 + e;
          dst[(size_t)row * D + col] = ALPHA * bf2f(act[(size_t)row * LDA + col]) + acc[mf][nf][e] + bb;
        }
      }
  }
  {
    constexpr int S = 8;
    const int KS = K / S;
    for (int li = blockIdx.x; li < 40 * S; li += gridDim.x) {
      const int sl = li % S, tl = li / S;
      const int mt = 128 + tl / 8, nt = tl % 8;
      const int tid_ = otid(), lane = tid_ & 63, w = tid_ >> 6, wm = w >> 1, wn = w & 1, r = lane & 15, q = lane >> 4;
      f32x4 acc[4][4]; zero_acc<4>(acc);
      if (mode == 0) gemm_core<4>(acc, A + (size_t)mt * 128 * ldk + sl * KS, ldk, W + (size_t)nt * 128 * ldk + sl * KS, ldk, KS, (u16*)ldsb);
      else gemm_core<4>(acc, A + ((size_t)mt * 64 + sl * (KS / 64)) * 8192, 64, W + ((size_t)nt * 64 + sl * (KS / 64)) * 8192, 64, KS, (u16*)ldsb, 8192);
#pragma unroll
      for (int mf = 0; mf < 4; ++mf)
#pragma unroll
        for (int nf = 0; nf < 4; ++nf) {
          const int col = nt * 128 + wn * 64 + nf * 16 + r;
#pragma unroll
          for (int e = 0; e < 4; ++e) {
            const int row = mt * 128 + wm * 64 + mf * 16 + q * 4 + e;
            (void)__hip_atomic_fetch_add(dst + (size_t)row * D + col, acc[mf][nf][e], __ATOMIC_RELAXED, __HIP_MEMORY_SCOPE_AGENT);
          }
        }
    }
  }
}

__device__ __forceinline__ void phase_ff1(const Params& P, int l, unsigned char* ldsb) {
  const u16* act = (const u16*)(P.ws + WS_ACT);
  const u16* W = (const u16*)(P.ws + WS_WFF1);
  u16* hid = (u16*)(P.ws + WS_A);
  const float* bias = P.in[26] + l * 4096;
  constexpr int MT = 133, NT = 32;
  TILE_LOOP(MT * NT) {
    int mt, nt; tile_decode(t, MT, NT, mt, nt);
    const int tid_ = otid(), lane = tid_ & 63, w = tid_ >> 6, wm = w >> 1, wn = w & 1, r = lane & 15, q = lane >> 4;
    f32x4 acc[4][4]; zero_acc<4>(acc);
    gemm_core<4>(acc, act + (size_t)mt * 128 * LDA, LDA, W + (size_t)nt * 128 * LDA, LDA, D, (u16*)ldsb);
#pragma unroll
    for (int mf = 0; mf < 4; ++mf)
#pragma unroll
      for (int nf = 0; nf < 4; ++nf) {
        const int col = nt * 128 + wn * 64 + nf * 16 + r;
        const float bb = bias[col];
#pragma unroll
        for (int e = 0; e < 4; ++e) {
          const int row = mt * 128 + wm * 64 + mf * 16 + q * 4 + e;
          float v = fmaxf(acc[mf][nf][e] + bb, 0.f);
          hid[((size_t)(row >> 7) * 64 + (col >> 6)) * 8192 + (row & 127) * 64 + (col & 63)] = (u16)f2bf(v * v);
        }
      }
  }
}

template <int BR>
__device__ __forceinline__ void rec_item(const Params& P, int l, int b, int h, int sample, unsigned char* ldsb) {
  constexpr int DV = (BR == 1) ? 64 : 128;
  constexpr int NFV = DV / 16;
  constexpr int NH = (BR == 1) ? 8 : 4;
  constexpr int OLD = DV + 4;
  constexpr int NEP = DV / 32;
  u16* QA = (u16*)ldsb;
  u16* KB = QA + 64 * LDT;
  u16* KT = KB + 64 * LDT;
  u16* ATT = KT + 64 * LDT;
  u16* VT = ATT + 64 * LDT;
  u16* ST = VT + 128 * LDT;
  float* Gsc = (float*)(ST + 128 * LDT);
  float* dec = Gsc + 64;
  float* dtv = dec + 64;
  float* psum = dtv + 64;
  float* invf = psum + 256;
  float* Gl = (float*)ST;
  float* AL = (float*)ATT;
  float* OST = (float*)ldsb;
  u16* XH = VT + 64 * LDT;

  const int tid = otid(), lane = tid & 63, w = tid >> 6, r = lane & 15, q = lane >> 4;
  const int T = sample ? 4 : TP;
  const int row0 = sample ? MP + b * 4 : b * TP;
  const int pos0 = sample ? 16384 : 0;
  const u16* proj = (const u16*)(P.ws + WS_A);
  u16* ybr = (u16*)(P.ws + WS_B) + (size_t)BR * M * LDY;
  float* ssq = (float*)(P.ws + WS_SSQ);

  float lg = 0.f, aneg = 0.f, dtb = 0.f, dsk = 0.f;
  if (BR == 2) {
    lg = log1pf(-exp2f(-5.f - (float)h));
    if (tid < 32) invf[tid] = exp2f(-(float)tid * (13.287712379549449f / 32.0f));
  }
  if (BR == 1) {
    aneg = -__expf(P.in[16][l * 8 + h]);
    dtb = P.in[15][l * 8 + h];
    dsk = P.in[17][l * 8 + h];
  }
  const int grp = h >> 2;

  f32x4 S[NFV];
  {
    const float* sin_ = P.in[2];
    if (sample) {
      const float* base = BR == 0 ? P.in[2] : (BR == 1 ? P.in[3] : P.in[5]);
      sin_ = base + ((size_t)(l * 128 + b) * NH + h) * 64 * DV;
    }
#pragma unroll
    for (int nf = 0; nf < NFV; ++nf)
#pragma unroll
      for (int e = 0; e < 4; ++e) {
        float v = sin_[(size_t)(16 * w + q * 4 + e) * DV + nf * 16 + r];
        S[nf][e] = sample ? v : 0.f;
      }
  }
  __syncthreads();

  uint4 Rg[NEP], RgN[NEP];
  uint4 Rq[2], Rk[2], Rv[4], Ral;
  uint4 Rq1, Rq2, Rk1, Rk2;
  uint4 Rx[11];
  float dtraw = 0.f;
  const int ci = tid & 63, part = tid >> 6;
  float w2r[16];
  float bias = 0.f;
  if (BR == 0) {
#pragma unroll
    for (int rr = 0; rr < 16; ++rr) w2r[rr] = P.in[10][(size_t)(l * 16 + rr) * 256 + h * 64 + ci];
    bias = P.in[11][l * 256 + h * 64 + ci];
  }
  const int cc = tid >> 3, ts = tid & 7;
  const bool act = tid < 192;
  const int seg = cc >> 3, c8 = (cc & 7) * 8;
  const int chan = seg == 0 ? h * 64 + c8 : (seg == 1 ? 512 + grp * 64 + c8 : 640 + grp * 64 + c8);
  float cwv[4][8], cbv[8];
  if (BR == 1 && act) {
    const float* cw = P.in[13] + (size_t)l * 4 * 768 + chan;
    const float* cb = P.in[14] + (size_t)l * 768 + chan;
#pragma unroll
    for (int i = 0; i < 4; ++i) {
      *(float4*)&cwv[i][0] = *(const float4*)(cw + i * 768);
      *(float4*)&cwv[i][4] = *(const float4*)(cw + i * 768 + 4);
    }
    *(float4*)&cbv[0] = *(const float4*)cb;
    *(float4*)&cbv[4] = *(const float4*)(cb + 4);
  }
#define REC_LOAD(CB, RGD)                                                                                     \
  {                                                                                                           \
    const int goff_ = BR == 0 ? 1024 + h * 128 : (BR == 1 ? 1552 + h * 64 : 3864 + h * 128);                  \
    _Pragma("unroll") for (int it = 0; it < NEP; ++it) {                                                      \
      const int id = tid + 256 * it;                                                                          \
      const int t = (DV == 128) ? (id >> 4) : (id >> 3);                                                      \
      const int j0 = (DV == 128) ? (id & 15) * 8 : (id & 7) * 8;                                              \
      RGD[it] = *(const uint4*)(proj + (size_t)(row0 + min((CB) + t, T - 1)) * NPJ + goff_ + j0);             \
    }                                                                                                         \
    if (BR == 0) {                                                                                            \
      _Pragma("unroll") for (int it = 0; it < 2; ++it) {                                                      \
        const int id = tid + 256 * it;                                                                        \
        const int t = id >> 3, i0 = (id & 7) * 8;                                                             \
        const u16* rp = proj + (size_t)(row0 + min((CB) + t, T - 1)) * NPJ + h * 64 + i0;                     \
        Rq[it] = *(const uint4*)rp;                                                                           \
        Rk[it] = *(const uint4*)(rp + 256);                                                                   \
      }                                                                                                       \
      { const int t = (tid & 127) >> 1, hf = tid & 1;                                                         \
        Ral = *(const uint4*)(proj + (size_t)(row0 + min((CB) + t, T - 1)) * NPJ + 1536 + hf * 8); }          \
    }                                                                                                         \
    if (BR == 2) {                                                                                            \
      const int t = tid >> 2, i0 = (tid & 3) * 8;                                                             \
      const u16* rp = proj + (size_t)(row0 + min((CB) + t, T - 1)) * NPJ + 2840 + h * 64 + i0;                \
      Rq1 = *(const uint4*)rp; Rq2 = *(const uint4*)(rp + 32);                                                \
      Rk1 = *(const uint4*)(rp + 256); Rk2 = *(const uint4*)(rp + 288);                                       \
    }                                                                                                         \
    if (BR == 1) {                                                                                            \
      if (act) {                                                                                              \
        _Pragma("unroll") for (int k = 0; k < 11; ++k) {                                                      \
          int tau = (CB) + ts * 8 - 3 + k;                                                                    \
          tau = min(max(tau, 0), T - 1);                                                                      \
          Rx[k] = *(const uint4*)(proj + (size_t)(row0 + tau) * NPJ + 2064 + chan);                           \
        }                                                                                                     \
      }                                                                                                       \
      if (w == 0) dtraw = bf2f(proj[(size_t)(row0 + min((CB) + lane, T - 1)) * NPJ + 2832 + h]);              \
    }                                                                                                         \
  }
  REC_LOAD(0, Rg)

  for (int c0 = 0; c0 < T; c0 += 64) {
    const int nvalid = min(64, T - c0);
    if (BR == 0 || BR == 2) {
      const int voff_ = (BR == 0 ? 512 : 3352) + h * 128;
#pragma unroll
      for (int it = 0; it < 4; ++it) {
        const int id = tid + 256 * it;
        const int t = id >> 4, j0 = (id & 15) * 8;
        Rv[it] = *(const uint4*)(proj + (size_t)(row0 + min(c0 + t, T - 1)) * NPJ + voff_ + j0);
      }
    }
    if (BR == 0) {
      if (tid < 128) {
        const int t = tid >> 1, hf = tid & 1;
        float a8[8];
        unpack8(Ral, a8);
        *(float4*)(AL + t * 16 + hf * 8) = make_float4(a8[0], a8[1], a8[2], a8[3]);
        *(float4*)(AL + t * 16 + hf * 8 + 4) = make_float4(a8[4], a8[5], a8[6], a8[7]);
      }
      __syncthreads();
      {
        float run = 0.f;
#pragma unroll 4
        for (int tt = 0; tt < 16; ++tt) {
          const int t = part * 16 + tt;
          const float4 x0 = *(const float4*)(AL + t * 16), x1 = *(const float4*)(AL + t * 16 + 4);
          const float4 x2 = *(const float4*)(AL + t * 16 + 8), x3 = *(const float4*)(AL + t * 16 + 12);
          float a = bias;
          a += x0.x * w2r[0] + x0.y * w2r[1] + x0.z * w2r[2] + x0.w * w2r[3];
          a += x1.x * w2r[4] + x1.y * w2r[5] + x1.z * w2r[6] + x1.w * w2r[7];
          a += x2.x * w2r[8] + x2.y * w2r[9] + x2.z * w2r[10] + x2.w * w2r[11];
          a += x3.x * w2r[12] + x3.y * w2r[13] + x3.z * w2r[14] + x3.w * w2r[15];
          float g = (fminf(a, 0.f) - log1pf(__expf(-fabsf(a)))) * (1.f / 16.f);
          if (t >= nvalid) g = 0.f;
          run += g;
          Gl[t * 64 + ci] = run;
        }
        psum[part * 64 + ci] = run;
      }
      __syncthreads();
      {
        float off = 0.f;
        for (int p = 0; p < part; ++p) off += psum[p * 64 + ci];
#pragma unroll 4
        for (int tt = 0; tt < 16; ++tt) Gl[(part * 16 + tt) * 64 + ci] += off;
      }
      __syncthreads();
#pragma unroll
      for (int it = 0; it < 2; ++it) {
        const int id = tid + 256 * it;
        const int t = id >> 3, i0 = (id & 7) * 8;
        const bool valid = t < nvalid;
        float qf[8], kf[8], G[8], Ge[8], qa[8], kb[8];
        unpack8(Rq[it], qf); unpack8(Rk[it], kf);
        *(float4*)&G[0] = *(const float4*)(Gl + t * 64 + i0);
        *(float4*)&G[4] = *(const float4*)(Gl + t * 64 + i0 + 4);
        *(float4*)&Ge[0] = *(const float4*)(Gl + 63 * 64 + i0);
        *(float4*)&Ge[4] = *(const float4*)(Gl + 63 * 64 + i0 + 4);
#pragma unroll
        for (int e = 0; e < 8; ++e) {
          const float qv = valid ? qf[e] : 0.f, kv = valid ? kf[e] : 0.f;
          qa[e] = qv * 0.125f * __expf(G[e]);
          kb[e] = kv * __expf(-G[e]);
          KT[tsw(i0 + e, t)] = (u16)f2bf(kv * __expf(Ge[e] - G[e]));
        }
        *(uint4*)(QA + t * LDT + i0) = pack8(qa);
        *(uint4*)(KB + t * LDT + i0) = pack8(kb);
        if (t == 63) {
#pragma unroll
          for (int e = 0; e < 8; ++e) dec[i0 + e] = __expf(Ge[e]);
        }
        __builtin_amdgcn_sched_barrier(0);
      }
#pragma unroll
      for (int it = 0; it < 4; ++it) {
        const int id = tid + 256 * it;
        const int t = id >> 4, j0 = (id & 15) * 8;
        uint4 v4 = Rv[it];
        if (t >= nvalid) v4 = make_uint4(0, 0, 0, 0);
        VT[tsw(j0 + 0, t)] = (u16)(v4.x & 0xffffu); VT[tsw(j0 + 1, t)] = (u16)(v4.x >> 16);
        VT[tsw(j0 + 2, t)] = (u16)(v4.y & 0xffffu); VT[tsw(j0 + 3, t)] = (u16)(v4.y >> 16);
        VT[tsw(j0 + 4, t)] = (u16)(v4.z & 0xffffu); VT[tsw(j0 + 5, t)] = (u16)(v4.z >> 16);
        VT[tsw(j0 + 6, t)] = (u16)(v4.w & 0xffffu); VT[tsw(j0 + 7, t)] = (u16)(v4.w >> 16);
      }
      if (tid < 64) Gsc[tid] = 0.f;
    }
    if (BR == 2) {
      {
        const int t = tid >> 2, i0 = (tid & 3) * 8;
        const bool valid = t < nvalid;
        float q1f[8], q2f[8], k1f[8], k2f[8], o1[8], o2[8], p1[8], p2[8];
        unpack8(Rq1, q1f); unpack8(Rq2, q2f); unpack8(Rk1, k1f); unpack8(Rk2, k2f);
        const float pos = (float)(pos0 + c0 + t);
        const float ed = __expf(lg * (float)(nvalid - min(t + 1, nvalid)));
#pragma unroll
        for (int e = 0; e < 8; ++e) {
          const float ang = pos * invf[i0 + e];
          double rev = (double)ang * 0.15915494309189535;
          rev -= floor(rev);
          const float rf = (float)rev;
          const float sn = __builtin_amdgcn_sinf(rf), cs = __builtin_amdgcn_cosf(rf);
          const float a1 = valid ? q1f[e] : 0.f, a2 = valid ? q2f[e] : 0.f;
          const float b1 = valid ? k1f[e] : 0.f, b2 = valid ? k2f[e] : 0.f;
          o1[e] = a1 * cs - a2 * sn;
          o2[e] = a1 * sn + a2 * cs;
          p1[e] = (b1 * cs - b2 * sn) * 0.125f;
          p2[e] = (b1 * sn + b2 * cs) * 0.125f;
          KT[tsw(i0 + e, t)] = (u16)f2bf(p1[e] * ed);
          KT[tsw(32 + i0 + e, t)] = (u16)f2bf(p2[e] * ed);
        }
        *(uint4*)(QA + t * LDT + i0) = pack8(o1);
        *(uint4*)(QA + t * LDT + 32 + i0) = pack8(o2);
        *(uint4*)(KB + t * LDT + i0) = pack8(p1);
        *(uint4*)(KB + t * LDT + 32 + i0) = pack8(p2);
      }
#pragma unroll
      for (int it = 0; it < 4; ++it) {
        const int id = tid + 256 * it;
        const int t = id >> 4, j0 = (id & 15) * 8;
        uint4 v4 = Rv[it];
        if (t >= nvalid) v4 = make_uint4(0, 0, 0, 0);
        VT[tsw(j0 + 0, t)] = (u16)(v4.x & 0xffffu); VT[tsw(j0 + 1, t)] = (u16)(v4.x >> 16);
        VT[tsw(j0 + 2, t)] = (u16)(v4.y & 0xffffu); VT[tsw(j0 + 3, t)] = (u16)(v4.y >> 16);
        VT[tsw(j0 + 4, t)] = (u16)(v4.z & 0xffffu); VT[tsw(j0 + 5, t)] = (u16)(v4.z >> 16);
        VT[tsw(j0 + 6, t)] = (u16)(v4.w & 0xffffu); VT[tsw(j0 + 7, t)] = (u16)(v4.w >> 16);
      }
      if (tid < 64) {
        Gsc[tid] = lg * (float)min(tid + 1, nvalid);
        dec[tid] = __expf(lg * (float)nvalid);
      }
    }
    if (BR == 1) {
      if (w == 0) {
        float dt = 0.f, g = 0.f;
        if (lane < nvalid) {
          dt = softplus_f(dtraw + dtb);
          g = dt * aneg;
        }
        float x = g;
#pragma unroll
        for (int o = 1; o < 64; o <<= 1) {
          float y = __shfl_up(x, o);
          if (lane >= o) x += y;
        }
        const float ge = __shfl(x, 63);
        Gsc[lane] = x; dtv[lane] = dt; dec[lane] = __expf(ge); psum[lane] = __expf(ge - x);
      }
      __syncthreads();
      if (act) {
        const bool first = (c0 == 0 && ts == 0);
        const float* cst = P.in[4] + (size_t)(l * 128 + b) * 3 * 768 + chan;
#pragma unroll
        for (int p = 0; p < 4; ++p) {
          float x0[11], x1[11];
#pragma unroll
          for (int k = 0; k < 11; ++k) {
            const unsigned wd = p == 0 ? Rx[k].x : (p == 1 ? Rx[k].y : (p == 2 ? Rx[k].z : Rx[k].w));
            x0[k] = __uint_as_float(wd << 16);
            x1[k] = __uint_as_float(wd & 0xffff0000u);
          }
          if (first) {
#pragma unroll
            for (int k = 0; k < 3; ++k) {
              const float2 sv = *(const float2*)(cst + k * 768 + 2 * p);
              x0[k] = sample ? sv.x : 0.f;
              x1[k] = sample ? sv.y : 0.f;
            }
          }
          float o0[8], o1[8];
#pragma unroll
          for (int tt = 0; tt < 8; ++tt) {
            const bool valid = (ts * 8 + tt) < nvalid;
            float a0 = cbv[2 * p], a1 = cbv[2 * p + 1];
#pragma unroll
            for (int i = 0; i < 4; ++i) { a0 += cwv[i][2 * p] * x0[tt + i]; a1 += cwv[i][2 * p + 1] * x1[tt + i]; }
            o0[tt] = valid ? silu_f(a0) : 0.f;
            o1[tt] = valid ? silu_f(a1) : 0.f;
          }
          u16* rowdst = seg == 0 ? XH : (seg == 1 ? KB : QA);
#pragma unroll
          for (int tt = 0; tt < 8; ++tt) *(unsigned*)(rowdst + (ts * 8 + tt) * LDT + c8 + 2 * p) = pack2(o0[tt], o1[tt]);
          if (seg < 2) {
            const float* sc = seg == 0 ? dtv : psum;
            u16* cdst = seg == 0 ? VT : KT;
            float c0v[8], c1v[8];
#pragma unroll
            for (int tt = 0; tt < 8; ++tt) { const float f = sc[ts * 8 + tt]; c0v[tt] = o0[tt] * f; c1v[tt] = o1[tt] * f; }
            *(uint4*)(cdst + tsw(c8 + 2 * p, ts * 8)) = pack8(c0v);
            *(uint4*)(cdst + tsw(c8 + 2 * p + 1, ts * 8)) = pack8(c1v);
          }
          __builtin_amdgcn_sched_barrier(0);
        }
      }
    }
    __syncthreads();
    if (c0 + 64 < T) { REC_LOAD(c0 + 64, RgN) }

#pragma unroll
    for (int nf = 0; nf < NFV; ++nf)
      *(uint2*)(ST + (nf * 16 + r) * LDT + 16 * w + q * 4) = make_uint2(pack2(S[nf][0], S[nf][1]), pack2(S[nf][2], S[nf][3]));

    bf16x8 aq[2];
    aq[0] = *(const bf16x8*)(QA + (16 * w + r) * LDT + q * 8);
    aq[1] = *(const bf16x8*)(QA + (16 * w + r) * LDT + 32 + q * 8);
    float gt[4];
#pragma unroll
    for (int e = 0; e < 4; ++e) gt[e] = Gsc[16 * w + q * 4 + e];
#pragma unroll
    for (int n = 0; n < 4; ++n) {
      f32x4 a = (f32x4){0.f, 0.f, 0.f, 0.f};
      if (n <= w) {
#pragma unroll
        for (int kk = 0; kk < 2; ++kk) {
          bf16x8 bk = *(const bf16x8*)(KB + (16 * n + r) * LDT + kk * 32 + q * 8);
          a = __builtin_amdgcn_mfma_f32_16x16x32_bf16(aq[kk], bk, a, 0, 0, 0);
        }
      }
      const int s = 16 * n + r;
      const float gs = Gsc[s];
#pragma unroll
      for (int e = 0; e < 4; ++e) {
        const int t = 16 * w + q * 4 + e;
        float v = (s <= t) ? a[e] * __expf(gt[e] - gs) : 0.f;
        ATT[t * LDT + s] = (u16)f2bf(v);
      }
    }
    __syncthreads();

    f32x4 O[NFV];
#pragma unroll
    for (int nf = 0; nf < NFV; ++nf) O[nf] = (f32x4){0.f, 0.f, 0.f, 0.f};
#pragma unroll
    for (int kk = 0; kk < 2; ++kk)
#pragma unroll
      for (int nf = 0; nf < NFV; ++nf) {
        bf16x8 bs = *(const bf16x8*)(ST + (nf * 16 + r) * LDT + kk * 32 + q * 8);
        O[nf] = __builtin_amdgcn_mfma_f32_16x16x32_bf16(aq[kk], bs, O[nf], 0, 0, 0);
      }
    if (BR != 0) {
#pragma unroll
      for (int e = 0; e < 4; ++e) {
        const float sc = __expf(gt[e]);
#pragma unroll
        for (int nf = 0; nf < NFV; ++nf) O[nf][e] *= sc;
      }
    }
    {
      float dc[4];
#pragma unroll
      for (int e = 0; e < 4; ++e) dc[e] = dec[16 * w + q * 4 + e];
#pragma unroll
      for (int nf = 0; nf < NFV; ++nf)
#pragma unroll
        for (int e = 0; e < 4; ++e) S[nf][e] *= dc[e];
    }
    int vtb[2], ktb[2];
    vtb[0] = r * LDT + ((q ^ (r >> 3)) << 3);
    vtb[1] = r * LDT + ((q ^ (2 + (r >> 3))) << 3);
    ktb[0] = tsw(16 * w + r, q * 8);
    ktb[1] = tsw(16 * w + r, 32 + q * 8);
#pragma unroll
    for (int kk = 0; kk < 2; ++kk) {
      bf16x8 at = *(const bf16x8*)(ATT + (16 * w + r) * LDT + kk * 32 + q * 8);
      bf16x8 ak = *(const bf16x8*)(KT + ktb[kk]);
#pragma unroll
      for (int nf = 0; nf < NFV; ++nf) {
        bf16x8 bv = *(const bf16x8*)(VT + vtb[nf & 1] + nf * 16 * LDT + ((kk ^ ((nf >> 1) & 1)) * 32));
        O[nf] = __builtin_amdgcn_mfma_f32_16x16x32_bf16(at, bv, O[nf], 0, 0, 0);
        S[nf] = __builtin_amdgcn_mfma_f32_16x16x32_bf16(ak, bv, S[nf], 0, 0, 0);
      }
    }
    __syncthreads();
#pragma unroll
    for (int nf = 0; nf < NFV; ++nf)
#pragma unroll
      for (int e = 0; e < 4; ++e) OST[(16 * w + q * 4 + e) * OLD + nf * 16 + r] = O[nf][e];
    __syncthreads();

#pragma unroll
    for (int it = 0; it < NEP; ++it) {
      const int id = tid + 256 * it;
      const int t = (DV == 128) ? (id >> 4) : (id >> 3);
      const int j0 = (DV == 128) ? (id & 15) * 8 : (id & 7) * 8;
      const bool valid = t < nvalid;
      const size_t row = (size_t)(row0 + c0 + t);
      float ov[8], gv[8], y[8];
      *(float4*)&ov[0] = *(const float4*)(OST + t * OLD + j0);
      *(float4*)&ov[4] = *(const float4*)(OST + t * OLD + j0 + 4);
      unpack8(Rg[it], gv);
      if (BR == 1) {
        float xh[8];
        unpack8(*(const uint4*)(XH + t * LDT + j0), xh);
        float ss = 0.f;
#pragma unroll
        for (int e = 0; e < 8; ++e) { y[e] = (ov[e] + dsk * xh[e]) * silu_f(gv[e]); ss += y[e] * y[e]; }
        ss += __shfl_xor(ss, 1); ss += __shfl_xor(ss, 2); ss += __shfl_xor(ss, 4);
        if (valid) {
          *(uint4*)(ybr + row * LDY + h * 64 + j0) = pack8(y);
          if ((tid & 7) == 0) ssq[row * 8 + h] = ss;
        }
      } else {
        float ss = 0.f;
#pragma unroll
        for (int e = 0; e < 8; ++e) ss += ov[e] * ov[e];
        ss += __shfl_xor(ss, 1); ss += __shfl_xor(ss, 2); ss += __shfl_xor(ss, 4); ss += __shfl_xor(ss, 8);
        const float rs = rsqrtf(ss * (1.f / 128.f) + 1e-6f);
        if (BR == 0) {
          const float* wn = P.in[12] + l * 128 + j0;
          const float4 w0 = *(const float4*)wn, w1 = *(const float4*)(wn + 4);
          const float wv[8] = {w0.x, w0.y, w0.z, w0.w, w1.x, w1.y, w1.z, w1.w};
#pragma unroll
          for (int e = 0; e < 8; ++e) y[e] = silu_f(gv[e]) * ov[e] * rs * wv[e];
        } else {
#pragma unroll
          for (int e = 0; e < 8; ++e) y[e] = silu_f(gv[e]) * ov[e] * rs;
        }
        if (valid) *(uint4*)(ybr + row * LDY + h * 128 + j0) = pack8(y);
      }
      __builtin_amdgcn_sched_barrier(0);
    }
#pragma unroll
    for (int it = 0; it < NEP; ++it) Rg[it] = RgN[it];
    __syncthreads();
  }
#undef REC_LOAD

  {
    float* so;
    if (sample) so = P.out + (BR == 0 ? O_SGS : (BR == 1 ? O_SSS : O_SRS)) + ((size_t)(l * 128 + b) * NH + h) * 64 * DV;
    else so = P.out + (BR == 0 ? O_SGP : (BR == 1 ? O_SSP : O_SRP)) + ((size_t)(l * 8 + b) * NH + h) * 64 * DV;
#pragma unroll
    for (int nf = 0; nf < NFV; ++nf)
#pragma unroll
      for (int e = 0; e < 4; ++e) so[(size_t)(16 * w + q * 4 + e) * DV + nf * 16 + r] = S[nf][e];
  }
}

#ifndef REC_ONLY
#define REC_ONLY -1
#endif
template <int BR>
__device__ __forceinline__ void rec_branch(const Params& P, int l, bool split, int wb, int nwb, int lb0, unsigned char* ldsb) {
  if (!(REC_ONLY < 0 || REC_ONLY == BR)) return;
  constexpr int NH = (BR == 1) ? 8 : 4;
  constexpr int nl = 8 * NH;
  const int end = nl + 128 * NH;
  int it, step;
  if (split) {
    const int bx = blockIdx.x;
    if (bx >= lb0 && bx < lb0 + nl) { it = bx - lb0; step = 1 << 20; }
    else if (bx >= 128) { it = nl + wb; step = nwb; }
    else { it = end; step = 1; }
  } else { it = blockIdx.x; step = gridDim.x; }
  for (; it < end; it += step) {
    const int sample = it >= nl;
    const int idx = sample ? it - nl : it;
    int ll = l;
    asm volatile("" : "+s"(ll));
    rec_item<BR>(P, ll, idx / NH, idx % NH, sample, ldsb);
  }
}

__device__ __forceinline__ void phase_rec(const Params& P, int l, unsigned char* ldsb) {
  const int G = gridDim.x;
  const u16* proj = (const u16*)(P.ws + WS_A);
  const bool split = (G >= 256);
  const int wb = split ? (int)blockIdx.x - 128 : (int)blockIdx.x;
  int nwb = split ? G - 128 : G;
  asm volatile("" : "+s"(nwb));
  if (wb >= 0) {
    for (int i = wb * 256 + otid(); i < (8 + 128) * 3 * 768; i += nwb * 256) {
      const bool pr = i < 8 * 3 * 768;
      const int j = pr ? i : i - 8 * 3 * 768;
      const int b = j / (3 * 768), rem = j - b * 3 * 768, rr = rem / 768, c = rem - rr * 768;
      const size_t row = pr ? (size_t)(b * TP + 2061 + rr) : (size_t)(MP + b * 4 + 1 + rr);
      const size_t oo = pr ? O_SCP + (size_t)l * 8 * 3 * 768 + j : O_SCS + (size_t)l * 128 * 3 * 768 + j;
      P.out[oo] = bf2f(proj[row * NPJ + 2064 + c]);
    }
  }
  rec_branch<0>(P, l, split, wb, nwb, 0, ldsb);
  rec_branch<1>(P, l, split, wb, nwb, 32, ldsb);
  rec_branch<2>(P, l, split, wb, nwb, 96, ldsb);
  if (wb >= 0) {
    __syncthreads();
    if (l == 0) {
      convert_layer(P, 0, ldsb, 1888, 4576, wb, nwb);
      convert_layer(P, 1, ldsb, 0, 2528, wb, nwb);
    } else {
      convert_layer(P, 1, ldsb, 2528, 4576, wb, nwb);
    }
    phase_gates(P, l, wb, nwb, ldsb);
  }
}


#define XB_TMO      128
#define XB_XCNT(j)  (256  + 64 * (j))
#define XB_XSUB(j)  (1280 + 64 * (j))
#define XB_XGEN(j)  (2304 + 64 * (j))
#define XB_TOP      3328
#define XB_TOPGEN   3392
#define XCD_BAR_WORDS 3456
#define XB_SPIN_CAP (1u << 22)
__device__ __forceinline__ unsigned xb_ld(unsigned* p) { return __hip_atomic_load(p, __ATOMIC_RELAXED, __HIP_MEMORY_SCOPE_AGENT); }
__device__ __forceinline__ unsigned xb_add(unsigned* p, unsigned v) { return __hip_atomic_fetch_add(p, v, __ATOMIC_RELAXED, __HIP_MEMORY_SCOPE_AGENT); }
__device__ __forceinline__ unsigned xb_xcc_id() { return (unsigned)__builtin_amdgcn_s_getreg((3 << 11) | 20) & 0xFu; }
#define XB_SPIN(cond, bar) do { unsigned _sp = 0; while (cond) { __builtin_amdgcn_s_sleep(1); \
    if ((++_sp & 255u) == 0u) { if (xb_ld(&(bar)[XB_TMO])) break; if (_sp > XB_SPIN_CAP) { atomicAdd(&(bar)[XB_TMO], 1u); break; } } } } while (0)
struct XcdBarrier { unsigned* bar; unsigned x; volatile LAS unsigned* st; };
__device__ __forceinline__ XcdBarrier xcd_barrier_post(unsigned* bar, volatile LAS unsigned* st) {
  XcdBarrier b; b.bar = bar; b.x = xb_xcc_id(); b.st = st;
  if (threadIdx.x == 0) (void)xb_add(&bar[XB_XCNT(b.x)], 1u);
  return b;
}
__device__ __forceinline__ void xcd_barrier_complete(unsigned* bar, unsigned x, unsigned& nloc, unsigned& nx) {
  const unsigned G = gridDim.x * gridDim.y * gridDim.z;
  unsigned sum, cnt, mine, sp = 0u;
  for (;;) {
    sum = 0u; cnt = 0u; mine = 0u;
#pragma unroll
    for (unsigned j = 0; j < 16; ++j) { const unsigned c = xb_ld(&bar[XB_XCNT(j)]); sum += c; cnt += (c > 0u) ? 1u : 0u; mine = (j == x) ? c : mine; }
    if (sum == G) break;
    __builtin_amdgcn_s_sleep(1);
    if ((++sp & 255u) == 0u) { if (xb_ld(&bar[XB_TMO])) break; if (sp > XB_SPIN_CAP) { atomicAdd(&bar[XB_TMO], 1u); break; } }
  }
  nloc = mine > 0u ? mine : 1u; nx = cnt > 0u ? cnt : 1u;
}
__device__ __forceinline__ void xcd_barrier(const XcdBarrier& b) {
  asm volatile("s_waitcnt vmcnt(0)" ::: "memory");
  __syncthreads();
  if (threadIdx.x == 0) {
    unsigned* bar = b.bar;
    __builtin_amdgcn_s_waitcnt(0);
    unsigned nloc = b.st[0], nx = b.st[1];
    if (nloc == 0u) { xcd_barrier_complete(bar, b.x, nloc, nx); b.st[0] = nloc; b.st[1] = nx; }
    const unsigned old = xb_add(&bar[XB_XSUB(b.x)], 1u);
    const unsigned gen = old / nloc;
    if (old + 1u == (gen + 1u) * nloc) {
      __builtin_amdgcn_fence(__ATOMIC_RELEASE, "agent");
      asm volatile("s_waitcnt vmcnt(0)" ::: "memory");
      const unsigned og = xb_add(&bar[XB_TOP], 1u);
      const unsigned tg = og / nx;
      if (og + 1u == (tg + 1u) * nx) xb_add(&bar[XB_TOPGEN], 1u);
      else XB_SPIN(xb_ld(&bar[XB_TOPGEN]) == tg, bar);
      __builtin_amdgcn_fence(__ATOMIC_ACQUIRE, "agent");
      xb_add(&bar[XB_XGEN(b.x)], 1u);
      asm volatile("s_waitcnt vmcnt(0)" ::: "memory");
    } else {
      XB_SPIN(xb_ld(&bar[XB_XGEN(b.x)]) == gen, bar);
      __builtin_amdgcn_fence(__ATOMIC_ACQUIRE, "agent");
      asm volatile("s_waitcnt vmcnt(0)" ::: "memory");
    }
  }
  __syncthreads();
}

__global__ void __launch_bounds__(256, 2) fwd_kernel(Params P, int ph_lo, int ph_hi) {
  extern __shared__ __attribute__((aligned(16))) unsigned char ldsb[];
  cg::grid_group grid = cg::this_grid();
  volatile LAS unsigned* xst = (volatile LAS unsigned*)(ldsb + 75904);
  if (threadIdx.x == 0) { xst[0] = 0u; xst[1] = 0u; xst[2] = 0u; xst[3] = 0u; }
  __syncthreads();
  XcdBarrier xb = xcd_barrier_post((unsigned*)(P.ws + WS_BAR), xst);
  if (ph_hi > 1000) grid.sync();
  for (int ph = ph_lo; ph < ph_hi; ++ph) {
    if (ph > ph_lo) xcd_barrier(xb);
    if (ph == 0) {
      if (PH_ON(0)) { convert_layer(P, 0, ldsb, 0, 1888, blockIdx.x, gridDim.x); ln_phase(P, 0, 0); }
      continue;
    }
    int phl = ph;
    asm volatile("" : "+s"(phl));
    const int l = (phl - 1) >> 3, s = (phl - 1) & 7;
    switch (s) {
      case 0: if (PH_ON(1)) { phase_proj(P, l, ldsb); if (DUP(1)) phase_proj(P, l, ldsb); } break;
      case 1: if (PH_ON(2)) { phase_rec(P, l, ldsb); if (DUP(2)) { __syncthreads(); phase_rec(P, l, ldsb); } } break;
      case 2: if (PH_ON(3)) { phase_merge(P, l, ldsb); if (DUP(3)) phase_merge(P, l, ldsb); } break;
      case 3: if (PH_ON(4)) { phase_resid(P, 0, l, ldsb); if (DUP(4)) phase_resid(P, 0, l, ldsb); } break;
      case 4: if (PH_ON(5)) { ln_phase(P, 1, l); if (DUP(5)) ln_phase(P, 1, l); } break;
      case 5: if (PH_ON(6)) { phase_ff1(P, l, ldsb); if (DUP(6)) phase_ff1(P, l, ldsb); } break;
      case 6: if (PH_ON(7)) { phase_resid(P, 1, l, ldsb); if (DUP(7)) phase_resid(P, 1, l, ldsb); } break;
      case 7:
        if (PH_ON(8)) { ln_phase(P, 2, l); }
        break;
    }
  }
}

extern "C" void kernel_launch(void* const* d_in, const int* in_sizes, int n_in, void* d_out, int out_size, void* d_ws,
                              size_t ws_size, hipStream_t stream) {
  static int grid_blocks = 0;
  if (grid_blocks == 0) {
    if (n_in != 31 || ws_size < WS_END || out_size != 44666880) {
      fprintf(stderr, "kernel_launch: unexpected problem (n_in %d, ws %zu, out %d)\n", n_in, ws_size, out_size);
      grid_blocks = -1;
      return;
    }
    int dev = 0, cus = 0, per_cu = 0;
    hipGetDevice(&dev);
    hipDeviceGetAttribute(&cus, hipDeviceAttributeMultiprocessorCount, dev);
    hipFuncSetAttribute((const void*)fwd_kernel, hipFuncAttributeMaxDynamicSharedMemorySize, LDS_BYTES);
    hipOccupancyMaxActiveBlocksPerMultiprocessor(&per_cu, (const void*)fwd_kernel, 256, LDS_BYTES);
    if (per_cu < 1) { fprintf(stderr, "kernel_launch: occupancy query says 0 blocks per CU\n"); grid_blocks = -1; return; }
    if (per_cu > 2) per_cu = 2;
    grid_blocks = cus * per_cu;
    grid_blocks -= grid_blocks % 8;
  }
  if (grid_blocks < 0) return;
  Params p{};
  for (int i = 0; i < 31; ++i) p.in[i] = (const float*)d_in[i];
  p.out = (float*)d_out;
  p.ws = (unsigned char*)d_ws;
  if (hipMemsetAsync((char*)d_ws + WS_BAR, 0, XCD_BAR_WORDS * 4, stream) != hipSuccess) { fprintf(stderr, "memset failed\n"); return; }
#if ONE_LAUNCH
  int lo = 0, hi = NPHASE;
  void* args[] = {&p, &lo, &hi};
  hipError_t e = hipLaunchCooperativeKernel((const void*)fwd_kernel, dim3(grid_blocks), dim3(256), args, LDS_BYTES, stream);
  if (e != hipSuccess) fprintf(stderr, "cooperative launch failed: %s (grid %d)\n", hipGetErrorString(e), grid_blocks);
#else
  for (int ph = 0; ph < NPHASE; ++ph) {
    hipLaunchKernelGGL(fwd_kernel, dim3(grid_blocks), dim3(256), LDS_BYTES, stream, p, ph, ph + 1);
  }
#endif
}
```

```cpp
#include <hip/hip_runtime.h>
#include <hip/hip_cooperative_groups.h>
#include <stdint.h>
#include <stdio.h>
namespace cg = cooperative_groups;

#ifndef ONE_LAUNCH
#define ONE_LAUNCH 1
#endif
#ifndef PHASE_ONLY
#define PHASE_ONLY -1
#endif
#define PH_ON(n) (PHASE_ONLY < 0 || PHASE_ONLY == (n))
#ifndef DUP_MASK
#define DUP_MASK 0
#endif
#define DUP(n) ((DUP_MASK >> (n)) & 1)

#define LAS __attribute__((address_space(3)))
typedef unsigned short u16;
typedef __attribute__((ext_vector_type(8))) short bf16x8;
typedef __attribute__((ext_vector_type(4))) float f32x4;

constexpr int D = 1024;
constexpr int TP = 2064;
constexpr int MP = 8 * TP;
constexpr int MS = 512;
constexpr int M = MP + MS;
constexpr int NPJ = 4376;
constexpr int LDT = 72;
constexpr float ALPHA = 1.4142135623730951f;
constexpr int NPHASE = 17;
constexpr int SPLIT_ROW0 = 128 * 128;

constexpr int LDA = 1088;
constexpr int LDY = 576;
constexpr int LDH = 4160;
constexpr size_t WS_WIN = 0;
constexpr size_t WS_WGATE = 9748480;
constexpr size_t WS_WOUT = 16433152;
constexpr size_t WS_WO = 19972096;
constexpr size_t WS_WFF1 = 22200320;
constexpr size_t WS_WFF2 = 31113216;
constexpr size_t WS_ACT = 39632896;
constexpr size_t WS_SSQ = 76677120;
constexpr size_t WS_A = 77221888;
constexpr size_t WS_B = 226215936;
constexpr size_t WS_BAR = 295946240;
constexpr size_t WS_W2 = WS_BAR + 16384;
constexpr size_t WS_G1X = WS_W2 + 22200320;
constexpr size_t WS_END = WS_G1X + 524288;
constexpr int G1_SPLIT = 16768;
constexpr size_t A_PRE = 37044224;

constexpr size_t O_YP = 0, O_YS = 16777216, O_SGP = 17301504, O_SGS = 17825792, O_SSP = 26214400, O_SSS = 26738688,
                 O_SCP = 35127296, O_SCS = 35164160, O_SRP = 35753984, O_SRS = 36278272;

constexpr int LDS_BYTES = 76032;

struct Params { const float* in[31]; float* out; unsigned char* ws; };

__device__ __forceinline__ unsigned f2bf(float f) {
  unsigned u = __float_as_uint(f);
  u += 0x7fffu + ((u >> 16) & 1u);
  return u >> 16;
}
__device__ __forceinline__ float bf2f(u16 h) { return __uint_as_float(((unsigned)h) << 16); }
__device__ __forceinline__ unsigned pack2(float a, float b) { return f2bf(a) | (f2bf(b) << 16); }
__device__ __forceinline__ void unpack8(uint4 v, float (&f)[8]) {
  f[0] = __uint_as_float(v.x << 16); f[1] = __uint_as_float(v.x & 0xffff0000u);
  f[2] = __uint_as_float(v.y << 16); f[3] = __uint_as_float(v.y & 0xffff0000u);
  f[4] = __uint_as_float(v.z << 16); f[5] = __uint_as_float(v.z & 0xffff0000u);
  f[6] = __uint_as_float(v.w << 16); f[7] = __uint_as_float(v.w & 0xffff0000u);
}
__device__ __forceinline__ uint4 pack8(const float (&f)[8]) {
  return make_uint4(pack2(f[0], f[1]), pack2(f[2], f[3]), pack2(f[4], f[5]), pack2(f[6], f[7]));
}
__device__ __forceinline__ int tsw(int row, int col) { return row * LDT + (col ^ (((row >> 3) & 7) << 3)); }
__device__ __forceinline__ int otid() { int t = threadIdx.x; asm volatile("" : "+v"(t)); return t; }
__device__ __forceinline__ float silu_f(float x) { return x / (1.f + __expf(-x)); }
__device__ __forceinline__ float sigmoid_f(float x) { return 1.f / (1.f + __expf(-x)); }
__device__ __forceinline__ float softplus_f(float x) { return fmaxf(x, 0.f) + log1pf(__expf(-fabsf(x))); }

__device__ __forceinline__ void conv_tile64(const float* __restrict__ src, int ld, int ldk, int ncol0, int nvalid, u16* __restrict__ dst,
                            int kt, int nt, const float* __restrict__ kscale, float* tile, int blocked_nkt = 0) {
  const int tid = otid();
  const int c = tid & 63, r4 = tid >> 6;
  const int n = nt * 64 + c;
  const bool ok = n < nvalid;
#pragma unroll
  for (int i = 0; i < 16; ++i) {
    int k = r4 + 4 * i;
    int kg = kt * 64 + k;
    float v = ok ? src[(size_t)kg * ld + ncol0 + n] : 0.f;
    if (kscale) v *= kscale[kg];
    tile[k * 65 + c] = v;
  }
  __syncthreads();
#pragma unroll
  for (int it = 0; it < 2; ++it) {
    int id = tid + 256 * it;
    int nn = id >> 3, kc = id & 7;
    unsigned w0 = pack2(tile[(kc * 8 + 0) * 65 + nn], tile[(kc * 8 + 1) * 65 + nn]);
    unsigned w1 = pack2(tile[(kc * 8 + 2) * 65 + nn], tile[(kc * 8 + 3) * 65 + nn]);
    unsigned w2 = pack2(tile[(kc * 8 + 4) * 65 + nn], tile[(kc * 8 + 5) * 65 + nn]);
    unsigned w3 = pack2(tile[(kc * 8 + 6) * 65 + nn], tile[(kc * 8 + 7) * 65 + nn]);
    const int n_ = nt * 64 + nn;
    const size_t di = blocked_nkt ? ((size_t)((n_ >> 7) * blocked_nkt + kt) * 8192 + (n_ & 127) * 64 + kc * 8)
                                  : ((size_t)n_ * ldk + kt * 64 + kc * 8);
    *(uint4*)(dst + di) = make_uint4(w0, w1, w2, w3);
  }
  __syncthreads();
}

__device__ __forceinline__ void convert_layer(const Params& P, int l, unsigned char* lds, int t_lo, int t_hi, int wb, int nwb) {
  float* tile = (float*)lds;
  unsigned char* ws = P.ws;
  const size_t wsel = (l == 0) ? 0 : WS_W2;
  for (int t = t_lo + wb; t < t_hi; t += nwb) {
    int idx = t;
    if (idx < 1120) {
      conv_tile64(P.in[9] + (size_t)l * 1024 * 7448, 7448, LDA, 0, NPJ, (u16*)(ws + wsel + WS_WIN), idx % 16, idx / 16, nullptr, tile);
      continue;
    }
    idx -= 1120;
    if (idx < 768) {
      conv_tile64(P.in[9] + (size_t)l * 1024 * 7448, 7448, LDA, NPJ, 3072, (u16*)(ws + wsel + WS_WGATE), idx % 16, idx / 16, nullptr, tile);
      continue;
    }
    idx -= 768;
    if (idx < 384) {
      int br = idx / 128, r = idx % 128;
      conv_tile64(P.in[19 + br] + (size_t)l * 512 * 1024, 1024, LDY, 0, 1024, (u16*)(ws + wsel + WS_WOUT) + (size_t)br * 1024 * LDY,
                  r % 8, r / 8, br == 1 ? P.in[18] + l * 512 : nullptr, tile);
      continue;
    }
    idx -= 384;
    if (idx < 256) {
      conv_tile64(P.in[22] + (size_t)l * 1024 * 1024, 1024, LDA, 0, 1024, (u16*)(ws + wsel + WS_WO), idx % 16, idx / 16, nullptr, tile);
      continue;
    }
    idx -= 256;
    if (idx < 1024) {
      conv_tile64(P.in[25] + (size_t)l * 1024 * 4096, 4096, LDA, 0, 4096, (u16*)(ws + WS_WFF1), idx % 16, idx / 16, nullptr, tile);
      continue;
    }
    idx -= 1024;
    conv_tile64(P.in[27] + (size_t)l * 4096 * 1024, 1024, LDH, 0, 1024, (u16*)(ws + WS_WFF2), idx % 64, idx / 64, nullptr, tile, 64);
  }
}

__device__ __forceinline__ void ln_phase(const Params& P, int mode, int l) {
  const int tid_ = otid();
  const int lane = tid_ & 63;
  const int gw = blockIdx.x * 4 + (tid_ >> 6);
  const int nw = gridDim.x * 4;
  const float* wv = mode == 0 ? P.in[7] : (mode == 1 ? P.in[23] + l * D : P.in[29] + l * D);
  const float* bv = mode == 0 ? P.in[8] : (mode == 1 ? P.in[24] + l * D : P.in[30] + l * D);
  u16* act = (u16*)(P.ws + WS_ACT);
  const bool final_out = (mode == 2 && l == 1);
  for (int row = gw; row < M; row += nw) {
    const float* s;
    int b = 0, t = 0;
    if (row < MP) { b = row / TP; t = row - b * TP; }
    if (mode == 0) {
      if (row < MP) s = (t < 16) ? P.in[6] + (size_t)t * D : P.in[0] + ((size_t)b * 2048 + (t - 16)) * D;
      else s = P.in[1] + (size_t)(row - MP) * D;
    } else if (mode == 1) {
      s = (const float*)(P.ws + WS_A + A_PRE) + (size_t)row * D;
    } else {
      s = (const float*)(P.ws + WS_B) + (size_t)row * D;
    }
    float4 v[4];
#pragma unroll
    for (int i = 0; i < 4; ++i) v[i] = *(const float4*)(s + i * 256 + lane * 4);
    float sum = 0.f;
#pragma unroll
    for (int i = 0; i < 4; ++i) sum += v[i].x + v[i].y + v[i].z + v[i].w;
#pragma unroll
    for (int o = 32; o >= 1; o >>= 1) sum += __shfl_xor(sum, o);
    const float mean = sum * (1.f / 1024.f);
    float sq = 0.f;
#pragma unroll
    for (int i = 0; i < 4; ++i) {
      v[i].x -= mean; v[i].y -= mean; v[i].z -= mean; v[i].w -= mean;
      sq += v[i].x * v[i].x + v[i].y * v[i].y + v[i].z * v[i].z + v[i].w * v[i].w;
    }
#pragma unroll
    for (int o = 32; o >= 1; o >>= 1) sq += __shfl_xor(sq, o);
    const float rstd = rsqrtf(sq * (1.f / 1024.f) + 1e-5f);
    float* od = nullptr;
    if (final_out) {
      if (row < MP) { if (t >= 16) od = P.out + O_YP + ((size_t)b * 2048 + (t - 16)) * D; }
      else od = P.out + O_YS + (size_t)(row - MP) * D;
    }
#pragma unroll
    for (int i = 0; i < 4; ++i) {
      const int c = i * 256 + lane * 4;
      float4 w4 = *(const float4*)(wv + c), b4 = *(const float4*)(bv + c);
      float y0 = v[i].x * rstd * w4.x + b4.x, y1 = v[i].y * rstd * w4.y + b4.y;
      float y2 = v[i].z * rstd * w4.z + b4.z, y3 = v[i].w * rstd * w4.w + b4.w;
      if (final_out) {
        if (od) *(float4*)(od + c) = make_float4(y0, y1, y2, y3);
      } else {
        const unsigned p0 = pack2(y0, y1), p1 = pack2(y2, y3);
        *(uint2*)(act + (size_t)row * LDA + c) = make_uint2(p0, p1);
        if (mode == 1 && row >= SPLIT_ROW0) {
          const float4 bb = *(const float4*)(P.in[28] + l * D + c);
          float* pz = (float*)(P.ws + WS_B) + (size_t)row * D + c;
          *(float4*)pz = make_float4(ALPHA * __uint_as_float(p0 << 16) + bb.x, ALPHA * __uint_as_float(p0 & 0xffff0000u) + bb.y,
                                     ALPHA * __uint_as_float(p1 << 16) + bb.z, ALPHA * __uint_as_float(p1 & 0xffff0000u) + bb.w);
        }
      }
    }
  }
}

#define G_LOAD4(R, k0)                                                                    \
  R##a0 = *(const uint4*)(ap + (k0)); R##a1 = *(const uint4*)(ap + sa + (k0));            \
  R##a2 = *(const uint4*)(ap + 2 * sa + (k0)); R##a3 = *(const uint4*)(ap + 3 * sa + (k0)); \
  R##b0 = *(const uint4*)(bp + (k0)); R##b1 = *(const uint4*)(bp + sb + (k0));
#define G_LOADB(R, k0)                                                                    \
  R##b2 = *(const uint4*)(bp + 2 * sb + (k0)); R##b3 = *(const uint4*)(bp + 3 * sb + (k0));
#define L_STORE4(R, buf)                                                                  \
  { u16* ad = As + (buf) * 128 * LDT + crow * LDT + cck;                                  \
    u16* bd = Bs + (buf) * BN * LDT + crow * LDT + cck;                                   \
    *(uint4*)(ad) = R##a0; *(uint4*)(ad + 32 * LDT) = R##a1; *(uint4*)(ad + 64 * LDT) = R##a2; *(uint4*)(ad + 96 * LDT) = R##a3; \
    *(uint4*)(bd) = R##b0; *(uint4*)(bd + 32 * LDT) = R##b1;                              \
    if (NF == 4) { *(uint4*)(bd + 64 * LDT) = R##b2; *(uint4*)(bd + 96 * LDT) = R##b3; } }
#define MMA_TILE(buf)                                                                     \
  { const u16* as = As + (buf) * 128 * LDT + (wm * 64 + r) * LDT + q * 8;                 \
    const u16* bs = Bs + (buf) * BN * LDT + (wn * NF * 16 + r) * LDT + q * 8;             \
    _Pragma("unroll") for (int kk = 0; kk < 2; ++kk) {                                    \
      bf16x8 af[4], bfr[NF];                                                              \
      _Pragma("unroll") for (int mf = 0; mf < 4; ++mf) af[mf] = *(const bf16x8*)(as + mf * 16 * LDT + kk * 32); \
      _Pragma("unroll") for (int nf = 0; nf < NF; ++nf) bfr[nf] = *(const bf16x8*)(bs + nf * 16 * LDT + kk * 32); \
      _Pragma("unroll") for (int mf = 0; mf < 4; ++mf)                                    \
        _Pragma("unroll") for (int nf = 0; nf < NF; ++nf)                                 \
          acc[mf][nf] = __builtin_amdgcn_mfma_f32_16x16x32_bf16(af[mf], bfr[nf], acc[mf][nf], 0, 0, 0); \
    } }

__device__ __forceinline__ int lds_byte(int r, int c) {
  int st = (r >> 4) * 2 + (c >> 5), rr = r & 15, cc = c & 31, ob = rr * 64 + cc * 2;
  return st * 1024 + (ob ^ (((ob >> 9) & 1) << 5));
}
__device__ __forceinline__ void stage_rc(int b, int& R, int& C) {
  int st = b >> 10, sb = b & 1023, swz = sb ^ (((sb >> 9) & 1) << 5);
  R = (st >> 1) * 16 + (swz >> 6);
  C = (st & 1) * 32 + ((swz & 63) >> 1);
}

template <int NF>
__device__ __forceinline__ void gemm_core(f32x4 (&acc)[4][NF], const u16* __restrict__ A, int lda,
                                          const u16* __restrict__ B, int ldb, int K, u16* lds, int kadv = 64) {
  constexpr int BN = 32 * NF;
  constexpr int ABYTES = 128 * 64 * 2;
  constexpr int BBYTES = BN * 64 * 2;
  constexpr int BUF = ABYTES + BBYTES;
  unsigned char* base = (unsigned char*)lds;
  const int tid = otid(), lane = tid & 63, w = tid >> 6, wm = w >> 1, wn = w & 1, r = lane & 15, q = lane >> 4;
  const u16* ga[4]; const u16* gb[NF];
#pragma unroll
  for (int i = 0; i < 4; ++i) { int R, C; stage_rc(tid * 16 + i * 4096, R, C); ga[i] = A + (size_t)R * lda + C; }
#pragma unroll
  for (int i = 0; i < NF; ++i) { int R, C; stage_rc(tid * 16 + i * 4096, R, C); gb[i] = B + (size_t)R * ldb + C; }
  int oa[4][2], ob[NF][2];
#pragma unroll
  for (int mf = 0; mf < 4; ++mf)
#pragma unroll
    for (int kk = 0; kk < 2; ++kk) oa[mf][kk] = lds_byte(wm * 64 + mf * 16 + r, kk * 32 + q * 8);
#pragma unroll
  for (int nf = 0; nf < NF; ++nf)
#pragma unroll
    for (int kk = 0; kk < 2; ++kk) ob[nf][kk] = lds_byte(wn * NF * 16 + nf * 16 + r, kk * 32 + q * 8);
#define STAGE_TILE(buf, k0)                                                                              \
  {                                                                                                      \
    _Pragma("unroll") for (int i = 0; i < 4; ++i)                                                        \
      __builtin_amdgcn_global_load_lds((const unsigned*)(ga[i] + (k0)),                                  \
        (LAS unsigned*)(base + (buf) * BUF + tid * 16 + i * 4096), 16, 0, 0);                            \
    _Pragma("unroll") for (int i = 0; i < NF; ++i)                                                       \
      __builtin_amdgcn_global_load_lds((const unsigned*)(gb[i] + (k0)),                                  \
        (LAS unsigned*)(base + (buf) * BUF + ABYTES + tid * 16 + i * 4096), 16, 0, 0);                   \
  }
  const int nk = K >> 6;
  STAGE_TILE(0, 0)
  asm volatile("s_waitcnt vmcnt(0)" ::: "memory");
  __syncthreads();
  for (int kt = 0; kt < nk; ++kt) {
    const int buf = kt & 1;
    if (kt + 1 < nk) STAGE_TILE(buf ^ 1, (size_t)(kt + 1) * kadv)
    const unsigned char* as = base + buf * BUF;
    const unsigned char* bs = as + ABYTES;
    bf16x8 af0[4], bf0[NF], af1[4], bf1[NF];
#pragma unroll
    for (int mf = 0; mf < 4; ++mf) af0[mf] = *(const bf16x8*)(as + oa[mf][0]);
#pragma unroll
    for (int nf = 0; nf < NF; ++nf) bf0[nf] = *(const bf16x8*)(bs + ob[nf][0]);
    __builtin_amdgcn_s_setprio(1);
#pragma unroll
    for (int nf = 0; nf < NF / 2; ++nf)
#pragma unroll
      for (int mf = 0; mf < 4; ++mf)
        acc[mf][nf] = __builtin_amdgcn_mfma_f32_16x16x32_bf16(af0[mf], bf0[nf], acc[mf][nf], 0, 0, 0);
    __builtin_amdgcn_s_setprio(0);
#pragma unroll
    for (int mf = 0; mf < 4; ++mf) af1[mf] = *(const bf16x8*)(as + oa[mf][1]);
#pragma unroll
    for (int nf = 0; nf < NF; ++nf) bf1[nf] = *(const bf16x8*)(bs + ob[nf][1]);
    __builtin_amdgcn_s_setprio(1);
#pragma unroll
    for (int nf = NF / 2; nf < NF; ++nf)
#pragma unroll
      for (int mf = 0; mf < 4; ++mf)
        acc[mf][nf] = __builtin_amdgcn_mfma_f32_16x16x32_bf16(af0[mf], bf0[nf], acc[mf][nf], 0, 0, 0);
#pragma unroll
    for (int nf = 0; nf < NF; ++nf)
#pragma unroll
      for (int mf = 0; mf < 4; ++mf)
        acc[mf][nf] = __builtin_amdgcn_mfma_f32_16x16x32_bf16(af1[mf], bf1[nf], acc[mf][nf], 0, 0, 0);
    __builtin_amdgcn_s_setprio(0);
    asm volatile("s_waitcnt vmcnt(0)" ::: "memory");
    __syncthreads();
  }
#undef STAGE_TILE
}

#define TILE_LOOP(total)                                                                      \
  const int _nx = (gridDim.x % 8 == 0) ? 8 : 1;                                              \
  const int _ns = gridDim.x / _nx;                                                           \
  const int _x = blockIdx.x % _nx, _s = blockIdx.x / _nx;                                    \
  const int _per = ((total) + _nx - 1) / _nx;                                                \
  const int _lo = _x * _per;                                                                 \
  const int _hi = min((total), _lo + _per);                                                  \
  for (int t = _lo + _s; t < _hi; t += _ns)

__device__ __forceinline__ void tile_decode(int t, int MT, int NT, int& mt, int& nt) {
  int g = t / (8 * NT), r = t - g * 8 * NT;
  int gs = min(8, MT - g * 8);
  mt = g * 8 + r % gs;
  nt = r / gs;
}

template <int NF>
__device__ __forceinline__ void zero_acc(f32x4 (&acc)[4][NF]) {
#pragma unroll
  for (int i = 0; i < 4; ++i)
#pragma unroll
    for (int j = 0; j < NF; ++j) acc[i][j] = (f32x4){0.f, 0.f, 0.f, 0.f};
}

__device__ __forceinline__ void phase_proj(const Params& P, int l, unsigned char* ldsb) {
  const u16* act = (const u16*)(P.ws + WS_ACT);
  const u16* W = (const u16*)(P.ws + (l == 0 ? 0 : WS_W2) + WS_WIN);
  u16* proj = (u16*)(P.ws + WS_A);
  constexpr int MT = 133, NT = 35;
  TILE_LOOP(MT * NT) {
    int mt, nt; tile_decode(t, MT, NT, mt, nt);
    const int tid_ = otid(), lane = tid_ & 63, w = tid_ >> 6, wm = w >> 1, wn = w & 1, r = lane & 15, q = lane >> 4;
    f32x4 acc[4][4]; zero_acc<4>(acc);
    gemm_core<4>(acc, act + (size_t)mt * 128 * LDA, LDA, W + (size_t)nt * 128 * LDA, LDA, D, (u16*)ldsb);
#pragma unroll
    for (int mf = 0; mf < 4; ++mf)
#pragma unroll
      for (int nf = 0; nf < 4; ++nf) {
        const int col = nt * 128 + wn * 64 + nf * 16 + r;
        if (col < NPJ) {
#pragma unroll
          for (int e = 0; e < 4; ++e) {
            const int row = mt * 128 + wm * 64 + mf * 16 + q * 4 + e;
            proj[(size_t)row * NPJ + col] = (u16)f2bf(acc[mf][nf][e]);
          }
        }
      }
  }
}

__device__ __forceinline__ u16* gate_row(const Params& P, int br, int row) {
  if (br == 0) return (u16*)P.out + (size_t)row * D;
  if (row < G1_SPLIT) return (u16*)P.out + (size_t)M * D + (size_t)row * D;
  return (u16*)(P.ws + WS_G1X) + (size_t)(row - G1_SPLIT) * D;
}

__device__ __forceinline__ void phase_gates(const Params& P, int l, int wb, int nwb, unsigned char* ldsb) {
  const u16* act = (const u16*)(P.ws + WS_ACT);
  const u16* Wg = (const u16*)(P.ws + (l == 0 ? 0 : WS_W2) + WS_WGATE);
  constexpr int MT = 133, NT = 8;
  for (int t = wb; t < 2 * MT * NT; t += nwb) {
    const int br = t / (MT * NT);
    int mt, nt; tile_decode(t - br * MT * NT, MT, NT, mt, nt);
    const int tid_ = otid(), lane = tid_ & 63, w = tid_ >> 6, wm = w >> 1, wn = w & 1, r = lane & 15, q = lane >> 4;
    f32x4 acc[4][4]; zero_acc<4>(acc);
    gemm_core<4>(acc, act + (size_t)mt * 128 * LDA, LDA, Wg + ((size_t)br * 1024 + nt * 128) * LDA, LDA, D, (u16*)ldsb);
#pragma unroll
    for (int mf = 0; mf < 4; ++mf)
#pragma unroll
      for (int e = 0; e < 4; ++e) {
        const int row = mt * 128 + wm * 64 + mf * 16 + q * 4 + e;
        u16* gr = gate_row(P, br, row);
#pragma unroll
        for (int nf = 0; nf < 4; ++nf) gr[nt * 128 + wn * 64 + nf * 16 + r] = (u16)f2bf(sigmoid_f(acc[mf][nf][e]));
      }
  }
}

__device__ __forceinline__ void phase_merge(const Params& P, int l, unsigned char* ldsb) {
  const u16* act = (const u16*)(P.ws + WS_ACT);
  const u16* Wg = (const u16*)(P.ws + (l == 0 ? 0 : WS_W2) + WS_WGATE);
  const u16* Wo = (const u16*)(P.ws + (l == 0 ? 0 : WS_W2) + WS_WOUT);
  const u16* ybr = (const u16*)(P.ws + WS_B);
  const float* ssq = (const float*)(P.ws + WS_SSQ);
  u16* merged = (u16*)(P.ws + WS_A);
  constexpr int MT = 133, NT = 16;
  {
    float* pre = (float*)(P.ws + WS_A + A_PRE);
    for (int i = blockIdx.x * 256 + otid(); i < (M - SPLIT_ROW0) * (D / 4); i += gridDim.x * 256) {
      const int row = SPLIT_ROW0 + i / (D / 4), c = (i % (D / 4)) * 4;
      const uint2 xv = *(const uint2*)(act + (size_t)row * LDA + c);
      *(float4*)(pre + (size_t)row * D + c) = make_float4(ALPHA * __uint_as_float(xv.x << 16), ALPHA * __uint_as_float(xv.x & 0xffff0000u),
                                                          ALPHA * __uint_as_float(xv.y << 16), ALPHA * __uint_as_float(xv.y & 0xffff0000u));
    }
  }
  TILE_LOOP(MT * NT) {
    int mt, nt; tile_decode(t, MT, NT, mt, nt);
    const int tid_ = otid(), lane = tid_ & 63, w = tid_ >> 6, wm = w >> 1, wn = w & 1, r = lane & 15, q = lane >> 4;
    f32x4 fin[4][2]; zero_acc<2>(fin);
#pragma unroll 1
    for (int br = 0; br < 3; ++br) {
      f32x4 g[4][2]; zero_acc<2>(g);
      if (br == 2) {
        gemm_core<2>(g, act + (size_t)mt * 128 * LDA, LDA, Wg + ((size_t)br * 1024 + nt * 64) * LDA, LDA, D, (u16*)ldsb);
#pragma unroll
        for (int mf = 0; mf < 4; ++mf)
#pragma unroll
          for (int nf = 0; nf < 2; ++nf)
#pragma unroll
            for (int e = 0; e < 4; ++e) g[mf][nf][e] = sigmoid_f(g[mf][nf][e]);
      } else {
#pragma unroll
        for (int mf = 0; mf < 4; ++mf)
#pragma unroll
          for (int e = 0; e < 4; ++e) {
            const u16* gr = gate_row(P, br, mt * 128 + wm * 64 + mf * 16 + q * 4 + e) + nt * 64 + wn * 32 + r;
#pragma unroll
            for (int nf = 0; nf < 2; ++nf) g[mf][nf][e] = bf2f(gr[nf * 16]);
          }
      }
      const u16* yb = ybr + (size_t)br * M * LDY + (size_t)mt * 128 * LDY;
      const u16* wb = Wo + (size_t)br * 1024 * LDY + (size_t)nt * 64 * LDY;
      if (br != 1) {
        f32x4 acc[4][2]; zero_acc<2>(acc);
        gemm_core<2>(acc, yb, LDY, wb, LDY, 512, (u16*)ldsb);
#pragma unroll
        for (int mf = 0; mf < 4; ++mf)
#pragma unroll
          for (int nf = 0; nf < 2; ++nf)
#pragma unroll
            for (int e = 0; e < 4; ++e) fin[mf][nf][e] += g[mf][nf][e] * acc[mf][nf][e];
      } else {
#pragma unroll 1
        for (int grp = 0; grp < 2; ++grp) {
          f32x4 acc[4][2]; zero_acc<2>(acc);
          gemm_core<2>(acc, yb + grp * 256, LDY, wb + grp * 256, LDY, 256, (u16*)ldsb);
#pragma unroll
          for (int mf = 0; mf < 4; ++mf)
#pragma unroll
            for (int e = 0; e < 4; ++e) {
              const int row = mt * 128 + wm * 64 + mf * 16 + q * 4 + e;
              float4 s4 = *(const float4*)(ssq + (size_t)row * 8 + grp * 4);
              float rs = rsqrtf((s4.x + s4.y + s4.z + s4.w) * (1.f / 256.f) + 1e-6f);
#pragma unroll
              for (int nf = 0; nf < 2; ++nf) fin[mf][nf][e] += g[mf][nf][e] * rs * acc[mf][nf][e];
            }
        }
      }
    }
#pragma unroll
    for (int mf = 0; mf < 4; ++mf)
#pragma unroll
      for (int nf = 0; nf < 2; ++nf)
#pragma unroll
        for (int e = 0; e < 4; ++e) {
          const int row = mt * 128 + wm * 64 + mf * 16 + q * 4 + e;
          const int col = nt * 64 + wn * 32 + nf * 16 + r;
          merged[(size_t)row * LDA + col] = (u16)f2bf(fin[mf][nf][e]);
        }
  }
}

__device__ __forceinline__ void phase_resid(const Params& P, int mode, int l, unsigned char* ldsb) {
  const u16* act = (const u16*)(P.ws + WS_ACT);
  const u16* A = (const u16*)(P.ws + WS_A);
  const int K = mode == 0 ? 1024 : 4096;
  const int ldk = mode == 0 ? LDA : LDH;
  const u16* W = (const u16*)(P.ws + (mode == 0 ? (l == 0 ? 0 : WS_W2) + WS_WO : WS_WFF2));
  float* dst = mode == 0 ? (float*)(P.ws + WS_A + A_PRE) : (float*)(P.ws + WS_B);
  const float* bias = P.in[28] + l * D;
  constexpr int MT = 128, NT = 8;
  TILE_LOOP(MT * NT) {
    int mt, nt; tile_decode(t, MT, NT, mt, nt);
    const int tid_ = otid(), lane = tid_ & 63, w = tid_ >> 6, wm = w >> 1, wn = w & 1, r = lane & 15, q = lane >> 4;
    f32x4 acc[4][4]; zero_acc<4>(acc);
    if (mode == 0) gemm_core<4>(acc, A + (size_t)mt * 128 * ldk, ldk, W + (size_t)nt * 128 * ldk, ldk, K, (u16*)ldsb);
    else gemm_core<4>(acc, A + (size_t)mt * 64 * 8192, 64, W + (size_t)nt * 64 * 8192, 64, K, (u16*)ldsb, 8192);
#pragma unroll
    for (int mf = 0; mf < 4; ++mf)
#pragma unroll
      for (int nf = 0; nf < 4; ++nf) {
        const int col = nt * 128 + wn * 64 + nf * 16 + r;
        const float bb = mode == 1 ? bias[col] : 0.f;
#pragma unroll
        for (int e = 0; e < 4; ++e) {
          const int row = mt * 128 + wm * 64 + mf * 16 + q * 4 + e;
          dst[(size_t)row * D + col] = ALPHA * bf2f(act[(size_t)row * LDA + col]) + acc[mf][nf][e] + bb;
        }
      }
  }
  {
    constexpr int S = 8;
    const int KS = K / S;
    for (int li = blockIdx.x; li < 40 * S; li += gridDim.x) {
      const int sl = li % S, tl = li / S;
      const int mt = 128 + tl / 8, nt = tl % 8;
      const int tid_ = otid(), lane = tid_ & 63, w = tid_ >> 6, wm = w >> 1, wn = w & 1, r = lane & 15, q = lane >> 4;
      f32x4 acc[4][4]; zero_acc<4>(acc);
      if (mode == 0) gemm_core<4>(acc, A + (size_t)mt * 128 * ldk + sl * KS, ldk, W + (size_t)nt * 128 * ldk + sl * KS, ldk, KS, (u16*)ldsb);
      else gemm_core<4>(acc, A + ((size_t)mt * 64 + sl * (KS / 64)) * 8192, 64, W + ((size_t)nt * 64 + sl * (KS / 64)) * 8192, 64, KS, (u16*)ldsb, 8192);
#pragma unroll
      for (int mf = 0; mf < 4; ++mf)
#pragma unroll
        for (int nf = 0; nf < 4; ++nf) {
          const int col = nt * 128 + wn * 64 + nf * 16 + r;
#pragma unroll
          for (int e = 0; e < 4; ++e) {
            const int row = mt * 128 + wm * 64 + mf * 16 + q * 4 + e;
            (void)__hip_atomic_fetch_add(dst + (size_t)row * D + col, acc[mf][nf][e], __ATOMIC_RELAXED, __HIP_MEMORY_SCOPE_AGENT);
          }
        }
    }
  }
}

__device__ __forceinline__ void phase_ff1(const Params& P, int l, unsigned char* ldsb) {
  const u16* act = (const u16*)(P.ws + WS_ACT);
  const u16* W = (const u16*)(P.ws + WS_WFF1);
  u16* hid = (u16*)(P.ws + WS_A);
  const float* bias = P.in[26] + l * 4096;
  constexpr int MT = 133, NT = 32;
  TILE_LOOP(MT * NT) {
    int mt, nt; tile_decode(t, MT, NT, mt, nt);
    const int tid_ = otid(), lane = tid_ & 63, w = tid_ >> 6, wm = w >> 1, wn = w & 1, r = lane & 15, q = lane >> 4;
    f32x4 acc[4][4]; zero_acc<4>(acc);
    gemm_core<4>(acc, act + (size_t)mt * 128 * LDA, LDA, W + (size_t)nt * 128 * LDA, LDA, D, (u16*)ldsb);
#pragma unroll
    for (int mf = 0; mf < 4; ++mf)
#pragma unroll
      for (int nf = 0; nf < 4; ++nf) {
        const int col = nt * 128 + wn * 64 + nf * 16 + r;
        const float bb = bias[col];
#pragma unroll
        for (int e = 0; e < 4; ++e) {
          const int row = mt * 128 + wm * 64 + mf * 16 + q * 4 + e;
          float v = fmaxf(acc[mf][nf][e] + bb, 0.f);
          hid[((size_t)(row >> 7) * 64 + (col >> 6)) * 8192 + (row & 127) * 64 + (col & 63)] = (u16)f2bf(v * v);
        }
      }
  }
}

template <int BR>
__device__ __forceinline__ void rec_item(const Params& P, int l, int b, int h, int sample, unsigned char* ldsb) {
  constexpr int DV = (BR == 1) ? 64 : 128;
  constexpr int NFV = DV / 16;
  constexpr int NH = (BR == 1) ? 8 : 4;
  constexpr int OLD = DV + 4;
  constexpr int NEP = DV / 32;
  u16* QA = (u16*)ldsb;
  u16* KB = QA + 64 * LDT;
  u16* KT = KB + 64 * LDT;
  u16* ATT = KT + 64 * LDT;
  u16* VT = ATT + 64 * LDT;
  u16* ST = VT + 128 * LDT;
  float* Gsc = (float*)(ST + 128 * LDT);
  float* dec = Gsc + 64;
  float* dtv = dec + 64;
  float* psum = dtv + 64;
  float* invf = psum + 256;
  float* Gl = (float*)ST;
  float* AL = (float*)ATT;
  float* OST = (float*)ldsb;
  u16* XH = VT + 64 * LDT;

  const int tid = otid(), lane = tid & 63, w = tid >> 6, r = lane & 15, q = lane >> 4;
  const int T = sample ? 4 : TP;
  const int row0 = sample ? MP + b * 4 : b * TP;
  const int pos0 = sample ? 16384 : 0;
  const u16* proj = (const u16*)(P.ws + WS_A);
  u16* ybr = (u16*)(P.ws + WS_B) + (size_t)BR * M * LDY;
  float* ssq = (float*)(P.ws + WS_SSQ);

  float lg = 0.f, aneg = 0.f, dtb = 0.f, dsk = 0.f;
  if (BR == 2) {
    lg = log1pf(-exp2f(-5.f - (float)h));
    if (tid < 32) invf[tid] = exp2f(-(float)tid * (13.287712379549449f / 32.0f));
  }
  if (BR == 1) {
    aneg = -__expf(P.in[16][l * 8 + h]);
    dtb = P.in[15][l * 8 + h];
    dsk = P.in[17][l * 8 + h];
  }
  const int grp = h >> 2;

  f32x4 S[NFV];
  {
    const float* sin_ = P.in[2];
    if (sample) {
      const float* base = BR == 0 ? P.in[2] : (BR == 1 ? P.in[3] : P.in[5]);
      sin_ = base + ((size_t)(l * 128 + b) * NH + h) * 64 * DV;
    }
#pragma unroll
    for (int nf = 0; nf < NFV; ++nf)
#pragma unroll
      for (int e = 0; e < 4; ++e) {
        float v = sin_[(size_t)(16 * w + q * 4 + e) * DV + nf * 16 + r];
        S[nf][e] = sample ? v : 0.f;
      }
  }
  __syncthreads();

  uint4 Rg[NEP], RgN[NEP];
  uint4 Rq[2], Rk[2], Rv[4], Ral;
  uint4 Rq1, Rq2, Rk1, Rk2;
  uint4 Rx[11];
  float dtraw = 0.f;
  const int ci = tid & 63, part = tid >> 6;
  float w2r[16];
  float bias = 0.f;
  if (BR == 0) {
#pragma unroll
    for (int rr = 0; rr < 16; ++rr) w2r[rr] = P.in[10][(size_t)(l * 16 + rr) * 256 + h * 64 + ci];
    bias = P.in[11][l * 256 + h * 64 + ci];
  }
  const int cc = tid >> 3, ts = tid & 7;
  const bool act = tid < 192;
  const int seg = cc >> 3, c8 = (cc & 7) * 8;
  const int chan = seg == 0 ? h * 64 + c8 : (seg == 1 ? 512 + grp * 64 + c8 : 640 + grp * 64 + c8);
  float cwv[4][8], cbv[8];
  if (BR == 1 && act) {
    const float* cw = P.in[13] + (size_t)l * 4 * 768 + chan;
    const float* cb = P.in[14] + (size_t)l * 768 + chan;
#pragma unroll
    for (int i = 0; i < 4; ++i) {
      *(float4*)&cwv[i][0] = *(const float4*)(cw + i * 768);
      *(float4*)&cwv[i][4] = *(const float4*)(cw + i * 768 + 4);
    }
    *(float4*)&cbv[0] = *(const float4*)cb;
    *(float4*)&cbv[4] = *(const float4*)(cb + 4);
  }
#define REC_LOAD(CB, RGD)                                                                                     \
  {                                                                                                           \
    const int goff_ = BR == 0 ? 1024 + h * 128 : (BR == 1 ? 1552 + h * 64 : 3864 + h * 128);                  \
    _Pragma("unroll") for (int it = 0; it < NEP; ++it) {                                                      \
      const int id = tid + 256 * it;                                                                          \
      const int t = (DV == 128) ? (id >> 4) : (id >> 3);                                                      \
      const int j0 = (DV == 128) ? (id & 15) * 8 : (id & 7) * 8;                                              \
      RGD[it] = *(const uint4*)(proj + (size_t)(row0 + min((CB) + t, T - 1)) * NPJ + goff_ + j0);             \
    }                                                                                                         \
    if (BR == 0) {                                                                                            \
      _Pragma("unroll") for (int it = 0; it < 2; ++it) {                                                      \
        const int id = tid + 256 * it;                                                                        \
        const int t = id >> 3, i0 = (id & 7) * 8;                                                             \
        const u16* rp = proj + (size_t)(row0 + min((CB) + t, T - 1)) * NPJ + h * 64 + i0;                     \
        Rq[it] = *(const uint4*)rp;                                                                           \
        Rk[it] = *(const uint4*)(rp + 256);                                                                   \
      }                                                                                                       \
      { const int t = (tid & 127) >> 1, hf = tid & 1;                                                         \
        Ral = *(const uint4*)(proj + (size_t)(row0 + min((CB) + t, T - 1)) * NPJ + 1536 + hf * 8); }          \
    }                                                                                                         \
    if (BR == 2) {                                                                                            \
      const int t = tid >> 2, i0 = (tid & 3) * 8;                                                             \
      const u16* rp = proj + (size_t)(row0 + min((CB) + t, T - 1)) * NPJ + 2840 + h * 64 + i0;                \
      Rq1 = *(const uint4*)rp; Rq2 = *(const uint4*)(rp + 32);                                                \
      Rk1 = *(const uint4*)(rp + 256); Rk2 = *(const uint4*)(rp + 288);                                       \
    }                                                                                                         \
    if (BR == 1) {                                                                                            \
      if (act) {                                                                                              \
        _Pragma("unroll") for (int k = 0; k < 11; ++k) {                                                      \
          int tau = (CB) + ts * 8 - 3 + k;                                                                    \
          tau = min(max(tau, 0), T - 1);                                                                      \
          Rx[k] = *(const uint4*)(proj + (size_t)(row0 + tau) * NPJ + 2064 + chan);                           \
        }                                                                                                     \
      }                                                                                                       \
      if (w == 0) dtraw = bf2f(proj[(size_t)(row0 + min((CB) + lane, T - 1)) * NPJ + 2832 + h]);              \
    }                                                                                                         \
  }
  REC_LOAD(0, Rg)

  for (int c0 = 0; c0 < T; c0 += 64) {
    const int nvalid = min(64, T - c0);
    if (BR == 0 || BR == 2) {
      const int voff_ = (BR == 0 ? 512 : 3352) + h * 128;
#pragma unroll
      for (int it = 0; it < 4; ++it) {
        const int id = tid + 256 * it;
        const int t = id >> 4, j0 = (id & 15) * 8;
        Rv[it] = *(const uint4*)(proj + (size_t)(row0 + min(c0 + t, T - 1)) * NPJ + voff_ + j0);
      }
    }
    if (BR == 0) {
      if (tid < 128) {
        const int t = tid >> 1, hf = tid & 1;
        float a8[8];
        unpack8(Ral, a8);
        *(float4*)(AL + t * 16 + hf * 8) = make_float4(a8[0], a8[1], a8[2], a8[3]);
        *(float4*)(AL + t * 16 + hf * 8 + 4) = make_float4(a8[4], a8[5], a8[6], a8[7]);
      }
      __syncthreads();
      {
        float run = 0.f;
#pragma unroll 4
        for (int tt = 0; tt < 16; ++tt) {
          const int t = part * 16 + tt;
          const float4 x0 = *(const float4*)(AL + t * 16), x1 = *(const float4*)(AL + t * 16 + 4);
          const float4 x2 = *(const float4*)(AL + t * 16 + 8), x3 = *(const float4*)(AL + t * 16 + 12);
          float a = bias;
          a += x0.x * w2r[0] + x0.y * w2r[1] + x0.z * w2r[2] + x0.w * w2r[3];
          a += x1.x * w2r[4] + x1.y * w2r[5] + x1.z * w2r[6] + x1.w * w2r[7];
          a += x2.x * w2r[8] + x2.y * w2r[9] + x2.z * w2r[10] + x2.w * w2r[11];
          a += x3.x * w2r[12] + x3.y * w2r[13] + x3.z * w2r[14] + x3.w * w2r[15];
          float g = (fminf(a, 0.f) - __logf(1.f + __expf(-fabsf(a)))) * (1.f / 16.f);
          if (t >= nvalid) g = 0.f;
          run += g;
          Gl[t * 64 + ci] = run;
        }
        psum[part * 64 + ci] = run;
      }
      __syncthreads();
      {
        float off = 0.f;
        for (int p = 0; p < part; ++p) off += psum[p * 64 + ci];
#pragma unroll 4
        for (int tt = 0; tt < 16; ++tt) Gl[(part * 16 + tt) * 64 + ci] += off;
      }
      __syncthreads();
#pragma unroll
      for (int it = 0; it < 2; ++it) {
        const int id = tid + 256 * it;
        const int t = id >> 3, i0 = (id & 7) * 8;
        const bool valid = t < nvalid;
        float qf[8], kf[8], G[8], Ge[8], qa[8], kb[8];
        unpack8(Rq[it], qf); unpack8(Rk[it], kf);
        *(float4*)&G[0] = *(const float4*)(Gl + t * 64 + i0);
        *(float4*)&G[4] = *(const float4*)(Gl + t * 64 + i0 + 4);
        *(float4*)&Ge[0] = *(const float4*)(Gl + 63 * 64 + i0);
        *(float4*)&Ge[4] = *(const float4*)(Gl + 63 * 64 + i0 + 4);
#pragma unroll
        for (int e = 0; e < 8; ++e) {
          const float qv = valid ? qf[e] : 0.f, kv = valid ? kf[e] : 0.f;
          qa[e] = qv * 0.125f * __expf(G[e]);
          kb[e] = kv * __expf(-G[e]);
          KT[tsw(i0 + e, t)] = (u16)f2bf(kv * __expf(Ge[e] - G[e]));
        }
        *(uint4*)(QA + t * LDT + i0) = pack8(qa);
        *(uint4*)(KB + t * LDT + i0) = pack8(kb);
        if (t == 63) {
#pragma unroll
          for (int e = 0; e < 8; ++e) dec[i0 + e] = __expf(Ge[e]);
        }
        __builtin_amdgcn_sched_barrier(0);
      }
#pragma unroll
      for (int it = 0; it < 4; ++it) {
        const int id = tid + 256 * it;
        const int t = id >> 4, j0 = (id & 15) * 8;
        uint4 v4 = Rv[it];
        if (t >= nvalid) v4 = make_uint4(0, 0, 0, 0);
        VT[tsw(j0 + 0, t)] = (u16)(v4.x & 0xffffu); VT[tsw(j0 + 1, t)] = (u16)(v4.x >> 16);
        VT[tsw(j0 + 2, t)] = (u16)(v4.y & 0xffffu); VT[tsw(j0 + 3, t)] = (u16)(v4.y >> 16);
        VT[tsw(j0 + 4, t)] = (u16)(v4.z & 0xffffu); VT[tsw(j0 + 5, t)] = (u16)(v4.z >> 16);
        VT[tsw(j0 + 6, t)] = (u16)(v4.w & 0xffffu); VT[tsw(j0 + 7, t)] = (u16)(v4.w >> 16);
      }
      if (tid < 64) Gsc[tid] = 0.f;
    }
    if (BR == 2) {
      {
        const int t = tid >> 2, i0 = (tid & 3) * 8;
        const bool valid = t < nvalid;
        float q1f[8], q2f[8], k1f[8], k2f[8], o1[8], o2[8], p1[8], p2[8];
        unpack8(Rq1, q1f); unpack8(Rq2, q2f); unpack8(Rk1, k1f); unpack8(Rk2, k2f);
        const float pos = (float)(pos0 + c0 + t);
        const float ed = __expf(lg * (float)(nvalid - min(t + 1, nvalid)));
#pragma unroll
        for (int e = 0; e < 8; ++e) {
          const float ang = pos * invf[i0 + e];
          double rev = (double)ang * 0.15915494309189535;
          rev -= floor(rev);
          const float rf = (float)rev;
          const float sn = __builtin_amdgcn_sinf(rf), cs = __builtin_amdgcn_cosf(rf);
          const float a1 = valid ? q1f[e] : 0.f, a2 = valid ? q2f[e] : 0.f;
          const float b1 = valid ? k1f[e] : 0.f, b2 = valid ? k2f[e] : 0.f;
          o1[e] = a1 * cs - a2 * sn;
          o2[e] = a1 * sn + a2 * cs;
          p1[e] = (b1 * cs - b2 * sn) * 0.125f;
          p2[e] = (b1 * sn + b2 * cs) * 0.125f;
          KT[tsw(i0 + e, t)] = (u16)f2bf(p1[e] * ed);
          KT[tsw(32 + i0 + e, t)] = (u16)f2bf(p2[e] * ed);
        }
        *(uint4*)(QA + t * LDT + i0) = pack8(o1);
        *(uint4*)(QA + t * LDT + 32 + i0) = pack8(o2);
        *(uint4*)(KB + t * LDT + i0) = pack8(p1);
        *(uint4*)(KB + t * LDT + 32 + i0) = pack8(p2);
      }
#pragma unroll
      for (int it = 0; it < 4; ++it) {
        const int id = tid + 256 * it;
        const int t = id >> 4, j0 = (id & 15) * 8;
        uint4 v4 = Rv[it];
        if (t >= nvalid) v4 = make_uint4(0, 0, 0, 0);
        VT[tsw(j0 + 0, t)] = (u16)(v4.x & 0xffffu); VT[tsw(j0 + 1, t)] = (u16)(v4.x >> 16);
        VT[tsw(j0 + 2, t)] = (u16)(v4.y & 0xffffu); VT[tsw(j0 + 3, t)] = (u16)(v4.y >> 16);
        VT[tsw(j0 + 4, t)] = (u16)(v4.z & 0xffffu); VT[tsw(j0 + 5, t)] = (u16)(v4.z >> 16);
        VT[tsw(j0 + 6, t)] = (u16)(v4.w & 0xffffu); VT[tsw(j0 + 7, t)] = (u16)(v4.w >> 16);
      }
      if (tid < 64) {
        Gsc[tid] = lg * (float)min(tid + 1, nvalid);
        dec[tid] = __expf(lg * (float)nvalid);
      }
    }
    if (BR == 1) {
      if (w == 0) {
        float dt = 0.f, g = 0.f;
        if (lane < nvalid) {
          dt = softplus_f(dtraw + dtb);
          g = dt * aneg;
        }
        float x = g;
#pragma unroll
        for (int o = 1; o < 64; o <<= 1) {
          float y = __shfl_up(x, o);
          if (lane >= o) x += y;
        }
        const float ge = __shfl(x, 63);
        Gsc[lane] = x; dtv[lane] = dt; dec[lane] = __expf(ge); psum[lane] = __expf(ge - x);
      }
      __syncthreads();
      if (act) {
        const bool first = (c0 == 0 && ts == 0);
        const float* cst = P.in[4] + (size_t)(l * 128 + b) * 3 * 768 + chan;
#pragma unroll
        for (int p = 0; p < 4; ++p) {
          float x0[11], x1[11];
#pragma unroll
          for (int k = 0; k < 11; ++k) {
            const unsigned wd = p == 0 ? Rx[k].x : (p == 1 ? Rx[k].y : (p == 2 ? Rx[k].z : Rx[k].w));
            x0[k] = __uint_as_float(wd << 16);
            x1[k] = __uint_as_float(wd & 0xffff0000u);
          }
          if (first) {
#pragma unroll
            for (int k = 0; k < 3; ++k) {
              const float2 sv = *(const float2*)(cst + k * 768 + 2 * p);
              x0[k] = sample ? sv.x : 0.f;
              x1[k] = sample ? sv.y : 0.f;
            }
          }
          float o0[8], o1[8];
#pragma unroll
          for (int tt = 0; tt < 8; ++tt) {
            const bool valid = (ts * 8 + tt) < nvalid;
            float a0 = cbv[2 * p], a1 = cbv[2 * p + 1];
#pragma unroll
            for (int i = 0; i < 4; ++i) { a0 += cwv[i][2 * p] * x0[tt + i]; a1 += cwv[i][2 * p + 1] * x1[tt + i]; }
            o0[tt] = valid ? silu_f(a0) : 0.f;
            o1[tt] = valid ? silu_f(a1) : 0.f;
          }
          u16* rowdst = seg == 0 ? XH : (seg == 1 ? KB : QA);
#pragma unroll
          for (int tt = 0; tt < 8; ++tt) *(unsigned*)(rowdst + (ts * 8 + tt) * LDT + c8 + 2 * p) = pack2(o0[tt], o1[tt]);
          if (seg < 2) {
            const float* sc = seg == 0 ? dtv : psum;
            u16* cdst = seg == 0 ? VT : KT;
            float c0v[8], c1v[8];
#pragma unroll
            for (int tt = 0; tt < 8; ++tt) { const float f = sc[ts * 8 + tt]; c0v[tt] = o0[tt] * f; c1v[tt] = o1[tt] * f; }
            *(uint4*)(cdst + tsw(c8 + 2 * p, ts * 8)) = pack8(c0v);
            *(uint4*)(cdst + tsw(c8 + 2 * p + 1, ts * 8)) = pack8(c1v);
          }
          __builtin_amdgcn_sched_barrier(0);
        }
      }
    }
    __syncthreads();
    if (c0 + 64 < T) { REC_LOAD(c0 + 64, RgN) }

#pragma unroll
    for (int nf = 0; nf < NFV; ++nf)
      *(uint2*)(ST + (nf * 16 + r) * LDT + 16 * w + q * 4) = make_uint2(pack2(S[nf][0], S[nf][1]), pack2(S[nf][2], S[nf][3]));

    bf16x8 aq[2];
    aq[0] = *(const bf16x8*)(QA + (16 * w + r) * LDT + q * 8);
    aq[1] = *(const bf16x8*)(QA + (16 * w + r) * LDT + 32 + q * 8);
    float gt[4];
#pragma unroll
    for (int e = 0; e < 4; ++e) gt[e] = Gsc[16 * w + q * 4 + e];
#pragma unroll
    for (int n = 0; n < 4; ++n) {
      f32x4 a = (f32x4){0.f, 0.f, 0.f, 0.f};
      if (n <= w) {
#pragma unroll
        for (int kk = 0; kk < 2; ++kk) {
          bf16x8 bk = *(const bf16x8*)(KB + (16 * n + r) * LDT + kk * 32 + q * 8);
          a = __builtin_amdgcn_mfma_f32_16x16x32_bf16(aq[kk], bk, a, 0, 0, 0);
        }
      }
      const int s = 16 * n + r;
      const float gs = Gsc[s];
#pragma unroll
      for (int e = 0; e < 4; ++e) {
        const int t = 16 * w + q * 4 + e;
        float v = (s <= t) ? a[e] * __expf(gt[e] - gs) : 0.f;
        ATT[t * LDT + s] = (u16)f2bf(v);
      }
    }
    __syncthreads();

    f32x4 O[NFV];
#pragma unroll
    for (int nf = 0; nf < NFV; ++nf) O[nf] = (f32x4){0.f, 0.f, 0.f, 0.f};
#pragma unroll
    for (int kk = 0; kk < 2; ++kk)
#pragma unroll
      for (int nf = 0; nf < NFV; ++nf) {
        bf16x8 bs = *(const bf16x8*)(ST + (nf * 16 + r) * LDT + kk * 32 + q * 8);
        O[nf] = __builtin_amdgcn_mfma_f32_16x16x32_bf16(aq[kk], bs, O[nf], 0, 0, 0);
      }
    if (BR != 0) {
#pragma unroll
      for (int e = 0; e < 4; ++e) {
        const float sc = __expf(gt[e]);
#pragma unroll
        for (int nf = 0; nf < NFV; ++nf) O[nf][e] *= sc;
      }
    }
    {
      float dc[4];
#pragma unroll
      for (int e = 0; e < 4; ++e) dc[e] = dec[16 * w + q * 4 + e];
#pragma unroll
      for (int nf = 0; nf < NFV; ++nf)
#pragma unroll
        for (int e = 0; e < 4; ++e) S[nf][e] *= dc[e];
    }
    int vtb[2], ktb[2];
    vtb[0] = r * LDT + ((q ^ (r >> 3)) << 3);
    vtb[1] = r * LDT + ((q ^ (2 + (r >> 3))) << 3);
    ktb[0] = tsw(16 * w + r, q * 8);
    ktb[1] = tsw(16 * w + r, 32 + q * 8);
#pragma unroll
    for (int kk = 0; kk < 2; ++kk) {
      bf16x8 at = *(const bf16x8*)(ATT + (16 * w + r) * LDT + kk * 32 + q * 8);
      bf16x8 ak = *(const bf16x8*)(KT + ktb[kk]);
#pragma unroll
      for (int nf = 0; nf < NFV; ++nf) {
        bf16x8 bv = *(const bf16x8*)(VT + vtb[nf & 1] + nf * 16 * LDT + ((kk ^ ((nf >> 1) & 1)) * 32));
        O[nf] = __builtin_amdgcn_mfma_f32_16x16x32_bf16(at, bv, O[nf], 0, 0, 0);
        S[nf] = __builtin_amdgcn_mfma_f32_16x16x32_bf16(ak, bv, S[nf], 0, 0, 0);
      }
    }
    __syncthreads();
#pragma unroll
    for (int nf = 0; nf < NFV; ++nf)
#pragma unroll
      for (int e = 0; e < 4; ++e) OST[(16 * w + q * 4 + e) * OLD + nf * 16 + r] = O[nf][e];
    __syncthreads();

#pragma unroll
    for (int it = 0; it < NEP; ++it) {
      const int id = tid + 256 * it;
      const int t = (DV == 128) ? (id >> 4) : (id >> 3);
      const int j0 = (DV == 128) ? (id & 15) * 8 : (id & 7) * 8;
      const bool valid = t < nvalid;
      const size_t row = (size_t)(row0 + c0 + t);
      float ov[8], gv[8], y[8];
      *(float4*)&ov[0] = *(const float4*)(OST + t * OLD + j0);
      *(float4*)&ov[4] = *(const float4*)(OST + t * OLD + j0 + 4);
      unpack8(Rg[it], gv);
      if (BR == 1) {
        float xh[8];
        unpack8(*(const uint4*)(XH + t * LDT + j0), xh);
        float ss = 0.f;
#pragma unroll
        for (int e = 0; e < 8; ++e) { y[e] = (ov[e] + dsk * xh[e]) * silu_f(gv[e]); ss += y[e] * y[e]; }
        ss += __shfl_xor(ss, 1); ss += __shfl_xor(ss, 2); ss += __shfl_xor(ss, 4);
        if (valid) {
          *(uint4*)(ybr + row * LDY + h * 64 + j0) = pack8(y);
          if ((tid & 7) == 0) ssq[row * 8 + h] = ss;
        }
      } else {
        float ss = 0.f;
#pragma unroll
        for (int e = 0; e < 8; ++e) ss += ov[e] * ov[e];
        ss += __shfl_xor(ss, 1); ss += __shfl_xor(ss, 2); ss += __shfl_xor(ss, 4); ss += __shfl_xor(ss, 8);
        const float rs = rsqrtf(ss * (1.f / 128.f) + 1e-6f);
        if (BR == 0) {
          const float* wn = P.in[12] + l * 128 + j0;
          const float4 w0 = *(const float4*)wn, w1 = *(const float4*)(wn + 4);
          const float wv[8] = {w0.x, w0.y, w0.z, w0.w, w1.x, w1.y, w1.z, w1.w};
#pragma unroll
          for (int e = 0; e < 8; ++e) y[e] = silu_f(gv[e]) * ov[e] * rs * wv[e];
        } else {
#pragma unroll
          for (int e = 0; e < 8; ++e) y[e] = silu_f(gv[e]) * ov[e] * rs;
        }
        if (valid) *(uint4*)(ybr + row * LDY + h * 128 + j0) = pack8(y);
      }
      __builtin_amdgcn_sched_barrier(0);
    }
#pragma unroll
    for (int it = 0; it < NEP; ++it) Rg[it] = RgN[it];
    __syncthreads();
  }
#undef REC_LOAD

  {
    float* so;
    if (sample) so = P.out + (BR == 0 ? O_SGS : (BR == 1 ? O_SSS : O_SRS)) + ((size_t)(l * 128 + b) * NH + h) * 64 * DV;
    else so = P.out + (BR == 0 ? O_SGP : (BR == 1 ? O_SSP : O_SRP)) + ((size_t)(l * 8 + b) * NH + h) * 64 * DV;
#pragma unroll
    for (int nf = 0; nf < NFV; ++nf)
#pragma unroll
      for (int e = 0; e < 4; ++e) so[(size_t)(16 * w + q * 4 + e) * DV + nf * 16 + r] = S[nf][e];
  }
}

#ifndef REC_ONLY
#define REC_ONLY -1
#endif
template <int BR>
__device__ __forceinline__ void rec_branch(const Params& P, int l, bool split, int wb, int nwb, int lb0, unsigned char* ldsb) {
  if (!(REC_ONLY < 0 || REC_ONLY == BR)) return;
  constexpr int NH = (BR == 1) ? 8 : 4;
  constexpr int nl = 8 * NH;
  const int end = nl + 128 * NH;
  int it, step;
  if (split) {
    const int bx = blockIdx.x;
    if (bx >= lb0 && bx < lb0 + nl) { it = bx - lb0; step = 1 << 20; }
    else if (bx >= 128) { it = nl + wb; step = nwb; }
    else { it = end; step = 1; }
  } else { it = blockIdx.x; step = gridDim.x; }
  for (; it < end; it += step) {
    const int sample = it >= nl;
    const int idx = sample ? it - nl : it;
    int ll = l;
    asm volatile("" : "+s"(ll));
    rec_item<BR>(P, ll, idx / NH, idx % NH, sample, ldsb);
  }
}

__device__ __forceinline__ void phase_rec(const Params& P, int l, unsigned char* ldsb) {
  const int G = gridDim.x;
  const u16* proj = (const u16*)(P.ws + WS_A);
  const bool split = (G >= 256);
  const int wb = split ? (int)blockIdx.x - 128 : (int)blockIdx.x;
  int nwb = split ? G - 128 : G;
  asm volatile("" : "+s"(nwb));
  if (wb >= 0) {
    for (int i = wb * 256 + otid(); i < (8 + 128) * 3 * 768; i += nwb * 256) {
      const bool pr = i < 8 * 3 * 768;
      const int j = pr ? i : i - 8 * 3 * 768;
      const int b = j / (3 * 768), rem = j - b * 3 * 768, rr = rem / 768, c = rem - rr * 768;
      const size_t row = pr ? (size_t)(b * TP + 2061 + rr) : (size_t)(MP + b * 4 + 1 + rr);
      const size_t oo = pr ? O_SCP + (size_t)l * 8 * 3 * 768 + j : O_SCS + (size_t)l * 128 * 3 * 768 + j;
      P.out[oo] = bf2f(proj[row * NPJ + 2064 + c]);
    }
  }
  rec_branch<0>(P, l, split, wb, nwb, 0, ldsb);
  rec_branch<1>(P, l, split, wb, nwb, 32, ldsb);
  rec_branch<2>(P, l, split, wb, nwb, 96, ldsb);
  if (wb >= 0) {
    __syncthreads();
    if (l == 0) {
      convert_layer(P, 0, ldsb, 1888, 4576, wb, nwb);
      convert_layer(P, 1, ldsb, 0, 2528, wb, nwb);
    } else {
      convert_layer(P, 1, ldsb, 2528, 4576, wb, nwb);
    }
    phase_gates(P, l, wb, nwb, ldsb);
  }
}


#define XB_TMO      128
#define XB_XCNT(j)  (256  + 64 * (j))
#define XB_XSUB(j)  (1280 + 64 * (j))
#define XB_XGEN(j)  (2304 + 64 * (j))
#define XB_TOP      3328
#define XB_TOPGEN   3392
#define XCD_BAR_WORDS 3456
#define XB_SPIN_CAP (1u << 22)
__device__ __forceinline__ unsigned xb_ld(unsigned* p) { return __hip_atomic_load(p, __ATOMIC_RELAXED, __HIP_MEMORY_SCOPE_AGENT); }
__device__ __forceinline__ unsigned xb_add(unsigned* p, unsigned v) { return __hip_atomic_fetch_add(p, v, __ATOMIC_RELAXED, __HIP_MEMORY_SCOPE_AGENT); }
__device__ __forceinline__ unsigned xb_xcc_id() { return (unsigned)__builtin_amdgcn_s_getreg((3 << 11) | 20) & 0xFu; }
#define XB_SPIN(cond, bar) do { unsigned _sp = 0; while (cond) { __builtin_amdgcn_s_sleep(1); \
    if ((++_sp & 255u) == 0u) { if (xb_ld(&(bar)[XB_TMO])) break; if (_sp > XB_SPIN_CAP) { atomicAdd(&(bar)[XB_TMO], 1u); break; } } } } while (0)
struct XcdBarrier { unsigned* bar; unsigned x; volatile LAS unsigned* st; };
__device__ __forceinline__ XcdBarrier xcd_barrier_post(unsigned* bar, volatile LAS unsigned* st) {
  XcdBarrier b; b.bar = bar; b.x = xb_xcc_id(); b.st = st;
  if (threadIdx.x == 0) (void)xb_add(&bar[XB_XCNT(b.x)], 1u);
  return b;
}
__device__ __forceinline__ void xcd_barrier_complete(unsigned* bar, unsigned x, unsigned& nloc, unsigned& nx) {
  const unsigned G = gridDim.x * gridDim.y * gridDim.z;
  unsigned sum, cnt, mine, sp = 0u;
  for (;;) {
    sum = 0u; cnt = 0u; mine = 0u;
#pragma unroll
    for (unsigned j = 0; j < 16; ++j) { const unsigned c = xb_ld(&bar[XB_XCNT(j)]); sum += c; cnt += (c > 0u) ? 1u : 0u; mine = (j == x) ? c : mine; }
    if (sum == G) break;
    __builtin_amdgcn_s_sleep(1);
    if ((++sp & 255u) == 0u) { if (xb_ld(&bar[XB_TMO])) break; if (sp > XB_SPIN_CAP) { atomicAdd(&bar[XB_TMO], 1u); break; } }
  }
  nloc = mine > 0u ? mine : 1u; nx = cnt > 0u ? cnt : 1u;
}
__device__ __forceinline__ void xcd_barrier(const XcdBarrier& b) {
  asm volatile("s_waitcnt vmcnt(0)" ::: "memory");
  __syncthreads();
  if (threadIdx.x == 0) {
    unsigned* bar = b.bar;
    __builtin_amdgcn_s_waitcnt(0);
    unsigned nloc = b.st[0], nx = b.st[1];
    if (nloc == 0u) { xcd_barrier_complete(bar, b.x, nloc, nx); b.st[0] = nloc; b.st[1] = nx; }
    const unsigned old = xb_add(&bar[XB_XSUB(b.x)], 1u);
    const unsigned gen = old / nloc;
    if (old + 1u == (gen + 1u) * nloc) {
      __builtin_amdgcn_fence(__ATOMIC_RELEASE, "agent");
      asm volatile("s_waitcnt vmcnt(0)" ::: "memory");
      const unsigned og = xb_add(&bar[XB_TOP], 1u);
      const unsigned tg = og / nx;
      if (og + 1u == (tg + 1u) * nx) xb_add(&bar[XB_TOPGEN], 1u);
      else XB_SPIN(xb_ld(&bar[XB_TOPGEN]) == tg, bar);
      __builtin_amdgcn_fence(__ATOMIC_ACQUIRE, "agent");
      xb_add(&bar[XB_XGEN(b.x)], 1u);
      asm volatile("s_waitcnt vmcnt(0)" ::: "memory");
    } else {
      XB_SPIN(xb_ld(&bar[XB_XGEN(b.x)]) == gen, bar);
      __builtin_amdgcn_fence(__ATOMIC_ACQUIRE, "agent");
      asm volatile("s_waitcnt vmcnt(0)" ::: "memory");
    }
  }
  __syncthreads();
}

__global__ void __launch_bounds__(256, 2) fwd_kernel(Params P, int ph_lo, int ph_hi) {
  extern __shared__ __attribute__((aligned(16))) unsigned char ldsb[];
  cg::grid_group grid = cg::this_grid();
  volatile LAS unsigned* xst = (volatile LAS unsigned*)(ldsb + 75904);
  if (threadIdx.x == 0) { xst[0] = 0u; xst[1] = 0u; xst[2] = 0u; xst[3] = 0u; }
  __syncthreads();
  XcdBarrier xb = xcd_barrier_post((unsigned*)(P.ws + WS_BAR), xst);
  if (ph_hi > 1000) grid.sync();
  for (int ph = ph_lo; ph < ph_hi; ++ph) {
    if (ph > ph_lo) xcd_barrier(xb);
    if (ph == 0) {
      if (PH_ON(0)) { convert_layer(P, 0, ldsb, 0, 1888, blockIdx.x, gridDim.x); ln_phase(P, 0, 0); }
      continue;
    }
    int phl = ph;
    asm volatile("" : "+s"(phl));
    const int l = (phl - 1) >> 3, s = (phl - 1) & 7;
    switch (s) {
      case 0: if (PH_ON(1)) { phase_proj(P, l, ldsb); if (DUP(1)) phase_proj(P, l, ldsb); } break;
      case 1: if (PH_ON(2)) { phase_rec(P, l, ldsb); if (DUP(2)) { __syncthreads(); phase_rec(P, l, ldsb); } } break;
      case 2: if (PH_ON(3)) { phase_merge(P, l, ldsb); if (DUP(3)) phase_merge(P, l, ldsb); } break;
      case 3: if (PH_ON(4)) { phase_resid(P, 0, l, ldsb); if (DUP(4)) phase_resid(P, 0, l, ldsb); } break;
      case 4: if (PH_ON(5)) { ln_phase(P, 1, l); if (DUP(5)) ln_phase(P, 1, l); } break;
      case 5: if (PH_ON(6)) { phase_ff1(P, l, ldsb); if (DUP(6)) phase_ff1(P, l, ldsb); } break;
      case 6: if (PH_ON(7)) { phase_resid(P, 1, l, ldsb); if (DUP(7)) phase_resid(P, 1, l, ldsb); } break;
      case 7:
        if (PH_ON(8)) { ln_phase(P, 2, l); }
        break;
    }
  }
}

extern "C" void kernel_launch(void* const* d_in, const int* in_sizes, int n_in, void* d_out, int out_size, void* d_ws,
                              size_t ws_size, hipStream_t stream) {
  static int grid_blocks = 0;
  if (grid_blocks == 0) {
    if (n_in != 31 || ws_size < WS_END || out_size != 44666880) {
      fprintf(stderr, "kernel_launch: unexpected problem (n_in %d, ws %zu, out %d)\n", n_in, ws_size, out_size);
      grid_blocks = -1;
      return;
    }
    int dev = 0, cus = 0, per_cu = 0;
    hipGetDevice(&dev);
    hipDeviceGetAttribute(&cus, hipDeviceAttributeMultiprocessorCount, dev);
    hipFuncSetAttribute((const void*)fwd_kernel, hipFuncAttributeMaxDynamicSharedMemorySize, LDS_BYTES);
    hipOccupancyMaxActiveBlocksPerMultiprocessor(&per_cu, (const void*)fwd_kernel, 256, LDS_BYTES);
    if (per_cu < 1) { fprintf(stderr, "kernel_launch: occupancy query says 0 blocks per CU\n"); grid_blocks = -1; return; }
    if (per_cu > 2) per_cu = 2;
    grid_blocks = cus * per_cu;
    grid_blocks -= grid_blocks % 8;
  }
  if (grid_blocks < 0) return;
  Params p{};
  for (int i = 0; i < 31; ++i) p.in[i] = (const float*)d_in[i];
  p.out = (float*)d_out;
  p.ws = (unsigned char*)d_ws;
  if (hipMemsetAsync((char*)d_ws + WS_BAR, 0, XCD_BAR_WORDS * 4, stream) != hipSuccess) { fprintf(stderr, "memset failed\n"); return; }
#if ONE_LAUNCH
  int lo = 0, hi = NPHASE;
  void* args[] = {&p, &lo, &hi};
  hipError_t e = hipLaunchCooperativeKernel((const void*)fwd_kernel, dim3(grid_blocks), dim3(256), args, LDS_BYTES, stream);
  if (e != hipSuccess) fprintf(stderr, "cooperative launch failed: %s (grid %d)\n", hipGetErrorString(e), grid_blocks);
#else
  for (int ph = 0; ph < NPHASE; ++ph) {
    hipLaunchKernelGGL(fwd_kernel, dim3(grid_blocks), dim3(256), LDS_BYTES, stream, p, ph, ph + 1);
  }
#endif
}
```

```cpp
#include <hip/hip_runtime.h>
#include <hip/hip_cooperative_groups.h>
#include <stdint.h>
#include <stdio.h>
namespace cg = cooperative_groups;

#ifndef ONE_LAUNCH
#define ONE_LAUNCH 1
#endif
#ifndef PHASE_ONLY
#define PHASE_ONLY -1
#endif
#define PH_ON(n) (PHASE_ONLY < 0 || PHASE_ONLY == (n))
#ifndef DUP_MASK
#define DUP_MASK 0
#endif
#define DUP(n) ((DUP_MASK >> (n)) & 1)

#define LAS __attribute__((address_space(3)))
typedef unsigned short u16;
typedef __attribute__((ext_vector_type(8))) short bf16x8;
typedef __attribute__((ext_vector_type(4))) float f32x4;

constexpr int D = 1024;
constexpr int TP = 2064;
constexpr int MP = 8 * TP;
constexpr int MS = 512;
constexpr int M = MP + MS;
constexpr int NPJ = 4376;
constexpr int LDT = 72;
constexpr float ALPHA = 1.4142135623730951f;
constexpr int NPHASE = 17;
constexpr int SPLIT_ROW0 = 128 * 128;

constexpr int LDA = 1088;
constexpr int LDY = 576;
constexpr int LDH = 4160;
constexpr size_t WS_WIN = 0;
constexpr size_t WS_WGATE = 9748480;
constexpr size_t WS_WOUT = 16433152;
constexpr size_t WS_WO = 19972096;
constexpr size_t WS_WFF1 = 22200320;
constexpr size_t WS_WFF2 = 31113216;
constexpr size_t WS_ACT = 39632896;
constexpr size_t WS_SSQ = 76677120;
constexpr size_t WS_A = 77221888;
constexpr size_t WS_B = 226215936;
constexpr size_t WS_BAR = 295946240;
constexpr size_t WS_W2 = WS_BAR + 16384;
constexpr size_t WS_G1X = WS_W2 + 22200320;
constexpr size_t WS_END = WS_G1X + 524288;
constexpr int G1_SPLIT = 16768;
constexpr size_t A_PRE = 37044224;

constexpr size_t O_YP = 0, O_YS = 16777216, O_SGP = 17301504, O_SGS = 17825792, O_SSP = 26214400, O_SSS = 26738688,
                 O_SCP = 35127296, O_SCS = 35164160, O_SRP = 35753984, O_SRS = 36278272;

constexpr int LDS_BYTES = 76032;

struct Params { const float* in[31]; float* out; unsigned char* ws; };

__device__ __forceinline__ unsigned f2bf(float f) {
  unsigned u = __float_as_uint(f);
  u += 0x7fffu + ((u >> 16) & 1u);
  return u >> 16;
}
__device__ __forceinline__ float bf2f(u16 h) { return __uint_as_float(((unsigned)h) << 16); }
__device__ __forceinline__ unsigned pack2(float a, float b) { return f2bf(a) | (f2bf(b) << 16); }
__device__ __forceinline__ void unpack8(uint4 v, float (&f)[8]) {
  f[0] = __uint_as_float(v.x << 16); f[1] = __uint_as_float(v.x & 0xffff0000u);
  f[2] = __uint_as_float(v.y << 16); f[3] = __uint_as_float(v.y & 0xffff0000u);
  f[4] = __uint_as_float(v.z << 16); f[5] = __uint_as_float(v.z & 0xffff0000u);
  f[6] = __uint_as_float(v.w << 16); f[7] = __uint_as_float(v.w & 0xffff0000u);
}
__device__ __forceinline__ uint4 pack8(const float (&f)[8]) {
  return make_uint4(pack2(f[0], f[1]), pack2(f[2], f[3]), pack2(f[4], f[5]), pack2(f[6], f[7]));
}
__device__ __forceinline__ int tsw(int row, int col) { return row * LDT + (col ^ (((row >> 3) & 7) << 3)); }
__device__ __forceinline__ int otid() { int t = threadIdx.x; asm volatile("" : "+v"(t)); return t; }
__device__ __forceinline__ float silu_f(float x) { return x / (1.f + __expf(-x)); }
__device__ __forceinline__ float silu_rcp(float x) { return x * __builtin_amdgcn_rcpf(1.f + __expf(-x)); }
__device__ __forceinline__ float sigmoid_f(float x) { return 1.f / (1.f + __expf(-x)); }
__device__ __forceinline__ float softplus_f(float x) { return fmaxf(x, 0.f) + log1pf(__expf(-fabsf(x))); }

__device__ __forceinline__ void conv_tile64(const float* __restrict__ src, int ld, int ldk, int ncol0, int nvalid, u16* __restrict__ dst,
                            int kt, int nt, const float* __restrict__ kscale, float* tile, int blocked_nkt = 0) {
  const int tid = otid();
  const int c = tid & 63, r4 = tid >> 6;
  const int n = nt * 64 + c;
  const bool ok = n < nvalid;
#pragma unroll
  for (int i = 0; i < 16; ++i) {
    int k = r4 + 4 * i;
    int kg = kt * 64 + k;
    float v = ok ? src[(size_t)kg * ld + ncol0 + n] : 0.f;
    if (kscale) v *= kscale[kg];
    tile[k * 65 + c] = v;
  }
  __syncthreads();
#pragma unroll
  for (int it = 0; it < 2; ++it) {
    int id = tid + 256 * it;
    int nn = id >> 3, kc = id & 7;
    unsigned w0 = pack2(tile[(kc * 8 + 0) * 65 + nn], tile[(kc * 8 + 1) * 65 + nn]);
    unsigned w1 = pack2(tile[(kc * 8 + 2) * 65 + nn], tile[(kc * 8 + 3) * 65 + nn]);
    unsigned w2 = pack2(tile[(kc * 8 + 4) * 65 + nn], tile[(kc * 8 + 5) * 65 + nn]);
    unsigned w3 = pack2(tile[(kc * 8 + 6) * 65 + nn], tile[(kc * 8 + 7) * 65 + nn]);
    const int n_ = nt * 64 + nn;
    const size_t di = blocked_nkt ? ((size_t)((n_ >> 7) * blocked_nkt + kt) * 8192 + (n_ & 127) * 64 + kc * 8)
                                  : ((size_t)n_ * ldk + kt * 64 + kc * 8);
    *(uint4*)(dst + di) = make_uint4(w0, w1, w2, w3);
  }
  __syncthreads();
}

__device__ __forceinline__ void convert_layer(const Params& P, int l, unsigned char* lds, int t_lo, int t_hi, int wb, int nwb) {
  float* tile = (float*)lds;
  unsigned char* ws = P.ws;
  const size_t wsel = (l == 0) ? 0 : WS_W2;
  for (int t = t_lo + wb; t < t_hi; t += nwb) {
    int idx = t;
    if (idx < 1120) {
      conv_tile64(P.in[9] + (size_t)l * 1024 * 7448, 7448, LDA, 0, NPJ, (u16*)(ws + wsel + WS_WIN), idx % 16, idx / 16, nullptr, tile);
      continue;
    }
    idx -= 1120;
    if (idx < 768) {
      conv_tile64(P.in[9] + (size_t)l * 1024 * 7448, 7448, LDA, NPJ, 3072, (u16*)(ws + wsel + WS_WGATE), idx % 16, idx / 16, nullptr, tile);
      continue;
    }
    idx -= 768;
    if (idx < 384) {
      int br = idx / 128, r = idx % 128;
      conv_tile64(P.in[19 + br] + (size_t)l * 512 * 1024, 1024, LDY, 0, 1024, (u16*)(ws + wsel + WS_WOUT) + (size_t)br * 1024 * LDY,
                  r % 8, r / 8, br == 1 ? P.in[18] + l * 512 : nullptr, tile);
      continue;
    }
    idx -= 384;
    if (idx < 256) {
      conv_tile64(P.in[22] + (size_t)l * 1024 * 1024, 1024, LDA, 0, 1024, (u16*)(ws + wsel + WS_WO), idx % 16, idx / 16, nullptr, tile);
      continue;
    }
    idx -= 256;
    if (idx < 1024) {
      conv_tile64(P.in[25] + (size_t)l * 1024 * 4096, 4096, LDA, 0, 4096, (u16*)(ws + WS_WFF1), idx % 16, idx / 16, nullptr, tile);
      continue;
    }
    idx -= 1024;
    conv_tile64(P.in[27] + (size_t)l * 4096 * 1024, 1024, LDH, 0, 1024, (u16*)(ws + WS_WFF2), idx % 64, idx / 64, nullptr, tile, 64);
  }
}

__device__ __forceinline__ void ln_phase(const Params& P, int mode, int l) {
  const int tid_ = otid();
  const int lane = tid_ & 63;
  const int gw = blockIdx.x * 4 + (tid_ >> 6);
  const int nw = gridDim.x * 4;
  const float* wv = mode == 0 ? P.in[7] : (mode == 1 ? P.in[23] + l * D : P.in[29] + l * D);
  const float* bv = mode == 0 ? P.in[8] : (mode == 1 ? P.in[24] + l * D : P.in[30] + l * D);
  u16* act = (u16*)(P.ws + WS_ACT);
  const bool final_out = (mode == 2 && l == 1);
  for (int row = gw; row < M; row += nw) {
    const float* s;
    int b = 0, t = 0;
    if (row < MP) { b = row / TP; t = row - b * TP; }
    if (mode == 0) {
      if (row < MP) s = (t < 16) ? P.in[6] + (size_t)t * D : P.in[0] + ((size_t)b * 2048 + (t - 16)) * D;
      else s = P.in[1] + (size_t)(row - MP) * D;
    } else if (mode == 1) {
      s = (const float*)(P.ws + WS_A + A_PRE) + (size_t)row * D;
    } else {
      s = (const float*)(P.ws + WS_B) + (size_t)row * D;
    }
    float4 v[4];
#pragma unroll
    for (int i = 0; i < 4; ++i) v[i] = *(const float4*)(s + i * 256 + lane * 4);
    float sum = 0.f;
#pragma unroll
    for (int i = 0; i < 4; ++i) sum += v[i].x + v[i].y + v[i].z + v[i].w;
#pragma unroll
    for (int o = 32; o >= 1; o >>= 1) sum += __shfl_xor(sum, o);
    const float mean = sum * (1.f / 1024.f);
    float sq = 0.f;
#pragma unroll
    for (int i = 0; i < 4; ++i) {
      v[i].x -= mean; v[i].y -= mean; v[i].z -= mean; v[i].w -= mean;
      sq += v[i].x * v[i].x + v[i].y * v[i].y + v[i].z * v[i].z + v[i].w * v[i].w;
    }
#pragma unroll
    for (int o = 32; o >= 1; o >>= 1) sq += __shfl_xor(sq, o);
    const float rstd = rsqrtf(sq * (1.f / 1024.f) + 1e-5f);
    float* od = nullptr;
    if (final_out) {
      if (row < MP) { if (t >= 16) od = P.out + O_YP + ((size_t)b * 2048 + (t - 16)) * D; }
      else od = P.out + O_YS + (size_t)(row - MP) * D;
    }
#pragma unroll
    for (int i = 0; i < 4; ++i) {
      const int c = i * 256 + lane * 4;
      float4 w4 = *(const float4*)(wv + c), b4 = *(const float4*)(bv + c);
      float y0 = v[i].x * rstd * w4.x + b4.x, y1 = v[i].y * rstd * w4.y + b4.y;
      float y2 = v[i].z * rstd * w4.z + b4.z, y3 = v[i].w * rstd * w4.w + b4.w;
      if (final_out) {
        if (od) *(float4*)(od + c) = make_float4(y0, y1, y2, y3);
      } else {
        const unsigned p0 = pack2(y0, y1), p1 = pack2(y2, y3);
        *(uint2*)(act + (size_t)row * LDA + c) = make_uint2(p0, p1);
        if (mode == 1 && row >= SPLIT_ROW0) {
          const float4 bb = *(const float4*)(P.in[28] + l * D + c);
          float* pz = (float*)(P.ws + WS_B) + (size_t)row * D + c;
          *(float4*)pz = make_float4(ALPHA * __uint_as_float(p0 << 16) + bb.x, ALPHA * __uint_as_float(p0 & 0xffff0000u) + bb.y,
                                     ALPHA * __uint_as_float(p1 << 16) + bb.z, ALPHA * __uint_as_float(p1 & 0xffff0000u) + bb.w);
        }
      }
    }
  }
}

#define G_LOAD4(R, k0)                                                                    \
  R##a0 = *(const uint4*)(ap + (k0)); R##a1 = *(const uint4*)(ap + sa + (k0));            \
  R##a2 = *(const uint4*)(ap + 2 * sa + (k0)); R##a3 = *(const uint4*)(ap + 3 * sa + (k0)); \
  R##b0 = *(const uint4*)(bp + (k0)); R##b1 = *(const uint4*)(bp + sb + (k0));
#define G_LOADB(R, k0)                                                                    \
  R##b2 = *(const uint4*)(bp + 2 * sb + (k0)); R##b3 = *(const uint4*)(bp + 3 * sb + (k0));
#define L_STORE4(R, buf)                                                                  \
  { u16* ad = As + (buf) * 128 * LDT + crow * LDT + cck;                                  \
    u16* bd = Bs + (buf) * BN * LDT + crow * LDT + cck;                                   \
    *(uint4*)(ad) = R##a0; *(uint4*)(ad + 32 * LDT) = R##a1; *(uint4*)(ad + 64 * LDT) = R##a2; *(uint4*)(ad + 96 * LDT) = R##a3; \
    *(uint4*)(bd) = R##b0; *(uint4*)(bd + 32 * LDT) = R##b1;                              \
    if (NF == 4) { *(uint4*)(bd + 64 * LDT) = R##b2; *(uint4*)(bd + 96 * LDT) = R##b3; } }
#define MMA_TILE(buf)                                                                     \
  { const u16* as = As + (buf) * 128 * LDT + (wm * 64 + r) * LDT + q * 8;                 \
    const u16* bs = Bs + (buf) * BN * LDT + (wn * NF * 16 + r) * LDT + q * 8;             \
    _Pragma("unroll") for (int kk = 0; kk < 2; ++kk) {                                    \
      bf16x8 af[4], bfr[NF];                                                              \
      _Pragma("unroll") for (int mf = 0; mf < 4; ++mf) af[mf] = *(const bf16x8*)(as + mf * 16 * LDT + kk * 32); \
      _Pragma("unroll") for (int nf = 0; nf < NF; ++nf) bfr[nf] = *(const bf16x8*)(bs + nf * 16 * LDT + kk * 32); \
      _Pragma("unroll") for (int mf = 0; mf < 4; ++mf)                                    \
        _Pragma("unroll") for (int nf = 0; nf < NF; ++nf)                                 \
          acc[mf][nf] = __builtin_amdgcn_mfma_f32_16x16x32_bf16(af[mf], bfr[nf], acc[mf][nf], 0, 0, 0); \
    } }

__device__ __forceinline__ int lds_byte(int r, int c) {
  int st = (r >> 4) * 2 + (c >> 5), rr = r & 15, cc = c & 31, ob = rr * 64 + cc * 2;
  return st * 1024 + (ob ^ (((ob >> 9) & 1) << 5));
}
__device__ __forceinline__ void stage_rc(int b, int& R, int& C) {
  int st = b >> 10, sb = b & 1023, swz = sb ^ (((sb >> 9) & 1) << 5);
  R = (st >> 1) * 16 + (swz >> 6);
  C = (st & 1) * 32 + ((swz & 63) >> 1);
}

template <int NF>
__device__ __forceinline__ void gemm_core(f32x4 (&acc)[4][NF], const u16* __restrict__ A, int lda,
                                          const u16* __restrict__ B, int ldb, int K, u16* lds, int kadv = 64) {
  constexpr int BN = 32 * NF;
  constexpr int ABYTES = 128 * 64 * 2;
  constexpr int BBYTES = BN * 64 * 2;
  constexpr int BUF = ABYTES + BBYTES;
  unsigned char* base = (unsigned char*)lds;
  const int tid = otid(), lane = tid & 63, w = tid >> 6, wm = w >> 1, wn = w & 1, r = lane & 15, q = lane >> 4;
  const u16* ga[4]; const u16* gb[NF];
#pragma unroll
  for (int i = 0; i < 4; ++i) { int R, C; stage_rc(tid * 16 + i * 4096, R, C); ga[i] = A + (size_t)R * lda + C; }
#pragma unroll
  for (int i = 0; i < NF; ++i) { int R, C; stage_rc(tid * 16 + i * 4096, R, C); gb[i] = B + (size_t)R * ldb + C; }
  int oa[4][2], ob[NF][2];
#pragma unroll
  for (int mf = 0; mf < 4; ++mf)
#pragma unroll
    for (int kk = 0; kk < 2; ++kk) oa[mf][kk] = lds_byte(wm * 64 + mf * 16 + r, kk * 32 + q * 8);
#pragma unroll
  for (int nf = 0; nf < NF; ++nf)
#pragma unroll
    for (int kk = 0; kk < 2; ++kk) ob[nf][kk] = lds_byte(wn * NF * 16 + nf * 16 + r, kk * 32 + q * 8);
#define STAGE_TILE(buf, k0)                                                                              \
  {                                                                                                      \
    _Pragma("unroll") for (int i = 0; i < 4; ++i)                                                        \
      __builtin_amdgcn_global_load_lds((const unsigned*)(ga[i] + (k0)),                                  \
        (LAS unsigned*)(base + (buf) * BUF + tid * 16 + i * 4096), 16, 0, 0);                            \
    _Pragma("unroll") for (int i = 0; i < NF; ++i)                                                       \
      __builtin_amdgcn_global_load_lds((const unsigned*)(gb[i] + (k0)),                                  \
        (LAS unsigned*)(base + (buf) * BUF + ABYTES + tid * 16 + i * 4096), 16, 0, 0);                   \
  }
  const int nk = K >> 6;
  STAGE_TILE(0, 0)
  asm volatile("s_waitcnt vmcnt(0)" ::: "memory");
  __syncthreads();
  for (int kt = 0; kt < nk; ++kt) {
    const int buf = kt & 1;
    if (kt + 1 < nk) STAGE_TILE(buf ^ 1, (size_t)(kt + 1) * kadv)
    const unsigned char* as = base + buf * BUF;
    const unsigned char* bs = as + ABYTES;
    bf16x8 af0[4], bf0[NF], af1[4], bf1[NF];
#pragma unroll
    for (int mf = 0; mf < 4; ++mf) af0[mf] = *(const bf16x8*)(as + oa[mf][0]);
#pragma unroll
    for (int nf = 0; nf < NF; ++nf) bf0[nf] = *(const bf16x8*)(bs + ob[nf][0]);
    __builtin_amdgcn_s_setprio(1);
#pragma unroll
    for (int nf = 0; nf < NF / 2; ++nf)
#pragma unroll
      for (int mf = 0; mf < 4; ++mf)
        acc[mf][nf] = __builtin_amdgcn_mfma_f32_16x16x32_bf16(af0[mf], bf0[nf], acc[mf][nf], 0, 0, 0);
    __builtin_amdgcn_s_setprio(0);
#pragma unroll
    for (int mf = 0; mf < 4; ++mf) af1[mf] = *(const bf16x8*)(as + oa[mf][1]);
#pragma unroll
    for (int nf = 0; nf < NF; ++nf) bf1[nf] = *(const bf16x8*)(bs + ob[nf][1]);
    __builtin_amdgcn_s_setprio(1);
#pragma unroll
    for (int nf = NF / 2; nf < NF; ++nf)
#pragma unroll
      for (int mf = 0; mf < 4; ++mf)
        acc[mf][nf] = __builtin_amdgcn_mfma_f32_16x16x32_bf16(af0[mf], bf0[nf], acc[mf][nf], 0, 0, 0);
#pragma unroll
    for (int nf = 0; nf < NF; ++nf)
#pragma unroll
      for (int mf = 0; mf < 4; ++mf)
        acc[mf][nf] = __builtin_amdgcn_mfma_f32_16x16x32_bf16(af1[mf], bf1[nf], acc[mf][nf], 0, 0, 0);
    __builtin_amdgcn_s_setprio(0);
    asm volatile("s_waitcnt vmcnt(0)" ::: "memory");
    __syncthreads();
  }
#undef STAGE_TILE
}

#define TILE_LOOP(total)                                                                      \
  const int _nx = (gridDim.x % 8 == 0) ? 8 : 1;                                              \
  const int _ns = gridDim.x / _nx;                                                           \
  const int _x = blockIdx.x % _nx, _s = blockIdx.x / _nx;                                    \
  const int _per = ((total) + _nx - 1) / _nx;                                                \
  const int _lo = _x * _per;                                                                 \
  const int _hi = min((total), _lo + _per);                                                  \
  for (int t = _lo + _s; t < _hi; t += _ns)

__device__ __forceinline__ void tile_decode(int t, int MT, int NT, int& mt, int& nt) {
  int g = t / (8 * NT), r = t - g * 8 * NT;
  int gs = min(8, MT - g * 8);
  mt = g * 8 + r % gs;
  nt = r / gs;
}

template <int NF>
__device__ __forceinline__ void zero_acc(f32x4 (&acc)[4][NF]) {
#pragma unroll
  for (int i = 0; i < 4; ++i)
#pragma unroll
    for (int j = 0; j < NF; ++j) acc[i][j] = (f32x4){0.f, 0.f, 0.f, 0.f};
}

__device__ __forceinline__ void phase_proj(const Params& P, int l, unsigned char* ldsb) {
  const u16* act = (const u16*)(P.ws + WS_ACT);
  const u16* W = (const u16*)(P.ws + (l == 0 ? 0 : WS_W2) + WS_WIN);
  u16* proj = (u16*)(P.ws + WS_A);
  constexpr int MT = 133, NT = 35;
  TILE_LOOP(MT * NT) {
    int mt, nt; tile_decode(t, MT, NT, mt, nt);
    const int tid_ = otid(), lane = tid_ & 63, w = tid_ >> 6, wm = w >> 1, wn = w & 1, r = lane & 15, q = lane >> 4;
    f32x4 acc[4][4]; zero_acc<4>(acc);
    gemm_core<4>(acc, act + (size_t)mt * 128 * LDA, LDA, W + (size_t)nt * 128 * LDA, LDA, D, (u16*)ldsb);
#pragma unroll
    for (int mf = 0; mf < 4; ++mf)
#pragma unroll
      for (int nf = 0; nf < 4; ++nf) {
        const int col = nt * 128 + wn * 64 + nf * 16 + r;
        if (col < NPJ) {
#pragma unroll
          for (int e = 0; e < 4; ++e) {
            const int row = mt * 128 + wm * 64 + mf * 16 + q * 4 + e;
            proj[(size_t)row * NPJ + col] = (u16)f2bf(acc[mf][nf][e]);
          }
        }
      }
  }
}

__device__ __forceinline__ u16* gate_row(const Params& P, int br, int row) {
  if (br == 0) return (u16*)P.out + (size_t)row * D;
  if (row < G1_SPLIT) return (u16*)P.out + (size_t)M * D + (size_t)row * D;
  return (u16*)(P.ws + WS_G1X) + (size_t)(row - G1_SPLIT) * D;
}

__device__ __forceinline__ void phase_gates(const Params& P, int l, int wb, int nwb, unsigned char* ldsb) {
  const u16* act = (const u16*)(P.ws + WS_ACT);
  const u16* Wg = (const u16*)(P.ws + (l == 0 ? 0 : WS_W2) + WS_WGATE);
  constexpr int MT = 133, NT = 8;
  for (int t = wb; t < 2 * MT * NT; t += nwb) {
    const int br = t / (MT * NT);
    int mt, nt; tile_decode(t - br * MT * NT, MT, NT, mt, nt);
    const int tid_ = otid(), lane = tid_ & 63, w = tid_ >> 6, wm = w >> 1, wn = w & 1, r = lane & 15, q = lane >> 4;
    f32x4 acc[4][4]; zero_acc<4>(acc);
    gemm_core<4>(acc, act + (size_t)mt * 128 * LDA, LDA, Wg + ((size_t)br * 1024 + nt * 128) * LDA, LDA, D, (u16*)ldsb);
#pragma unroll
    for (int mf = 0; mf < 4; ++mf)
#pragma unroll
      for (int e = 0; e < 4; ++e) {
        const int row = mt * 128 + wm * 64 + mf * 16 + q * 4 + e;
        u16* gr = gate_row(P, br, row);
#pragma unroll
        for (int nf = 0; nf < 4; ++nf) gr[nt * 128 + wn * 64 + nf * 16 + r] = (u16)f2bf(sigmoid_f(acc[mf][nf][e]));
      }
  }
}

__device__ __forceinline__ void phase_merge(const Params& P, int l, unsigned char* ldsb) {
  const u16* act = (const u16*)(P.ws + WS_ACT);
  const u16* Wg = (const u16*)(P.ws + (l == 0 ? 0 : WS_W2) + WS_WGATE);
  const u16* Wo = (const u16*)(P.ws + (l == 0 ? 0 : WS_W2) + WS_WOUT);
  const u16* ybr = (const u16*)(P.ws + WS_B);
  const float* ssq = (const float*)(P.ws + WS_SSQ);
  u16* merged = (u16*)(P.ws + WS_A);
  constexpr int MT = 133, NT = 16;
  {
    float* pre = (float*)(P.ws + WS_A + A_PRE);
    for (int i = blockIdx.x * 256 + otid(); i < (M - SPLIT_ROW0) * (D / 4); i += gridDim.x * 256) {
      const int row = SPLIT_ROW0 + i / (D / 4), c = (i % (D / 4)) * 4;
      const uint2 xv = *(const uint2*)(act + (size_t)row * LDA + c);
      *(float4*)(pre + (size_t)row * D + c) = make_float4(ALPHA * __uint_as_float(xv.x << 16), ALPHA * __uint_as_float(xv.x & 0xffff0000u),
                                                          ALPHA * __uint_as_float(xv.y << 16), ALPHA * __uint_as_float(xv.y & 0xffff0000u));
    }
  }
  TILE_LOOP(MT * NT) {
    int mt, nt; tile_decode(t, MT, NT, mt, nt);
    const int tid_ = otid(), lane = tid_ & 63, w = tid_ >> 6, wm = w >> 1, wn = w & 1, r = lane & 15, q = lane >> 4;
    f32x4 fin[4][2]; zero_acc<2>(fin);
#pragma unroll 1
    for (int br = 0; br < 3; ++br) {
      f32x4 g[4][2]; zero_acc<2>(g);
      if (br == 2) {
        gemm_core<2>(g, act + (size_t)mt * 128 * LDA, LDA, Wg + ((size_t)br * 1024 + nt * 64) * LDA, LDA, D, (u16*)ldsb);
#pragma unroll
        for (int mf = 0; mf < 4; ++mf)
#pragma unroll
          for (int nf = 0; nf < 2; ++nf)
#pragma unroll
            for (int e = 0; e < 4; ++e) g[mf][nf][e] = sigmoid_f(g[mf][nf][e]);
      } else {
#pragma unroll
        for (int mf = 0; mf < 4; ++mf)
#pragma unroll
          for (int e = 0; e < 4; ++e) {
            const u16* gr = gate_row(P, br, mt * 128 + wm * 64 + mf * 16 + q * 4 + e) + nt * 64 + wn * 32 + r;
#pragma unroll
            for (int nf = 0; nf < 2; ++nf) g[mf][nf][e] = bf2f(gr[nf * 16]);
          }
      }
      const u16* yb = ybr + (size_t)br * M * LDY + (size_t)mt * 128 * LDY;
      const u16* wb = Wo + (size_t)br * 1024 * LDY + (size_t)nt * 64 * LDY;
      if (br != 1) {
        f32x4 acc[4][2]; zero_acc<2>(acc);
        gemm_core<2>(acc, yb, LDY, wb, LDY, 512, (u16*)ldsb);
#pragma unroll
        for (int mf = 0; mf < 4; ++mf)
#pragma unroll
          for (int nf = 0; nf < 2; ++nf)
#pragma unroll
            for (int e = 0; e < 4; ++e) fin[mf][nf][e] += g[mf][nf][e] * acc[mf][nf][e];
      } else {
#pragma unroll 1
        for (int grp = 0; grp < 2; ++grp) {
          f32x4 acc[4][2]; zero_acc<2>(acc);
          gemm_core<2>(acc, yb + grp * 256, LDY, wb + grp * 256, LDY, 256, (u16*)ldsb);
#pragma unroll
          for (int mf = 0; mf < 4; ++mf)
#pragma unroll
            for (int e = 0; e < 4; ++e) {
              const int row = mt * 128 + wm * 64 + mf * 16 + q * 4 + e;
              float4 s4 = *(const float4*)(ssq + (size_t)row * 8 + grp * 4);
              float rs = rsqrtf((s4.x + s4.y + s4.z + s4.w) * (1.f / 256.f) + 1e-6f);
#pragma unroll
              for (int nf = 0; nf < 2; ++nf) fin[mf][nf][e] += g[mf][nf][e] * rs * acc[mf][nf][e];
            }
        }
      }
    }
#pragma unroll
    for (int mf = 0; mf < 4; ++mf)
#pragma unroll
      for (int nf = 0; nf < 2; ++nf)
#pragma unroll
        for (int e = 0; e < 4; ++e) {
          const int row = mt * 128 + wm * 64 + mf * 16 + q * 4 + e;
          const int col = nt * 64 + wn * 32 + nf * 16 + r;
          merged[(size_t)row * LDA + col] = (u16)f2bf(fin[mf][nf][e]);
        }
  }
}

__device__ __forceinline__ void phase_resid(const Params& P, int mode, int l, unsigned char* ldsb) {
  const u16* act = (const u16*)(P.ws + WS_ACT);
  const u16* A = (const u16*)(P.ws + WS_A);
  const int K = mode == 0 ? 1024 : 4096;
  const int ldk = mode == 0 ? LDA : LDH;
  const u16* W = (const u16*)(P.ws + (mode == 0 ? (l == 0 ? 0 : WS_W2) + WS_WO : WS_WFF2));
  float* dst = mode == 0 ? (float*)(P.ws + WS_A + A_PRE) : (float*)(P.ws + WS_B);
  const float* bias = P.in[28] + l * D;
  constexpr int MT = 128, NT = 8;
  TILE_LOOP(MT * NT) {
    int mt, nt; tile_decode(t, MT, NT, mt, nt);
    const int tid_ = otid(), lane = tid_ & 63, w = tid_ >> 6, wm = w >> 1, wn = w & 1, r = lane & 15, q = lane >> 4;
    f32x4 acc[4][4]; zero_acc<4>(acc);
    if (mode == 0) gemm_core<4>(acc, A + (size_t)mt * 128 * ldk, ldk, W + (size_t)nt * 128 * ldk, ldk, K, (u16*)ldsb);
    else gemm_core<4>(acc, A + (size_t)mt * 64 * 8192, 64, W + (size_t)nt * 64 * 8192, 64, K, (u16*)ldsb, 8192);
#pragma unroll
    for (int mf = 0; mf < 4; ++mf)
#pragma unroll
      for (int nf = 0; nf < 4; ++nf) {
        const int col = nt * 128 + wn * 64 + nf * 16 + r;
        const float bb = mode == 1 ? bias[col] : 0.f;
#pragma unroll
        for (int e = 0; e < 4; ++e) {
          const int row = mt * 128 + wm * 64 + mf * 16 + q * 4 + e;
          dst[(size_t)row * D + col] = ALPHA * bf2f(act[(size_t)row * LDA + col]) + acc[mf][nf][e] + bb;
        }
      }
  }
  {
    constexpr int S = 8;
    const int KS = K / S;
    for (int li = blockIdx.x; li < 40 * S; li += gridDim.x) {
      const int sl = li % S, tl = li / S;
      const int mt = 128 + tl / 8, nt = tl % 8;
      const int tid_ = otid(), lane = tid_ & 63, w = tid_ >> 6, wm = w >> 1, wn = w & 1, r = lane & 15, q = lane >> 4;
      f32x4 acc[4][4]; zero_acc<4>(acc);
      if (mode == 0) gemm_core<4>(acc, A + (size_t)mt * 128 * ldk + sl * KS, ldk, W + (size_t)nt * 128 * ldk + sl * KS, ldk, KS, (u16*)ldsb);
      else gemm_core<4>(acc, A + ((size_t)mt * 64 + sl * (KS / 64)) * 8192, 64, W + ((size_t)nt * 64 + sl * (KS / 64)) * 8192, 64, KS, (u16*)ldsb, 8192);
#pragma unroll
      for (int mf = 0; mf < 4; ++mf)
#pragma unroll
        for (int nf = 0; nf < 4; ++nf) {
          const int col = nt * 128 + wn * 64 + nf * 16 + r;
#pragma unroll
          for (int e = 0; e < 4; ++e) {
            const int row = mt * 128 + wm * 64 + mf * 16 + q * 4 + e;
            (void)__hip_atomic_fetch_add(dst + (size_t)row * D + col, acc[mf][nf][e], __ATOMIC_RELAXED, __HIP_MEMORY_SCOPE_AGENT);
          }
        }
    }
  }
}

__device__ __forceinline__ void phase_ff1(const Params& P, int l, unsigned char* ldsb) {
  const u16* act = (const u16*)(P.ws + WS_ACT);
  const u16* W = (const u16*)(P.ws + WS_WFF1);
  u16* hid = (u16*)(P.ws + WS_A);
  const float* bias = P.in[26] + l * 4096;
  constexpr int MT = 133, NT = 32;
  TILE_LOOP(MT * NT) {
    int mt, nt; tile_decode(t, MT, NT, mt, nt);
    const int tid_ = otid(), lane = tid_ & 63, w = tid_ >> 6, wm = w >> 1, wn = w & 1, r = lane & 15, q = lane >> 4;
    f32x4 acc[4][4]; zero_acc<4>(acc);
    gemm_core<4>(acc, act + (size_t)mt * 128 * LDA, LDA, W + (size_t)nt * 128 * LDA, LDA, D, (u16*)ldsb);
#pragma unroll
    for (int mf = 0; mf < 4; ++mf)
#pragma unroll
      for (int nf = 0; nf < 4; ++nf) {
        const int col = nt * 128 + wn * 64 + nf * 16 + r;
        const float bb = bias[col];
#pragma unroll
        for (int e = 0; e < 4; ++e) {
          const int row = mt * 128 + wm * 64 + mf * 16 + q * 4 + e;
          float v = fmaxf(acc[mf][nf][e] + bb, 0.f);
          hid[((size_t)(row >> 7) * 64 + (col >> 6)) * 8192 + (row & 127) * 64 + (col & 63)] = (u16)f2bf(v * v);
        }
      }
  }
}

template <int BR>
__device__ __forceinline__ void rec_item(const Params& P, int l, int b, int h, int sample, unsigned char* ldsb) {
  constexpr int DV = (BR == 1) ? 64 : 128;
  constexpr int NFV = DV / 16;
  constexpr int NH = (BR == 1) ? 8 : 4;
  constexpr int OLD = DV + 4;
  constexpr int NEP = DV / 32;
  u16* QA = (u16*)ldsb;
  u16* KB = QA + 64 * LDT;
  u16* KT = KB + 64 * LDT;
  u16* ATT = KT + 64 * LDT;
  u16* VT = ATT + 64 * LDT;
  u16* ST = VT + 128 * LDT;
  float* Gsc = (float*)(ST + 128 * LDT);
  float* dec = Gsc + 64;
  float* dtv = dec + 64;
  float* psum = dtv + 64;
  float* invf = psum + 256;
  float* Gl = (float*)ST;
  float* AL = (float*)ATT;
  float* OST = (float*)ldsb;
  u16* XH = VT + 64 * LDT;

  const int tid = otid(), lane = tid & 63, w = tid >> 6, r = lane & 15, q = lane >> 4;
  const int T = sample ? 4 : TP;
  const int row0 = sample ? MP + b * 4 : b * TP;
  const int pos0 = sample ? 16384 : 0;
  const u16* proj = (const u16*)(P.ws + WS_A);
  u16* ybr = (u16*)(P.ws + WS_B) + (size_t)BR * M * LDY;
  float* ssq = (float*)(P.ws + WS_SSQ);

  float lg = 0.f, aneg = 0.f, dtb = 0.f, dsk = 0.f;
  if (BR == 2) {
    lg = log1pf(-exp2f(-5.f - (float)h));
    if (tid < 32) invf[tid] = exp2f(-(float)tid * (13.287712379549449f / 32.0f));
  }
  if (BR == 1) {
    aneg = -__expf(P.in[16][l * 8 + h]);
    dtb = P.in[15][l * 8 + h];
    dsk = P.in[17][l * 8 + h];
  }
  const int grp = h >> 2;

  f32x4 S[NFV];
  {
    const float* sin_ = P.in[2];
    if (sample) {
      const float* base = BR == 0 ? P.in[2] : (BR == 1 ? P.in[3] : P.in[5]);
      sin_ = base + ((size_t)(l * 128 + b) * NH + h) * 64 * DV;
    }
#pragma unroll
    for (int nf = 0; nf < NFV; ++nf)
#pragma unroll
      for (int e = 0; e < 4; ++e) {
        float v = sin_[(size_t)(16 * w + q * 4 + e) * DV + nf * 16 + r];
        S[nf][e] = sample ? v : 0.f;
      }
  }
  __syncthreads();

  uint4 Rg[NEP], RgN[NEP];
  uint4 Rq[2], Rk[2], Rv[4], Ral;
  uint4 Rq1, Rq2, Rk1, Rk2;
  uint4 Rx[11];
  float dtraw = 0.f;
  const int ci = tid & 63, part = tid >> 6;
  float w2r[16];
  float bias = 0.f;
  if (BR == 0) {
#pragma unroll
    for (int rr = 0; rr < 16; ++rr) w2r[rr] = P.in[10][(size_t)(l * 16 + rr) * 256 + h * 64 + ci];
    bias = P.in[11][l * 256 + h * 64 + ci];
  }
  const int cc = tid >> 3, ts = tid & 7;
  const bool act = tid < 192;
  const int seg = cc >> 3, c8 = (cc & 7) * 8;
  const int chan = seg == 0 ? h * 64 + c8 : (seg == 1 ? 512 + grp * 64 + c8 : 640 + grp * 64 + c8);
  float cwv[4][8], cbv[8];
  if (BR == 1 && act) {
    const float* cw = P.in[13] + (size_t)l * 4 * 768 + chan;
    const float* cb = P.in[14] + (size_t)l * 768 + chan;
#pragma unroll
    for (int i = 0; i < 4; ++i) {
      *(float4*)&cwv[i][0] = *(const float4*)(cw + i * 768);
      *(float4*)&cwv[i][4] = *(const float4*)(cw + i * 768 + 4);
    }
    *(float4*)&cbv[0] = *(const float4*)cb;
    *(float4*)&cbv[4] = *(const float4*)(cb + 4);
  }
#define REC_LOAD(CB, RGD)                                                                                     \
  {                                                                                                           \
    const int goff_ = BR == 0 ? 1024 + h * 128 : (BR == 1 ? 1552 + h * 64 : 3864 + h * 128);                  \
    _Pragma("unroll") for (int it = 0; it < NEP; ++it) {                                                      \
      const int id = tid + 256 * it;                                                                          \
      const int t = (DV == 128) ? (id >> 4) : (id >> 3);                                                      \
      const int j0 = (DV == 128) ? (id & 15) * 8 : (id & 7) * 8;                                              \
      RGD[it] = *(const uint4*)(proj + (size_t)(row0 + min((CB) + t, T - 1)) * NPJ + goff_ + j0);             \
    }                                                                                                         \
    if (BR == 0) {                                                                                            \
      _Pragma("unroll") for (int it = 0; it < 2; ++it) {                                                      \
        const int id = tid + 256 * it;                                                                        \
        const int t = id >> 3, i0 = (id & 7) * 8;                                                             \
        const u16* rp = proj + (size_t)(row0 + min((CB) + t, T - 1)) * NPJ + h * 64 + i0;                     \
        Rq[it] = *(const uint4*)rp;                                                                           \
        Rk[it] = *(const uint4*)(rp + 256);                                                                   \
      }                                                                                                       \
      { const int t = (tid & 127) >> 1, hf = tid & 1;                                                         \
        Ral = *(const uint4*)(proj + (size_t)(row0 + min((CB) + t, T - 1)) * NPJ + 1536 + hf * 8); }          \
    }                                                                                                         \
    if (BR == 2) {                                                                                            \
      const int t = tid >> 2, i0 = (tid & 3) * 8;                                                             \
      const u16* rp = proj + (size_t)(row0 + min((CB) + t, T - 1)) * NPJ + 2840 + h * 64 + i0;                \
      Rq1 = *(const uint4*)rp; Rq2 = *(const uint4*)(rp + 32);                                                \
      Rk1 = *(const uint4*)(rp + 256); Rk2 = *(const uint4*)(rp + 288);                                       \
    }                                                                                                         \
    if (BR == 1) {                                                                                            \
      if (act) {                                                                                              \
        _Pragma("unroll") for (int k = 0; k < 11; ++k) {                                                      \
          int tau = (CB) + ts * 8 - 3 + k;                                                                    \
          tau = min(max(tau, 0), T - 1);                                                                      \
          Rx[k] = *(const uint4*)(proj + (size_t)(row0 + tau) * NPJ + 2064 + chan);                           \
        }                                                                                                     \
      }                                                                                                       \
      if (w == 0) dtraw = bf2f(proj[(size_t)(row0 + min((CB) + lane, T - 1)) * NPJ + 2832 + h]);              \
    }                                                                                                         \
  }
  REC_LOAD(0, Rg)

  for (int c0 = 0; c0 < T; c0 += 64) {
    const int nvalid = min(64, T - c0);
    if (BR == 0 || BR == 2) {
      const int voff_ = (BR == 0 ? 512 : 3352) + h * 128;
#pragma unroll
      for (int it = 0; it < 4; ++it) {
        const int id = tid + 256 * it;
        const int t = id >> 4, j0 = (id & 15) * 8;
        Rv[it] = *(const uint4*)(proj + (size_t)(row0 + min(c0 + t, T - 1)) * NPJ + voff_ + j0);
      }
    }
    if (BR == 0) {
      if (tid < 128) {
        const int t = tid >> 1, hf = tid & 1;
        float a8[8];
        unpack8(Ral, a8);
        *(float4*)(AL + t * 16 + hf * 8) = make_float4(a8[0], a8[1], a8[2], a8[3]);
        *(float4*)(AL + t * 16 + hf * 8 + 4) = make_float4(a8[4], a8[5], a8[6], a8[7]);
      }
      __syncthreads();
      {
        float run = 0.f;
#pragma unroll 4
        for (int tt = 0; tt < 16; ++tt) {
          const int t = part * 16 + tt;
          const float4 x0 = *(const float4*)(AL + t * 16), x1 = *(const float4*)(AL + t * 16 + 4);
          const float4 x2 = *(const float4*)(AL + t * 16 + 8), x3 = *(const float4*)(AL + t * 16 + 12);
          float a = bias;
          a += x0.x * w2r[0] + x0.y * w2r[1] + x0.z * w2r[2] + x0.w * w2r[3];
          a += x1.x * w2r[4] + x1.y * w2r[5] + x1.z * w2r[6] + x1.w * w2r[7];
          a += x2.x * w2r[8] + x2.y * w2r[9] + x2.z * w2r[10] + x2.w * w2r[11];
          a += x3.x * w2r[12] + x3.y * w2r[13] + x3.z * w2r[14] + x3.w * w2r[15];
          float g = (fminf(a, 0.f) - __logf(1.f + __expf(-fabsf(a)))) * (1.f / 16.f);
          if (t >= nvalid) g = 0.f;
          run += g;
          Gl[t * 64 + ci] = run;
        }
        psum[part * 64 + ci] = run;
      }
      __syncthreads();
      {
        float off = 0.f;
        for (int p = 0; p < part; ++p) off += psum[p * 64 + ci];
#pragma unroll 4
        for (int tt = 0; tt < 16; ++tt) Gl[(part * 16 + tt) * 64 + ci] += off;
      }
      __syncthreads();
#pragma unroll
      for (int it = 0; it < 2; ++it) {
        const int id = tid + 256 * it;
        const int t = id >> 3, i0 = (id & 7) * 8;
        const bool valid = t < nvalid;
        float qf[8], kf[8], G[8], Ge[8], qa[8], kb[8];
        unpack8(Rq[it], qf); unpack8(Rk[it], kf);
        *(float4*)&G[0] = *(const float4*)(Gl + t * 64 + i0);
        *(float4*)&G[4] = *(const float4*)(Gl + t * 64 + i0 + 4);
        *(float4*)&Ge[0] = *(const float4*)(Gl + 63 * 64 + i0);
        *(float4*)&Ge[4] = *(const float4*)(Gl + 63 * 64 + i0 + 4);
#pragma unroll
        for (int e = 0; e < 8; ++e) {
          const float qv = valid ? qf[e] : 0.f, kv = valid ? kf[e] : 0.f;
          qa[e] = qv * 0.125f * __expf(G[e]);
          kb[e] = kv * __expf(-G[e]);
          KT[tsw(i0 + e, t)] = (u16)f2bf(kv * __expf(Ge[e] - G[e]));
        }
        *(uint4*)(QA + t * LDT + i0) = pack8(qa);
        *(uint4*)(KB + t * LDT + i0) = pack8(kb);
        if (t == 63) {
#pragma unroll
          for (int e = 0; e < 8; ++e) dec[i0 + e] = __expf(Ge[e]);
        }
        __builtin_amdgcn_sched_barrier(0);
      }
#pragma unroll
      for (int it = 0; it < 4; ++it) {
        const int id = tid + 256 * it;
        const int t = id >> 4, j0 = (id & 15) * 8;
        uint4 v4 = Rv[it];
        if (t >= nvalid) v4 = make_uint4(0, 0, 0, 0);
        VT[tsw(j0 + 0, t)] = (u16)(v4.x & 0xffffu); VT[tsw(j0 + 1, t)] = (u16)(v4.x >> 16);
        VT[tsw(j0 + 2, t)] = (u16)(v4.y & 0xffffu); VT[tsw(j0 + 3, t)] = (u16)(v4.y >> 16);
        VT[tsw(j0 + 4, t)] = (u16)(v4.z & 0xffffu); VT[tsw(j0 + 5, t)] = (u16)(v4.z >> 16);
        VT[tsw(j0 + 6, t)] = (u16)(v4.w & 0xffffu); VT[tsw(j0 + 7, t)] = (u16)(v4.w >> 16);
      }
      if (tid < 64) Gsc[tid] = 0.f;
    }
    if (BR == 2) {
      {
        const int t = tid >> 2, i0 = (tid & 3) * 8;
        const bool valid = t < nvalid;
        float q1f[8], q2f[8], k1f[8], k2f[8], o1[8], o2[8], p1[8], p2[8];
        unpack8(Rq1, q1f); unpack8(Rq2, q2f); unpack8(Rk1, k1f); unpack8(Rk2, k2f);
        const float pos = (float)(pos0 + c0 + t);
        const float ed = __expf(lg * (float)(nvalid - min(t + 1, nvalid)));
#pragma unroll
        for (int e = 0; e < 8; ++e) {
          const float ang = pos * invf[i0 + e];
          double rev = (double)ang * 0.15915494309189535;
          rev -= floor(rev);
          const float rf = (float)rev;
          const float sn = __builtin_amdgcn_sinf(rf), cs = __builtin_amdgcn_cosf(rf);
          const float a1 = valid ? q1f[e] : 0.f, a2 = valid ? q2f[e] : 0.f;
          const float b1 = valid ? k1f[e] : 0.f, b2 = valid ? k2f[e] : 0.f;
          o1[e] = a1 * cs - a2 * sn;
          o2[e] = a1 * sn + a2 * cs;
          p1[e] = (b1 * cs - b2 * sn) * 0.125f;
          p2[e] = (b1 * sn + b2 * cs) * 0.125f;
          KT[tsw(i0 + e, t)] = (u16)f2bf(p1[e] * ed);
          KT[tsw(32 + i0 + e, t)] = (u16)f2bf(p2[e] * ed);
        }
        *(uint4*)(QA + t * LDT + i0) = pack8(o1);
        *(uint4*)(QA + t * LDT + 32 + i0) = pack8(o2);
        *(uint4*)(KB + t * LDT + i0) = pack8(p1);
        *(uint4*)(KB + t * LDT + 32 + i0) = pack8(p2);
      }
#pragma unroll
      for (int it = 0; it < 4; ++it) {
        const int id = tid + 256 * it;
        const int t = id >> 4, j0 = (id & 15) * 8;
        uint4 v4 = Rv[it];
        if (t >= nvalid) v4 = make_uint4(0, 0, 0, 0);
        VT[tsw(j0 + 0, t)] = (u16)(v4.x & 0xffffu); VT[tsw(j0 + 1, t)] = (u16)(v4.x >> 16);
        VT[tsw(j0 + 2, t)] = (u16)(v4.y & 0xffffu); VT[tsw(j0 + 3, t)] = (u16)(v4.y >> 16);
        VT[tsw(j0 + 4, t)] = (u16)(v4.z & 0xffffu); VT[tsw(j0 + 5, t)] = (u16)(v4.z >> 16);
        VT[tsw(j0 + 6, t)] = (u16)(v4.w & 0xffffu); VT[tsw(j0 + 7, t)] = (u16)(v4.w >> 16);
      }
      if (tid < 64) {
        Gsc[tid] = lg * (float)min(tid + 1, nvalid);
        dec[tid] = __expf(lg * (float)nvalid);
      }
    }
    if (BR == 1) {
      if (w == 0) {
        float dt = 0.f, g = 0.f;
        if (lane < nvalid) {
          dt = softplus_f(dtraw + dtb);
          g = dt * aneg;
        }
        float x = g;
#pragma unroll
        for (int o = 1; o < 64; o <<= 1) {
          float y = __shfl_up(x, o);
          if (lane >= o) x += y;
        }
        const float ge = __shfl(x, 63);
        Gsc[lane] = x; dtv[lane] = dt; dec[lane] = __expf(ge); psum[lane] = __expf(ge - x);
      }
      __syncthreads();
      if (act) {
        const bool first = (c0 == 0 && ts == 0);
        const float* cst = P.in[4] + (size_t)(l * 128 + b) * 3 * 768 + chan;
#pragma unroll
        for (int p = 0; p < 4; ++p) {
          float x0[11], x1[11];
#pragma unroll
          for (int k = 0; k < 11; ++k) {
            const unsigned wd = p == 0 ? Rx[k].x : (p == 1 ? Rx[k].y : (p == 2 ? Rx[k].z : Rx[k].w));
            x0[k] = __uint_as_float(wd << 16);
            x1[k] = __uint_as_float(wd & 0xffff0000u);
          }
          if (first) {
#pragma unroll
            for (int k = 0; k < 3; ++k) {
              const float2 sv = *(const float2*)(cst + k * 768 + 2 * p);
              x0[k] = sample ? sv.x : 0.f;
              x1[k] = sample ? sv.y : 0.f;
            }
          }
          float o0[8], o1[8];
#pragma unroll
          for (int tt = 0; tt < 8; ++tt) {
            const bool valid = (ts * 8 + tt) < nvalid;
            float a0 = cbv[2 * p], a1 = cbv[2 * p + 1];
#pragma unroll
            for (int i = 0; i < 4; ++i) { a0 += cwv[i][2 * p] * x0[tt + i]; a1 += cwv[i][2 * p + 1] * x1[tt + i]; }
            o0[tt] = valid ? silu_f(a0) : 0.f;
            o1[tt] = valid ? silu_f(a1) : 0.f;
          }
          u16* rowdst = seg == 0 ? XH : (seg == 1 ? KB : QA);
#pragma unroll
          for (int tt = 0; tt < 8; ++tt) *(unsigned*)(rowdst + (ts * 8 + tt) * LDT + c8 + 2 * p) = pack2(o0[tt], o1[tt]);
          if (seg < 2) {
            const float* sc = seg == 0 ? dtv : psum;
            u16* cdst = seg == 0 ? VT : KT;
            float c0v[8], c1v[8];
#pragma unroll
            for (int tt = 0; tt < 8; ++tt) { const float f = sc[ts * 8 + tt]; c0v[tt] = o0[tt] * f; c1v[tt] = o1[tt] * f; }
            *(uint4*)(cdst + tsw(c8 + 2 * p, ts * 8)) = pack8(c0v);
            *(uint4*)(cdst + tsw(c8 + 2 * p + 1, ts * 8)) = pack8(c1v);
          }
          __builtin_amdgcn_sched_barrier(0);
        }
      }
    }
    __syncthreads();
    if (c0 + 64 < T) { REC_LOAD(c0 + 64, RgN) }

#pragma unroll
    for (int nf = 0; nf < NFV; ++nf)
      *(uint2*)(ST + (nf * 16 + r) * LDT + 16 * w + q * 4) = make_uint2(pack2(S[nf][0], S[nf][1]), pack2(S[nf][2], S[nf][3]));

    bf16x8 aq[2];
    aq[0] = *(const bf16x8*)(QA + (16 * w + r) * LDT + q * 8);
    aq[1] = *(const bf16x8*)(QA + (16 * w + r) * LDT + 32 + q * 8);
    float gt[4];
#pragma unroll
    for (int e = 0; e < 4; ++e) gt[e] = Gsc[16 * w + q * 4 + e];
#pragma unroll
    for (int n = 0; n < 4; ++n) {
      f32x4 a = (f32x4){0.f, 0.f, 0.f, 0.f};
      if (n <= w) {
#pragma unroll
        for (int kk = 0; kk < 2; ++kk) {
          bf16x8 bk = *(const bf16x8*)(KB + (16 * n + r) * LDT + kk * 32 + q * 8);
          a = __builtin_amdgcn_mfma_f32_16x16x32_bf16(aq[kk], bk, a, 0, 0, 0);
        }
      }
      const int s = 16 * n + r;
      const float gs = Gsc[s];
#pragma unroll
      for (int e = 0; e < 4; ++e) {
        const int t = 16 * w + q * 4 + e;
        float v = (s <= t) ? a[e] * __expf(gt[e] - gs) : 0.f;
        ATT[t * LDT + s] = (u16)f2bf(v);
      }
    }
    __syncthreads();

    f32x4 O[NFV];
#pragma unroll
    for (int nf = 0; nf < NFV; ++nf) O[nf] = (f32x4){0.f, 0.f, 0.f, 0.f};
#pragma unroll
    for (int kk = 0; kk < 2; ++kk)
#pragma unroll
      for (int nf = 0; nf < NFV; ++nf) {
        bf16x8 bs = *(const bf16x8*)(ST + (nf * 16 + r) * LDT + kk * 32 + q * 8);
        O[nf] = __builtin_amdgcn_mfma_f32_16x16x32_bf16(aq[kk], bs, O[nf], 0, 0, 0);
      }
    if (BR != 0) {
#pragma unroll
      for (int e = 0; e < 4; ++e) {
        const float sc = __expf(gt[e]);
#pragma unroll
        for (int nf = 0; nf < NFV; ++nf) O[nf][e] *= sc;
      }
    }
    {
      float dc[4];
#pragma unroll
      for (int e = 0; e < 4; ++e) dc[e] = dec[16 * w + q * 4 + e];
#pragma unroll
      for (int nf = 0; nf < NFV; ++nf)
#pragma unroll
        for (int e = 0; e < 4; ++e) S[nf][e] *= dc[e];
    }
    int vtb[2], ktb[2];
    vtb[0] = r * LDT + ((q ^ (r >> 3)) << 3);
    vtb[1] = r * LDT + ((q ^ (2 + (r >> 3))) << 3);
    ktb[0] = tsw(16 * w + r, q * 8);
    ktb[1] = tsw(16 * w + r, 32 + q * 8);
#pragma unroll
    for (int kk = 0; kk < 2; ++kk) {
      bf16x8 at = *(const bf16x8*)(ATT + (16 * w + r) * LDT + kk * 32 + q * 8);
      bf16x8 ak = *(const bf16x8*)(KT + ktb[kk]);
#pragma unroll
      for (int nf = 0; nf < NFV; ++nf) {
        bf16x8 bv = *(const bf16x8*)(VT + vtb[nf & 1] + nf * 16 * LDT + ((kk ^ ((nf >> 1) & 1)) * 32));
        O[nf] = __builtin_amdgcn_mfma_f32_16x16x32_bf16(at, bv, O[nf], 0, 0, 0);
        S[nf] = __builtin_amdgcn_mfma_f32_16x16x32_bf16(ak, bv, S[nf], 0, 0, 0);
      }
    }
    __syncthreads();
#pragma unroll
    for (int nf = 0; nf < NFV; ++nf)
#pragma unroll
      for (int e = 0; e < 4; ++e) OST[(16 * w + q * 4 + e) * OLD + nf * 16 + r] = O[nf][e];
    __syncthreads();

#pragma unroll
    for (int it = 0; it < NEP; ++it) {
      const int id = tid + 256 * it;
      const int t = (DV == 128) ? (id >> 4) : (id >> 3);
      const int j0 = (DV == 128) ? (id & 15) * 8 : (id & 7) * 8;
      const bool valid = t < nvalid;
      const size_t row = (size_t)(row0 + c0 + t);
      float ov[8], gv[8], y[8];
      *(float4*)&ov[0] = *(const float4*)(OST + t * OLD + j0);
      *(float4*)&ov[4] = *(const float4*)(OST + t * OLD + j0 + 4);
      unpack8(Rg[it], gv);
      if (BR == 1) {
        float xh[8];
        unpack8(*(const uint4*)(XH + t * LDT + j0), xh);
        float ss = 0.f;
#pragma unroll
        for (int e = 0; e < 8; ++e) { y[e] = (ov[e] + dsk * xh[e]) * silu_rcp(gv[e]); ss += y[e] * y[e]; }
        ss += __shfl_xor(ss, 1); ss += __shfl_xor(ss, 2); ss += __shfl_xor(ss, 4);
        if (valid) {
          *(uint4*)(ybr + row * LDY + h * 64 + j0) = pack8(y);
          if ((tid & 7) == 0) ssq[row * 8 + h] = ss;
        }
      } else {
        float ss = 0.f;
#pragma unroll
        for (int e = 0; e < 8; ++e) ss += ov[e] * ov[e];
        ss += __shfl_xor(ss, 1); ss += __shfl_xor(ss, 2); ss += __shfl_xor(ss, 4); ss += __shfl_xor(ss, 8);
        const float rs = rsqrtf(ss * (1.f / 128.f) + 1e-6f);
        if (BR == 0) {
          const float* wn = P.in[12] + l * 128 + j0;
          const float4 w0 = *(const float4*)wn, w1 = *(const float4*)(wn + 4);
          const float wv[8] = {w0.x, w0.y, w0.z, w0.w, w1.x, w1.y, w1.z, w1.w};
#pragma unroll
          for (int e = 0; e < 8; ++e) y[e] = silu_rcp(gv[e]) * ov[e] * rs * wv[e];
        } else {
#pragma unroll
          for (int e = 0; e < 8; ++e) y[e] = silu_rcp(gv[e]) * ov[e] * rs;
        }
        if (valid) *(uint4*)(ybr + row * LDY + h * 128 + j0) = pack8(y);
      }
      __builtin_amdgcn_sched_barrier(0);
    }
#pragma unroll
    for (int it = 0; it < NEP; ++it) Rg[it] = RgN[it];
    __syncthreads();
  }
#undef REC_LOAD

  {
    float* so;
    if (sample) so = P.out + (BR == 0 ? O_SGS : (BR == 1 ? O_SSS : O_SRS)) + ((size_t)(l * 128 + b) * NH + h) * 64 * DV;
    else so = P.out + (BR == 0 ? O_SGP : (BR == 1 ? O_SSP : O_SRP)) + ((size_t)(l * 8 + b) * NH + h) * 64 * DV;
#pragma unroll
    for (int nf = 0; nf < NFV; ++nf)
#pragma unroll
      for (int e = 0; e < 4; ++e) so[(size_t)(16 * w + q * 4 + e) * DV + nf * 16 + r] = S[nf][e];
  }
}

#ifndef REC_ONLY
#define REC_ONLY -1
#endif
template <int BR>
__device__ __forceinline__ void rec_branch(const Params& P, int l, bool split, int wb, int nwb, int lb0, unsigned char* ldsb) {
  if (!(REC_ONLY < 0 || REC_ONLY == BR)) return;
  constexpr int NH = (BR == 1) ? 8 : 4;
  constexpr int nl = 8 * NH;
  const int end = nl + 128 * NH;
  int it, step;
  if (split) {
    const int bx = blockIdx.x;
    if (bx >= lb0 && bx < lb0 + nl) { it = bx - lb0; step = 1 << 20; }
    else if (bx >= 128) { it = nl + wb; step = nwb; }
    else { it = end; step = 1; }
  } else { it = blockIdx.x; step = gridDim.x; }
  for (; it < end; it += step) {
    const int sample = it >= nl;
    const int idx = sample ? it - nl : it;
    int ll = l;
    asm volatile("" : "+s"(ll));
    rec_item<BR>(P, ll, idx / NH, idx % NH, sample, ldsb);
  }
}

__device__ __forceinline__ void phase_rec(const Params& P, int l, unsigned char* ldsb) {
  const int G = gridDim.x;
  const u16* proj = (const u16*)(P.ws + WS_A);
  const bool split = (G >= 256);
  const int wb = split ? (int)blockIdx.x - 128 : (int)blockIdx.x;
  int nwb = split ? G - 128 : G;
  asm volatile("" : "+s"(nwb));
  if (wb >= 0) {
    for (int i = wb * 256 + otid(); i < (8 + 128) * 3 * 768; i += nwb * 256) {
      const bool pr = i < 8 * 3 * 768;
      const int j = pr ? i : i - 8 * 3 * 768;
      const int b = j / (3 * 768), rem = j - b * 3 * 768, rr = rem / 768, c = rem - rr * 768;
      const size_t row = pr ? (size_t)(b * TP + 2061 + rr) : (size_t)(MP + b * 4 + 1 + rr);
      const size_t oo = pr ? O_SCP + (size_t)l * 8 * 3 * 768 + j : O_SCS + (size_t)l * 128 * 3 * 768 + j;
      P.out[oo] = bf2f(proj[row * NPJ + 2064 + c]);
    }
  }
  rec_branch<0>(P, l, split, wb, nwb, 0, ldsb);
  rec_branch<1>(P, l, split, wb, nwb, 32, ldsb);
  rec_branch<2>(P, l, split, wb, nwb, 96, ldsb);
  if (wb >= 0) {
    __syncthreads();
    if (l == 0) {
      convert_layer(P, 0, ldsb, 1888, 4576, wb, nwb);
      convert_layer(P, 1, ldsb, 0, 2528, wb, nwb);
    } else {
      convert_layer(P, 1, ldsb, 2528, 4576, wb, nwb);
    }
    phase_gates(P, l, wb, nwb, ldsb);
  }
}


#define XB_TMO      128
#define XB_XCNT(j)  (256  + 64 * (j))
#define XB_XSUB(j)  (1280 + 64 * (j))
#define XB_XGEN(j)  (2304 + 64 * (j))
#define XB_TOP      3328
#define XB_TOPGEN   3392
#define XCD_BAR_WORDS 3456
#define XB_SPIN_CAP (1u << 22)
__device__ __forceinline__ unsigned xb_ld(unsigned* p) { return __hip_atomic_load(p, __ATOMIC_RELAXED, __HIP_MEMORY_SCOPE_AGENT); }
__device__ __forceinline__ unsigned xb_add(unsigned* p, unsigned v) { return __hip_atomic_fetch_add(p, v, __ATOMIC_RELAXED, __HIP_MEMORY_SCOPE_AGENT); }
__device__ __forceinline__ unsigned xb_xcc_id() { return (unsigned)__builtin_amdgcn_s_getreg((3 << 11) | 20) & 0xFu; }
#define XB_SPIN(cond, bar) do { unsigned _sp = 0; while (cond) { __builtin_amdgcn_s_sleep(1); \
    if ((++_sp & 255u) == 0u) { if (xb_ld(&(bar)[XB_TMO])) break; if (_sp > XB_SPIN_CAP) { atomicAdd(&(bar)[XB_TMO], 1u); break; } } } } while (0)
struct XcdBarrier { unsigned* bar; unsigned x; volatile LAS unsigned* st; };
__device__ __forceinline__ XcdBarrier xcd_barrier_post(unsigned* bar, volatile LAS unsigned* st) {
  XcdBarrier b; b.bar = bar; b.x = xb_xcc_id(); b.st = st;
  if (threadIdx.x == 0) (void)xb_add(&bar[XB_XCNT(b.x)], 1u);
  return b;
}
__device__ __forceinline__ void xcd_barrier_complete(unsigned* bar, unsigned x, unsigned& nloc, unsigned& nx) {
  const unsigned G = gridDim.x * gridDim.y * gridDim.z;
  unsigned sum, cnt, mine, sp = 0u;
  for (;;) {
    sum = 0u; cnt = 0u; mine = 0u;
#pragma unroll
    for (unsigned j = 0; j < 16; ++j) { const unsigned c = xb_ld(&bar[XB_XCNT(j)]); sum += c; cnt += (c > 0u) ? 1u : 0u; mine = (j == x) ? c : mine; }
    if (sum == G) break;
    __builtin_amdgcn_s_sleep(1);
    if ((++sp & 255u) == 0u) { if (xb_ld(&bar[XB_TMO])) break; if (sp > XB_SPIN_CAP) { atomicAdd(&bar[XB_TMO], 1u); break; } }
  }
  nloc = mine > 0u ? mine : 1u; nx = cnt > 0u ? cnt : 1u;
}
__device__ __forceinline__ void xcd_barrier(const XcdBarrier& b) {
  asm volatile("s_waitcnt vmcnt(0)" ::: "memory");
  __syncthreads();
  if (threadIdx.x == 0) {
    unsigned* bar = b.bar;
    __builtin_amdgcn_s_waitcnt(0);
    unsigned nloc = b.st[0], nx = b.st[1];
    if (nloc == 0u) { xcd_barrier_complete(bar, b.x, nloc, nx); b.st[0] = nloc; b.st[1] = nx; }
    const unsigned old = xb_add(&bar[XB_XSUB(b.x)], 1u);
    const unsigned gen = old / nloc;
    if (old + 1u == (gen + 1u) * nloc) {
      __builtin_amdgcn_fence(__ATOMIC_RELEASE, "agent");
      asm volatile("s_waitcnt vmcnt(0)" ::: "memory");
      const unsigned og = xb_add(&bar[XB_TOP], 1u);
      const unsigned tg = og / nx;
      if (og + 1u == (tg + 1u) * nx) xb_add(&bar[XB_TOPGEN], 1u);
      else XB_SPIN(xb_ld(&bar[XB_TOPGEN]) == tg, bar);
      __builtin_amdgcn_fence(__ATOMIC_ACQUIRE, "agent");
      xb_add(&bar[XB_XGEN(b.x)], 1u);
      asm volatile("s_waitcnt vmcnt(0)" ::: "memory");
    } else {
      XB_SPIN(xb_ld(&bar[XB_XGEN(b.x)]) == gen, bar);
      __builtin_amdgcn_fence(__ATOMIC_ACQUIRE, "agent");
      asm volatile("s_waitcnt vmcnt(0)" ::: "memory");
    }
  }
  __syncthreads();
}

__global__ void __launch_bounds__(256, 2) fwd_kernel(Params P, int ph_lo, int ph_hi) {
  extern __shared__ __attribute__((aligned(16))) unsigned char ldsb[];
  cg::grid_group grid = cg::this_grid();
  volatile LAS unsigned* xst = (volatile LAS unsigned*)(ldsb + 75904);
  if (threadIdx.x == 0) { xst[0] = 0u; xst[1] = 0u; xst[2] = 0u; xst[3] = 0u; }
  __syncthreads();
  XcdBarrier xb = xcd_barrier_post((unsigned*)(P.ws + WS_BAR), xst);
  if (ph_hi > 1000) grid.sync();
  for (int ph = ph_lo; ph < ph_hi; ++ph) {
    if (ph > ph_lo) xcd_barrier(xb);
    if (ph == 0) {
      if (PH_ON(0)) { convert_layer(P, 0, ldsb, 0, 1888, blockIdx.x, gridDim.x); ln_phase(P, 0, 0); }
      continue;
    }
    int phl = ph;
    asm volatile("" : "+s"(phl));
    const int l = (phl - 1) >> 3, s = (phl - 1) & 7;
    switch (s) {
      case 0: if (PH_ON(1)) { phase_proj(P, l, ldsb); if (DUP(1)) phase_proj(P, l, ldsb); } break;
      case 1: if (PH_ON(2)) { phase_rec(P, l, ldsb); if (DUP(2)) { __syncthreads(); phase_rec(P, l, ldsb); } } break;
      case 2: if (PH_ON(3)) { phase_merge(P, l, ldsb); if (DUP(3)) phase_merge(P, l, ldsb); } break;
      case 3: if (PH_ON(4)) { phase_resid(P, 0, l, ldsb); if (DUP(4)) phase_resid(P, 0, l, ldsb); } break;
      case 4: if (PH_ON(5)) { ln_phase(P, 1, l); if (DUP(5)) ln_phase(P, 1, l); } break;
      case 5: if (PH_ON(6)) { phase_ff1(P, l, ldsb); if (DUP(6)) phase_ff1(P, l, ldsb); } break;
      case 6: if (PH_ON(7)) { phase_resid(P, 1, l, ldsb); if (DUP(7)) phase_resid(P, 1, l, ldsb); } break;
      case 7:
        if (PH_ON(8)) { ln_phase(P, 2, l); }
        break;
    }
  }
}

extern "C" void kernel_launch(void* const* d_in, const int* in_sizes, int n_in, void* d_out, int out_size, void* d_ws,
                              size_t ws_size, hipStream_t stream) {
  static int grid_blocks = 0;
  if (grid_blocks == 0) {
    if (n_in != 31 || ws_size < WS_END || out_size != 44666880) {
      fprintf(stderr, "kernel_launch: unexpected problem (n_in %d, ws %zu, out %d)\n", n_in, ws_size, out_size);
      grid_blocks = -1;
      return;
    }
    int dev = 0, cus = 0, per_cu = 0;
    hipGetDevice(&dev);
    hipDeviceGetAttribute(&cus, hipDeviceAttributeMultiprocessorCount, dev);
    hipFuncSetAttribute((const void*)fwd_kernel, hipFuncAttributeMaxDynamicSharedMemorySize, LDS_BYTES);
    hipOccupancyMaxActiveBlocksPerMultiprocessor(&per_cu, (const void*)fwd_kernel, 256, LDS_BYTES);
    if (per_cu < 1) { fprintf(stderr, "kernel_launch: occupancy query says 0 blocks per CU\n"); grid_blocks = -1; return; }
    if (per_cu > 2) per_cu = 2;
    grid_blocks = cus * per_cu;
    grid_blocks -= grid_blocks % 8;
  }
  if (grid_blocks < 0) return;
  Params p{};
  for (int i = 0; i < 31; ++i) p.in[i] = (const float*)d_in[i];
  p.out = (float*)d_out;
  p.ws = (unsigned char*)d_ws;
  if (hipMemsetAsync((char*)d_ws + WS_BAR, 0, XCD_BAR_WORDS * 4, stream) != hipSuccess) { fprintf(stderr, "memset failed\n"); return; }
#if ONE_LAUNCH
  int lo = 0, hi = NPHASE;
  void* args[] = {&p, &lo, &hi};
  hipError_t e = hipLaunchCooperativeKernel((const void*)fwd_kernel, dim3(grid_blocks), dim3(256), args, LDS_BYTES, stream);
  if (e != hipSuccess) fprintf(stderr, "cooperative launch failed: %s (grid %d)\n", hipGetErrorString(e), grid_blocks);
#else
  for (int ph = 0; ph < NPHASE; ++ph) {
    hipLaunchKernelGGL(fwd_kernel, dim3(grid_blocks), dim3(256), LDS_BYTES, stream, p, ph, ph + 1);
  }
#endif
}
```

```cpp
#include <hip/hip_runtime.h>
#include <hip/hip_cooperative_groups.h>
#include <stdint.h>
#include <stdio.h>
namespace cg = cooperative_groups;

#ifndef ONE_LAUNCH
#define ONE_LAUNCH 1
#endif
#ifndef PHASE_ONLY
#define PHASE_ONLY -1
#endif
#define PH_ON(n) (PHASE_ONLY < 0 || PHASE_ONLY == (n))
#ifndef DUP_MASK
#define DUP_MASK 0
#endif
#define DUP(n) ((DUP_MASK >> (n)) & 1)

#define LAS __attribute__((address_space(3)))
typedef unsigned short u16;
typedef __attribute__((ext_vector_type(8))) short bf16x8;
typedef __attribute__((ext_vector_type(4))) float f32x4;

constexpr int D = 1024;
constexpr int TP = 2064;
constexpr int MP = 8 * TP;
constexpr int MS = 512;
constexpr int M = MP + MS;
constexpr int NPJ = 4376;
constexpr int LDT = 72;
constexpr float ALPHA = 1.4142135623730951f;
constexpr int NPHASE = 17;
constexpr int SPLIT_ROW0 = 128 * 128;

constexpr int LDA = 1088;
constexpr int LDY = 576;
constexpr int LDH = 4160;
constexpr size_t WS_WIN = 0;
constexpr size_t WS_WGATE = 9748480;
constexpr size_t WS_WOUT = 16433152;
constexpr size_t WS_WO = 19972096;
constexpr size_t WS_WFF1 = 22200320;
constexpr size_t WS_WFF2 = 31113216;
constexpr size_t WS_ACT = 39632896;
constexpr size_t WS_SSQ = 76677120;
constexpr size_t WS_A = 77221888;
constexpr size_t WS_B = 226215936;
constexpr size_t WS_BAR = 295946240;
constexpr size_t WS_W2 = WS_BAR + 16384;
constexpr size_t WS_G1X = WS_W2 + 22200320;
constexpr size_t WS_END = WS_G1X + 524288;
constexpr int G1_SPLIT = 16768;
constexpr size_t A_PRE = 37044224;

constexpr size_t O_YP = 0, O_YS = 16777216, O_SGP = 17301504, O_SGS = 17825792, O_SSP = 26214400, O_SSS = 26738688,
                 O_SCP = 35127296, O_SCS = 35164160, O_SRP = 35753984, O_SRS = 36278272;

constexpr int LDS_BYTES = 76032;

struct Params { const float* in[31]; float* out; unsigned char* ws; };

__device__ __forceinline__ unsigned f2bf(float f) {
  unsigned u = __float_as_uint(f);
  u += 0x7fffu + ((u >> 16) & 1u);
  return u >> 16;
}
__device__ __forceinline__ float bf2f(u16 h) { return __uint_as_float(((unsigned)h) << 16); }
__device__ __forceinline__ unsigned pack2(float a, float b) { return f2bf(a) | (f2bf(b) << 16); }
__device__ __forceinline__ void unpack8(uint4 v, float (&f)[8]) {
  f[0] = __uint_as_float(v.x << 16); f[1] = __uint_as_float(v.x & 0xffff0000u);
  f[2] = __uint_as_float(v.y << 16); f[3] = __uint_as_float(v.y & 0xffff0000u);
  f[4] = __uint_as_float(v.z << 16); f[5] = __uint_as_float(v.z & 0xffff0000u);
  f[6] = __uint_as_float(v.w << 16); f[7] = __uint_as_float(v.w & 0xffff0000u);
}
__device__ __forceinline__ uint4 pack8(const float (&f)[8]) {
  return make_uint4(pack2(f[0], f[1]), pack2(f[2], f[3]), pack2(f[4], f[5]), pack2(f[6], f[7]));
}
__device__ __forceinline__ int tsw(int row, int col) { return row * LDT + (col ^ (((row >> 3) & 7) << 3)); }
__device__ __forceinline__ int otid() { int t = threadIdx.x; asm volatile("" : "+v"(t)); return t; }
__device__ __forceinline__ float silu_f(float x) { return x / (1.f + __expf(-x)); }
__device__ __forceinline__ float silu_rcp(float x) { return x * __builtin_amdgcn_rcpf(1.f + __expf(-x)); }
__device__ __forceinline__ float sigmoid_f(float x) { return __builtin_amdgcn_rcpf(1.f + __expf(-x)); }
__device__ __forceinline__ float softplus_f(float x) {
  const float e = __expf(-fabsf(x));
  const float l1p = e < 1e-3f ? e * (1.f - 0.5f * e) : __logf(1.f + e);
  return fmaxf(x, 0.f) + l1p;
}

__device__ __forceinline__ void conv_tile64(const float* __restrict__ src, int ld, int ldk, int ncol0, int nvalid, u16* __restrict__ dst,
                            int kt, int nt, const float* __restrict__ kscale, float* tile, int blocked_nkt = 0) {
  const int tid = otid();
  const int c = tid & 63, r4 = tid >> 6;
  const int n = nt * 64 + c;
  const bool ok = n < nvalid;
#pragma unroll
  for (int i = 0; i < 16; ++i) {
    int k = r4 + 4 * i;
    int kg = kt * 64 + k;
    float v = ok ? src[(size_t)kg * ld + ncol0 + n] : 0.f;
    if (kscale) v *= kscale[kg];
    tile[k * 65 + c] = v;
  }
  __syncthreads();
#pragma unroll
  for (int it = 0; it < 2; ++it) {
    int id = tid + 256 * it;
    int nn = id >> 3, kc = id & 7;
    unsigned w0 = pack2(tile[(kc * 8 + 0) * 65 + nn], tile[(kc * 8 + 1) * 65 + nn]);
    unsigned w1 = pack2(tile[(kc * 8 + 2) * 65 + nn], tile[(kc * 8 + 3) * 65 + nn]);
    unsigned w2 = pack2(tile[(kc * 8 + 4) * 65 + nn], tile[(kc * 8 + 5) * 65 + nn]);
    unsigned w3 = pack2(tile[(kc * 8 + 6) * 65 + nn], tile[(kc * 8 + 7) * 65 + nn]);
    const int n_ = nt * 64 + nn;
    const size_t di = blocked_nkt ? ((size_t)((n_ >> 7) * blocked_nkt + kt) * 8192 + (n_ & 127) * 64 + kc * 8)
                                  : ((size_t)n_ * ldk + kt * 64 + kc * 8);
    *(uint4*)(dst + di) = make_uint4(w0, w1, w2, w3);
  }
  __syncthreads();
}

__device__ __forceinline__ void convert_layer(const Params& P, int l, unsigned char* lds, int t_lo, int t_hi, int wb, int nwb) {
  float* tile = (float*)lds;
  unsigned char* ws = P.ws;
  const size_t wsel = (l == 0) ? 0 : WS_W2;
  for (int t = t_lo + wb; t < t_hi; t += nwb) {
    int idx = t;
    if (idx < 1120) {
      conv_tile64(P.in[9] + (size_t)l * 1024 * 7448, 7448, LDA, 0, NPJ, (u16*)(ws + wsel + WS_WIN), idx % 16, idx / 16, nullptr, tile);
      continue;
    }
    idx -= 1120;
    if (idx < 768) {
      conv_tile64(P.in[9] + (size_t)l * 1024 * 7448, 7448, LDA, NPJ, 3072, (u16*)(ws + wsel + WS_WGATE), idx % 16, idx / 16, nullptr, tile);
      continue;
    }
    idx -= 768;
    if (idx < 384) {
      int br = idx / 128, r = idx % 128;
      conv_tile64(P.in[19 + br] + (size_t)l * 512 * 1024, 1024, LDY, 0, 1024, (u16*)(ws + wsel + WS_WOUT) + (size_t)br * 1024 * LDY,
                  r % 8, r / 8, br == 1 ? P.in[18] + l * 512 : nullptr, tile);
      continue;
    }
    idx -= 384;
    if (idx < 256) {
      conv_tile64(P.in[22] + (size_t)l * 1024 * 1024, 1024, LDA, 0, 1024, (u16*)(ws + wsel + WS_WO), idx % 16, idx / 16, nullptr, tile);
      continue;
    }
    idx -= 256;
    if (idx < 1024) {
      conv_tile64(P.in[25] + (size_t)l * 1024 * 4096, 4096, LDA, 0, 4096, (u16*)(ws + WS_WFF1), idx % 16, idx / 16, nullptr, tile);
      continue;
    }
    idx -= 1024;
    conv_tile64(P.in[27] + (size_t)l * 4096 * 1024, 1024, LDH, 0, 1024, (u16*)(ws + WS_WFF2), idx % 64, idx / 64, nullptr, tile, 64);
  }
}

__device__ __forceinline__ void ln_phase(const Params& P, int mode, int l) {
  const int tid_ = otid();
  const int lane = tid_ & 63;
  const int gw = blockIdx.x * 4 + (tid_ >> 6);
  const int nw = gridDim.x * 4;
  const float* wv = mode == 0 ? P.in[7] : (mode == 1 ? P.in[23] + l * D : P.in[29] + l * D);
  const float* bv = mode == 0 ? P.in[8] : (mode == 1 ? P.in[24] + l * D : P.in[30] + l * D);
  u16* act = (u16*)(P.ws + WS_ACT);
  const bool final_out = (mode == 2 && l == 1);
  for (int row = gw; row < M; row += nw) {
    const float* s;
    int b = 0, t = 0;
    if (row < MP) { b = row / TP; t = row - b * TP; }
    if (mode == 0) {
      if (row < MP) s = (t < 16) ? P.in[6] + (size_t)t * D : P.in[0] + ((size_t)b * 2048 + (t - 16)) * D;
      else s = P.in[1] + (size_t)(row - MP) * D;
    } else if (mode == 1) {
      s = (const float*)(P.ws + WS_A + A_PRE) + (size_t)row * D;
    } else {
      s = (const float*)(P.ws + WS_B) + (size_t)row * D;
    }
    float4 v[4];
#pragma unroll
    for (int i = 0; i < 4; ++i) v[i] = *(const float4*)(s + i * 256 + lane * 4);
    float sum = 0.f;
#pragma unroll
    for (int i = 0; i < 4; ++i) sum += v[i].x + v[i].y + v[i].z + v[i].w;
#pragma unroll
    for (int o = 32; o >= 1; o >>= 1) sum += __shfl_xor(sum, o);
    const float mean = sum * (1.f / 1024.f);
    float sq = 0.f;
#pragma unroll
    for (int i = 0; i < 4; ++i) {
      v[i].x -= mean; v[i].y -= mean; v[i].z -= mean; v[i].w -= mean;
      sq += v[i].x * v[i].x + v[i].y * v[i].y + v[i].z * v[i].z + v[i].w * v[i].w;
    }
#pragma unroll
    for (int o = 32; o >= 1; o >>= 1) sq += __shfl_xor(sq, o);
    const float rstd = rsqrtf(sq * (1.f / 1024.f) + 1e-5f);
    float* od = nullptr;
    if (final_out) {
      if (row < MP) { if (t >= 16) od = P.out + O_YP + ((size_t)b * 2048 + (t - 16)) * D; }
      else od = P.out + O_YS + (size_t)(row - MP) * D;
    }
#pragma unroll
    for (int i = 0; i < 4; ++i) {
      const int c = i * 256 + lane * 4;
      float4 w4 = *(const float4*)(wv + c), b4 = *(const float4*)(bv + c);
      float y0 = v[i].x * rstd * w4.x + b4.x, y1 = v[i].y * rstd * w4.y + b4.y;
      float y2 = v[i].z * rstd * w4.z + b4.z, y3 = v[i].w * rstd * w4.w + b4.w;
      if (final_out) {
        if (od) *(float4*)(od + c) = make_float4(y0, y1, y2, y3);
      } else {
        const unsigned p0 = pack2(y0, y1), p1 = pack2(y2, y3);
        *(uint2*)(act + (size_t)row * LDA + c) = make_uint2(p0, p1);
        if (mode == 1 && row >= SPLIT_ROW0) {
          const float4 bb = *(const float4*)(P.in[28] + l * D + c);
          float* pz = (float*)(P.ws + WS_B) + (size_t)row * D + c;
          *(float4*)pz = make_float4(ALPHA * __uint_as_float(p0 << 16) + bb.x, ALPHA * __uint_as_float(p0 & 0xffff0000u) + bb.y,
                                     ALPHA * __uint_as_float(p1 << 16) + bb.z, ALPHA * __uint_as_float(p1 & 0xffff0000u) + bb.w);
        }
      }
    }
  }
}

#define G_LOAD4(R, k0)                                                                    \
  R##a0 = *(const uint4*)(ap + (k0)); R##a1 = *(const uint4*)(ap + sa + (k0));            \
  R##a2 = *(const uint4*)(ap + 2 * sa + (k0)); R##a3 = *(const uint4*)(ap + 3 * sa + (k0)); \
  R##b0 = *(const uint4*)(bp + (k0)); R##b1 = *(const uint4*)(bp + sb + (k0));
#define G_LOADB(R, k0)                                                                    \
  R##b2 = *(const uint4*)(bp + 2 * sb + (k0)); R##b3 = *(const uint4*)(bp + 3 * sb + (k0));
#define L_STORE4(R, buf)                                                                  \
  { u16* ad = As + (buf) * 128 * LDT + crow * LDT + cck;                                  \
    u16* bd = Bs + (buf) * BN * LDT + crow * LDT + cck;                                   \
    *(uint4*)(ad) = R##a0; *(uint4*)(ad + 32 * LDT) = R##a1; *(uint4*)(ad + 64 * LDT) = R##a2; *(uint4*)(ad + 96 * LDT) = R##a3; \
    *(uint4*)(bd) = R##b0; *(uint4*)(bd + 32 * LDT) = R##b1;                              \
    if (NF == 4) { *(uint4*)(bd + 64 * LDT) = R##b2; *(uint4*)(bd + 96 * LDT) = R##b3; } }
#define MMA_TILE(buf)                                                                     \
  { const u16* as = As + (buf) * 128 * LDT + (wm * 64 + r) * LDT + q * 8;                 \
    const u16* bs = Bs + (buf) * BN * LDT + (wn * NF * 16 + r) * LDT + q * 8;             \
    _Pragma("unroll") for (int kk = 0; kk < 2; ++kk) {                                    \
      bf16x8 af[4], bfr[NF];                                                              \
      _Pragma("unroll") for (int mf = 0; mf < 4; ++mf) af[mf] = *(const bf16x8*)(as + mf * 16 * LDT + kk * 32); \
      _Pragma("unroll") for (int nf = 0; nf < NF; ++nf) bfr[nf] = *(const bf16x8*)(bs + nf * 16 * LDT + kk * 32); \
      _Pragma("unroll") for (int mf = 0; mf < 4; ++mf)                                    \
        _Pragma("unroll") for (int nf = 0; nf < NF; ++nf)                                 \
          acc[mf][nf] = __builtin_amdgcn_mfma_f32_16x16x32_bf16(af[mf], bfr[nf], acc[mf][nf], 0, 0, 0); \
    } }

__device__ __forceinline__ int lds_byte(int r, int c) {
  int st = (r >> 4) * 2 + (c >> 5), rr = r & 15, cc = c & 31, ob = rr * 64 + cc * 2;
  return st * 1024 + (ob ^ (((ob >> 9) & 1) << 5));
}
__device__ __forceinline__ void stage_rc(int b, int& R, int& C) {
  int st = b >> 10, sb = b & 1023, swz = sb ^ (((sb >> 9) & 1) << 5);
  R = (st >> 1) * 16 + (swz >> 6);
  C = (st & 1) * 32 + ((swz & 63) >> 1);
}

template <int NF>
__device__ __forceinline__ void gemm_core(f32x4 (&acc)[4][NF], const u16* __restrict__ A, int lda,
                                          const u16* __restrict__ B, int ldb, int K, u16* lds, int kadv = 64) {
  constexpr int BN = 32 * NF;
  constexpr int ABYTES = 128 * 64 * 2;
  constexpr int BBYTES = BN * 64 * 2;
  constexpr int BUF = ABYTES + BBYTES;
  unsigned char* base = (unsigned char*)lds;
  const int tid = otid(), lane = tid & 63, w = tid >> 6, wm = w >> 1, wn = w & 1, r = lane & 15, q = lane >> 4;
  const u16* ga[4]; const u16* gb[NF];
#pragma unroll
  for (int i = 0; i < 4; ++i) { int R, C; stage_rc(tid * 16 + i * 4096, R, C); ga[i] = A + (size_t)R * lda + C; }
#pragma unroll
  for (int i = 0; i < NF; ++i) { int R, C; stage_rc(tid * 16 + i * 4096, R, C); gb[i] = B + (size_t)R * ldb + C; }
  int oa[4][2], ob[NF][2];
#pragma unroll
  for (int mf = 0; mf < 4; ++mf)
#pragma unroll
    for (int kk = 0; kk < 2; ++kk) oa[mf][kk] = lds_byte(wm * 64 + mf * 16 + r, kk * 32 + q * 8);
#pragma unroll
  for (int nf = 0; nf < NF; ++nf)
#pragma unroll
    for (int kk = 0; kk < 2; ++kk) ob[nf][kk] = lds_byte(wn * NF * 16 + nf * 16 + r, kk * 32 + q * 8);
#define STAGE_TILE(buf, k0)                                                                              \
  {                                                                                                      \
    _Pragma("unroll") for (int i = 0; i < 4; ++i)                                                        \
      __builtin_amdgcn_global_load_lds((const unsigned*)(ga[i] + (k0)),                                  \
        (LAS unsigned*)(base + (buf) * BUF + tid * 16 + i * 4096), 16, 0, 0);                            \
    _Pragma("unroll") for (int i = 0; i < NF; ++i)                                                       \
      __builtin_amdgcn_global_load_lds((const unsigned*)(gb[i] + (k0)),                                  \
        (LAS unsigned*)(base + (buf) * BUF + ABYTES + tid * 16 + i * 4096), 16, 0, 0);                   \
  }
  const int nk = K >> 6;
  STAGE_TILE(0, 0)
  asm volatile("s_waitcnt vmcnt(0)" ::: "memory");
  __syncthreads();
  for (int kt = 0; kt < nk; ++kt) {
    const int buf = kt & 1;
    if (kt + 1 < nk) STAGE_TILE(buf ^ 1, (size_t)(kt + 1) * kadv)
    const unsigned char* as = base + buf * BUF;
    const unsigned char* bs = as + ABYTES;
    bf16x8 af0[4], bf0[NF], af1[4], bf1[NF];
#pragma unroll
    for (int mf = 0; mf < 4; ++mf) af0[mf] = *(const bf16x8*)(as + oa[mf][0]);
#pragma unroll
    for (int nf = 0; nf < NF; ++nf) bf0[nf] = *(const bf16x8*)(bs + ob[nf][0]);
    __builtin_amdgcn_s_setprio(1);
#pragma unroll
    for (int nf = 0; nf < NF / 2; ++nf)
#pragma unroll
      for (int mf = 0; mf < 4; ++mf)
        acc[mf][nf] = __builtin_amdgcn_mfma_f32_16x16x32_bf16(af0[mf], bf0[nf], acc[mf][nf], 0, 0, 0);
    __builtin_amdgcn_s_setprio(0);
#pragma unroll
    for (int mf = 0; mf < 4; ++mf) af1[mf] = *(const bf16x8*)(as + oa[mf][1]);
#pragma unroll
    for (int nf = 0; nf < NF; ++nf) bf1[nf] = *(const bf16x8*)(bs + ob[nf][1]);
    __builtin_amdgcn_s_setprio(1);
#pragma unroll
    for (int nf = NF / 2; nf < NF; ++nf)
#pragma unroll
      for (int mf = 0; mf < 4; ++mf)
        acc[mf][nf] = __builtin_amdgcn_mfma_f32_16x16x32_bf16(af0[mf], bf0[nf], acc[mf][nf], 0, 0, 0);
#pragma unroll
    for (int nf = 0; nf < NF; ++nf)
#pragma unroll
      for (int mf = 0; mf < 4; ++mf)
        acc[mf][nf] = __builtin_amdgcn_mfma_f32_16x16x32_bf16(af1[mf], bf1[nf], acc[mf][nf], 0, 0, 0);
    __builtin_amdgcn_s_setprio(0);
    asm volatile("s_waitcnt vmcnt(0)" ::: "memory");
    __syncthreads();
  }
#undef STAGE_TILE
}

#define TILE_LOOP(total)                                                                      \
  const int _nx = (gridDim.x % 8 == 0) ? 8 : 1;                                              \
  const int _ns = gridDim.x / _nx;                                                           \
  const int _x = blockIdx.x % _nx, _s = blockIdx.x / _nx;                                    \
  const int _per = ((total) + _nx - 1) / _nx;                                                \
  const int _lo = _x * _per;                                                                 \
  const int _hi = min((total), _lo + _per);                                                  \
  for (int t = _lo + _s; t < _hi; t += _ns)

__device__ __forceinline__ void tile_decode(int t, int MT, int NT, int& mt, int& nt) {
  int g = t / (8 * NT), r = t - g * 8 * NT;
  int gs = min(8, MT - g * 8);
  mt = g * 8 + r % gs;
  nt = r / gs;
}

template <int NF>
__device__ __forceinline__ void zero_acc(f32x4 (&acc)[4][NF]) {
#pragma unroll
  for (int i = 0; i < 4; ++i)
#pragma unroll
    for (int j = 0; j < NF; ++j) acc[i][j] = (f32x4){0.f, 0.f, 0.f, 0.f};
}

__device__ __forceinline__ void phase_proj(const Params& P, int l, unsigned char* ldsb) {
  const u16* act = (const u16*)(P.ws + WS_ACT);
  const u16* W = (const u16*)(P.ws + (l == 0 ? 0 : WS_W2) + WS_WIN);
  u16* proj = (u16*)(P.ws + WS_A);
  constexpr int MT = 133, NT = 35;
  TILE_LOOP(MT * NT) {
    int mt, nt; tile_decode(t, MT, NT, mt, nt);
    const int tid_ = otid(), lane = tid_ & 63, w = tid_ >> 6, wm = w >> 1, wn = w & 1, r = lane & 15, q = lane >> 4;
    f32x4 acc[4][4]; zero_acc<4>(acc);
    gemm_core<4>(acc, act + (size_t)mt * 128 * LDA, LDA, W + (size_t)nt * 128 * LDA, LDA, D, (u16*)ldsb);
#pragma unroll
    for (int mf = 0; mf < 4; ++mf)
#pragma unroll
      for (int nf = 0; nf < 4; ++nf) {
        const int col = nt * 128 + wn * 64 + nf * 16 + r;
        if (col < NPJ) {
#pragma unroll
          for (int e = 0; e < 4; ++e) {
            const int row = mt * 128 + wm * 64 + mf * 16 + q * 4 + e;
            proj[(size_t)row * NPJ + col] = (u16)f2bf(acc[mf][nf][e]);
          }
        }
      }
  }
}

__device__ __forceinline__ u16* gate_row(const Params& P, int br, int row) {
  if (br == 0) return (u16*)P.out + (size_t)row * D;
  if (row < G1_SPLIT) return (u16*)P.out + (size_t)M * D + (size_t)row * D;
  return (u16*)(P.ws + WS_G1X) + (size_t)(row - G1_SPLIT) * D;
}

__device__ __forceinline__ void phase_gates(const Params& P, int l, int wb, int nwb, unsigned char* ldsb) {
  const u16* act = (const u16*)(P.ws + WS_ACT);
  const u16* Wg = (const u16*)(P.ws + (l == 0 ? 0 : WS_W2) + WS_WGATE);
  constexpr int MT = 133, NT = 8;
  for (int t = wb; t < 2 * MT * NT; t += nwb) {
    const int br = t / (MT * NT);
    int mt, nt; tile_decode(t - br * MT * NT, MT, NT, mt, nt);
    const int tid_ = otid(), lane = tid_ & 63, w = tid_ >> 6, wm = w >> 1, wn = w & 1, r = lane & 15, q = lane >> 4;
    f32x4 acc[4][4]; zero_acc<4>(acc);
    gemm_core<4>(acc, act + (size_t)mt * 128 * LDA, LDA, Wg + ((size_t)br * 1024 + nt * 128) * LDA, LDA, D, (u16*)ldsb);
#pragma unroll
    for (int mf = 0; mf < 4; ++mf)
#pragma unroll
      for (int e = 0; e < 4; ++e) {
        const int row = mt * 128 + wm * 64 + mf * 16 + q * 4 + e;
        u16* gr = gate_row(P, br, row);
#pragma unroll
        for (int nf = 0; nf < 4; ++nf) gr[nt * 128 + wn * 64 + nf * 16 + r] = (u16)f2bf(sigmoid_f(acc[mf][nf][e]));
      }
  }
}

__device__ __forceinline__ void phase_merge(const Params& P, int l, unsigned char* ldsb) {
  const u16* act = (const u16*)(P.ws + WS_ACT);
  const u16* Wg = (const u16*)(P.ws + (l == 0 ? 0 : WS_W2) + WS_WGATE);
  const u16* Wo = (const u16*)(P.ws + (l == 0 ? 0 : WS_W2) + WS_WOUT);
  const u16* ybr = (const u16*)(P.ws + WS_B);
  const float* ssq = (const float*)(P.ws + WS_SSQ);
  u16* merged = (u16*)(P.ws + WS_A);
  constexpr int MT = 133, NT = 16;
  {
    float* pre = (float*)(P.ws + WS_A + A_PRE);
    for (int i = blockIdx.x * 256 + otid(); i < (M - SPLIT_ROW0) * (D / 4); i += gridDim.x * 256) {
      const int row = SPLIT_ROW0 + i / (D / 4), c = (i % (D / 4)) * 4;
      const uint2 xv = *(const uint2*)(act + (size_t)row * LDA + c);
      *(float4*)(pre + (size_t)row * D + c) = make_float4(ALPHA * __uint_as_float(xv.x << 16), ALPHA * __uint_as_float(xv.x & 0xffff0000u),
                                                          ALPHA * __uint_as_float(xv.y << 16), ALPHA * __uint_as_float(xv.y & 0xffff0000u));
    }
  }
  TILE_LOOP(MT * NT) {
    int mt, nt; tile_decode(t, MT, NT, mt, nt);
    const int tid_ = otid(), lane = tid_ & 63, w = tid_ >> 6, wm = w >> 1, wn = w & 1, r = lane & 15, q = lane >> 4;
    f32x4 fin[4][2]; zero_acc<2>(fin);
#pragma unroll 1
    for (int br = 0; br < 3; ++br) {
      f32x4 g[4][2]; zero_acc<2>(g);
      if (br == 2) {
        gemm_core<2>(g, act + (size_t)mt * 128 * LDA, LDA, Wg + ((size_t)br * 1024 + nt * 64) * LDA, LDA, D, (u16*)ldsb);
#pragma unroll
        for (int mf = 0; mf < 4; ++mf)
#pragma unroll
          for (int nf = 0; nf < 2; ++nf)
#pragma unroll
            for (int e = 0; e < 4; ++e) g[mf][nf][e] = sigmoid_f(g[mf][nf][e]);
      } else {
#pragma unroll
        for (int mf = 0; mf < 4; ++mf)
#pragma unroll
          for (int e = 0; e < 4; ++e) {
            const u16* gr = gate_row(P, br, mt * 128 + wm * 64 + mf * 16 + q * 4 + e) + nt * 64 + wn * 32 + r;
#pragma unroll
            for (int nf = 0; nf < 2; ++nf) g[mf][nf][e] = bf2f(gr[nf * 16]);
          }
      }
      const u16* yb = ybr + (size_t)br * M * LDY + (size_t)mt * 128 * LDY;
      const u16* wb = Wo + (size_t)br * 1024 * LDY + (size_t)nt * 64 * LDY;
      if (br != 1) {
        f32x4 acc[4][2]; zero_acc<2>(acc);
        gemm_core<2>(acc, yb, LDY, wb, LDY, 512, (u16*)ldsb);
#pragma unroll
        for (int mf = 0; mf < 4; ++mf)
#pragma unroll
          for (int nf = 0; nf < 2; ++nf)
#pragma unroll
            for (int e = 0; e < 4; ++e) fin[mf][nf][e] += g[mf][nf][e] * acc[mf][nf][e];
      } else {
#pragma unroll 1
        for (int grp = 0; grp < 2; ++grp) {
          f32x4 acc[4][2]; zero_acc<2>(acc);
          gemm_core<2>(acc, yb + grp * 256, LDY, wb + grp * 256, LDY, 256, (u16*)ldsb);
#pragma unroll
          for (int mf = 0; mf < 4; ++mf)
#pragma unroll
            for (int e = 0; e < 4; ++e) {
              const int row = mt * 128 + wm * 64 + mf * 16 + q * 4 + e;
              float4 s4 = *(const float4*)(ssq + (size_t)row * 8 + grp * 4);
              float rs = rsqrtf((s4.x + s4.y + s4.z + s4.w) * (1.f / 256.f) + 1e-6f);
#pragma unroll
              for (int nf = 0; nf < 2; ++nf) fin[mf][nf][e] += g[mf][nf][e] * rs * acc[mf][nf][e];
            }
        }
      }
    }
#pragma unroll
    for (int mf = 0; mf < 4; ++mf)
#pragma unroll
      for (int nf = 0; nf < 2; ++nf)
#pragma unroll
        for (int e = 0; e < 4; ++e) {
          const int row = mt * 128 + wm * 64 + mf * 16 + q * 4 + e;
          const int col = nt * 64 + wn * 32 + nf * 16 + r;
          merged[(size_t)row * LDA + col] = (u16)f2bf(fin[mf][nf][e]);
        }
  }
}

__device__ __forceinline__ void phase_resid(const Params& P, int mode, int l, unsigned char* ldsb) {
  const u16* act = (const u16*)(P.ws + WS_ACT);
  const u16* A = (const u16*)(P.ws + WS_A);
  const int K = mode == 0 ? 1024 : 4096;
  const int ldk = mode == 0 ? LDA : LDH;
  const u16* W = (const u16*)(P.ws + (mode == 0 ? (l == 0 ? 0 : WS_W2) + WS_WO : WS_WFF2));
  float* dst = mode == 0 ? (float*)(P.ws + WS_A + A_PRE) : (float*)(P.ws + WS_B);
  const float* bias = P.in[28] + l * D;
  constexpr int MT = 128, NT = 8;
  TILE_LOOP(MT * NT) {
    int mt, nt; tile_decode(t, MT, NT, mt, nt);
    const int tid_ = otid(), lane = tid_ & 63, w = tid_ >> 6, wm = w >> 1, wn = w & 1, r = lane & 15, q = lane >> 4;
    f32x4 acc[4][4]; zero_acc<4>(acc);
    if (mode == 0) gemm_core<4>(acc, A + (size_t)mt * 128 * ldk, ldk, W + (size_t)nt * 128 * ldk, ldk, K, (u16*)ldsb);
    else gemm_core<4>(acc, A + (size_t)mt * 64 * 8192, 64, W + (size_t)nt * 64 * 8192, 64, K, (u16*)ldsb, 8192);
#pragma unroll
    for (int mf = 0; mf < 4; ++mf)
#pragma unroll
      for (int nf = 0; nf < 4; ++nf) {
        const int col = nt * 128 + wn * 64 + nf * 16 + r;
        const float bb = mode == 1 ? bias[col] : 0.f;
#pragma unroll
        for (int e = 0; e < 4; ++e) {
          const int row = mt * 128 + wm * 64 + mf * 16 + q * 4 + e;
          dst[(size_t)row * D + col] = ALPHA * bf2f(act[(size_t)row * LDA + col]) + acc[mf][nf][e] + bb;
        }
      }
  }
  {
    constexpr int S = 8;
    const int KS = K / S;
    for (int li = blockIdx.x; li < 40 * S; li += gridDim.x) {
      const int sl = li % S, tl = li / S;
      const int mt = 128 + tl / 8, nt = tl % 8;
      const int tid_ = otid(), lane = tid_ & 63, w = tid_ >> 6, wm = w >> 1, wn = w & 1, r = lane & 15, q = lane >> 4;
      f32x4 acc[4][4]; zero_acc<4>(acc);
      if (mode == 0) gemm_core<4>(acc, A + (size_t)mt * 128 * ldk + sl * KS, ldk, W + (size_t)nt * 128 * ldk + sl * KS, ldk, KS, (u16*)ldsb);
      else gemm_core<4>(acc, A + ((size_t)mt * 64 + sl * (KS / 64)) * 8192, 64, W + ((size_t)nt * 64 + sl * (KS / 64)) * 8192, 64, KS, (u16*)ldsb, 8192);
#pragma unroll
      for (int mf = 0; mf < 4; ++mf)
#pragma unroll
        for (int nf = 0; nf < 4; ++nf) {
          const int col = nt * 128 + wn * 64 + nf * 16 + r;
#pragma unroll
          for (int e = 0; e < 4; ++e) {
            const int row = mt * 128 + wm * 64 + mf * 16 + q * 4 + e;
            (void)__hip_atomic_fetch_add(dst + (size_t)row * D + col, acc[mf][nf][e], __ATOMIC_RELAXED, __HIP_MEMORY_SCOPE_AGENT);
          }
        }
    }
  }
}

__device__ __forceinline__ void phase_ff1(const Params& P, int l, unsigned char* ldsb) {
  const u16* act = (const u16*)(P.ws + WS_ACT);
  const u16* W = (const u16*)(P.ws + WS_WFF1);
  u16* hid = (u16*)(P.ws + WS_A);
  const float* bias = P.in[26] + l * 4096;
  constexpr int MT = 133, NT = 32;
  TILE_LOOP(MT * NT) {
    int mt, nt; tile_decode(t, MT, NT, mt, nt);
    const int tid_ = otid(), lane = tid_ & 63, w = tid_ >> 6, wm = w >> 1, wn = w & 1, r = lane & 15, q = lane >> 4;
    f32x4 acc[4][4]; zero_acc<4>(acc);
    gemm_core<4>(acc, act + (size_t)mt * 128 * LDA, LDA, W + (size_t)nt * 128 * LDA, LDA, D, (u16*)ldsb);
#pragma unroll
    for (int mf = 0; mf < 4; ++mf)
#pragma unroll
      for (int nf = 0; nf < 4; ++nf) {
        const int col = nt * 128 + wn * 64 + nf * 16 + r;
        const float bb = bias[col];
#pragma unroll
        for (int e = 0; e < 4; ++e) {
          const int row = mt * 128 + wm * 64 + mf * 16 + q * 4 + e;
          float v = fmaxf(acc[mf][nf][e] + bb, 0.f);
          hid[((size_t)(row >> 7) * 64 + (col >> 6)) * 8192 + (row & 127) * 64 + (col & 63)] = (u16)f2bf(v * v);
        }
      }
  }
}

template <int BR>
__device__ __forceinline__ void rec_item(const Params& P, int l, int b, int h, int sample, unsigned char* ldsb) {
  constexpr int DV = (BR == 1) ? 64 : 128;
  constexpr int NFV = DV / 16;
  constexpr int NH = (BR == 1) ? 8 : 4;
  constexpr int OLD = DV + 4;
  constexpr int NEP = DV / 32;
  u16* QA = (u16*)ldsb;
  u16* KB = QA + 64 * LDT;
  u16* KT = KB + 64 * LDT;
  u16* ATT = KT + 64 * LDT;
  u16* VT = ATT + 64 * LDT;
  u16* ST = VT + 128 * LDT;
  float* Gsc = (float*)(ST + 128 * LDT);
  float* dec = Gsc + 64;
  float* dtv = dec + 64;
  float* psum = dtv + 64;
  float* invf = psum + 256;
  float* Gl = (float*)ST;
  float* AL = (float*)ATT;
  float* OST = (float*)ldsb;
  u16* XH = VT + 64 * LDT;

  const int tid = otid(), lane = tid & 63, w = tid >> 6, r = lane & 15, q = lane >> 4;
  const int T = sample ? 4 : TP;
  const int row0 = sample ? MP + b * 4 : b * TP;
  const int pos0 = sample ? 16384 : 0;
  const u16* proj = (const u16*)(P.ws + WS_A);
  u16* ybr = (u16*)(P.ws + WS_B) + (size_t)BR * M * LDY;
  float* ssq = (float*)(P.ws + WS_SSQ);

  float lg = 0.f, aneg = 0.f, dtb = 0.f, dsk = 0.f;
  if (BR == 2) {
    lg = log1pf(-exp2f(-5.f - (float)h));
    if (tid < 32) invf[tid] = exp2f(-(float)tid * (13.287712379549449f / 32.0f));
  }
  if (BR == 1) {
    aneg = -__expf(P.in[16][l * 8 + h]);
    dtb = P.in[15][l * 8 + h];
    dsk = P.in[17][l * 8 + h];
  }
  const int grp = h >> 2;

  f32x4 S[NFV];
  {
    const float* sin_ = P.in[2];
    if (sample) {
      const float* base = BR == 0 ? P.in[2] : (BR == 1 ? P.in[3] : P.in[5]);
      sin_ = base + ((size_t)(l * 128 + b) * NH + h) * 64 * DV;
    }
#pragma unroll
    for (int nf = 0; nf < NFV; ++nf)
#pragma unroll
      for (int e = 0; e < 4; ++e) {
        float v = sin_[(size_t)(16 * w + q * 4 + e) * DV + nf * 16 + r];
        S[nf][e] = sample ? v : 0.f;
      }
  }
  __syncthreads();

  uint4 Rg[NEP], RgN[NEP];
  uint4 Rq[2], Rk[2], Rv[4], Ral;
  uint4 Rq1, Rq2, Rk1, Rk2;
  uint4 Rx[11];
  float dtraw = 0.f;
  const int ci = tid & 63, part = tid >> 6;
  float w2r[16];
  float bias = 0.f;
  if (BR == 0) {
#pragma unroll
    for (int rr = 0; rr < 16; ++rr) w2r[rr] = P.in[10][(size_t)(l * 16 + rr) * 256 + h * 64 + ci];
    bias = P.in[11][l * 256 + h * 64 + ci];
  }
  const int cc = tid >> 3, ts = tid & 7;
  const bool act = tid < 192;
  const int seg = cc >> 3, c8 = (cc & 7) * 8;
  const int chan = seg == 0 ? h * 64 + c8 : (seg == 1 ? 512 + grp * 64 + c8 : 640 + grp * 64 + c8);
  float cwv[4][8], cbv[8];
  if (BR == 1 && act) {
    const float* cw = P.in[13] + (size_t)l * 4 * 768 + chan;
    const float* cb = P.in[14] + (size_t)l * 768 + chan;
#pragma unroll
    for (int i = 0; i < 4; ++i) {
      *(float4*)&cwv[i][0] = *(const float4*)(cw + i * 768);
      *(float4*)&cwv[i][4] = *(const float4*)(cw + i * 768 + 4);
    }
    *(float4*)&cbv[0] = *(const float4*)cb;
    *(float4*)&cbv[4] = *(const float4*)(cb + 4);
  }
#define REC_LOAD(CB, RGD)                                                                                     \
  {                                                                                                           \
    const int goff_ = BR == 0 ? 1024 + h * 128 : (BR == 1 ? 1552 + h * 64 : 3864 + h * 128);                  \
    _Pragma("unroll") for (int it = 0; it < NEP; ++it) {                                                      \
      const int id = tid + 256 * it;                                                                          \
      const int t = (DV == 128) ? (id >> 4) : (id >> 3);                                                      \
      const int j0 = (DV == 128) ? (id & 15) * 8 : (id & 7) * 8;                                              \
      RGD[it] = *(const uint4*)(proj + (size_t)(row0 + min((CB) + t, T - 1)) * NPJ + goff_ + j0);             \
    }                                                                                                         \
    if (BR == 0) {                                                                                            \
      _Pragma("unroll") for (int it = 0; it < 2; ++it) {                                                      \
        const int id = tid + 256 * it;                                                                        \
        const int t = id >> 3, i0 = (id & 7) * 8;                                                             \
        const u16* rp = proj + (size_t)(row0 + min((CB) + t, T - 1)) * NPJ + h * 64 + i0;                     \
        Rq[it] = *(const uint4*)rp;                                                                           \
        Rk[it] = *(const uint4*)(rp + 256);                                                                   \
      }                                                                                                       \
      { const int t = (tid & 127) >> 1, hf = tid & 1;                                                         \
        Ral = *(const uint4*)(proj + (size_t)(row0 + min((CB) + t, T - 1)) * NPJ + 1536 + hf * 8); }          \
    }                                                                                                         \
    if (BR == 2) {                                                                                            \
      const int t = tid >> 2, i0 = (tid & 3) * 8;                                                             \
      const u16* rp = proj + (size_t)(row0 + min((CB) + t, T - 1)) * NPJ + 2840 + h * 64 + i0;                \
      Rq1 = *(const uint4*)rp; Rq2 = *(const uint4*)(rp + 32);                                                \
      Rk1 = *(const uint4*)(rp + 256); Rk2 = *(const uint4*)(rp + 288);                                       \
    }                                                                                                         \
    if (BR == 1) {                                                                                            \
      if (act) {                                                                                              \
        _Pragma("unroll") for (int k = 0; k < 11; ++k) {                                                      \
          int tau = (CB) + ts * 8 - 3 + k;                                                                    \
          tau = min(max(tau, 0), T - 1);                                                                      \
          Rx[k] = *(const uint4*)(proj + (size_t)(row0 + tau) * NPJ + 2064 + chan);                           \
        }                                                                                                     \
      }                                                                                                       \
      if (w == 0) dtraw = bf2f(proj[(size_t)(row0 + min((CB) + lane, T - 1)) * NPJ + 2832 + h]);              \
    }                                                                                                         \
  }
  REC_LOAD(0, Rg)

  for (int c0 = 0; c0 < T; c0 += 64) {
    const int nvalid = min(64, T - c0);
    if (BR == 0 || BR == 2) {
      const int voff_ = (BR == 0 ? 512 : 3352) + h * 128;
#pragma unroll
      for (int it = 0; it < 4; ++it) {
        const int id = tid + 256 * it;
        const int t = id >> 4, j0 = (id & 15) * 8;
        Rv[it] = *(const uint4*)(proj + (size_t)(row0 + min(c0 + t, T - 1)) * NPJ + voff_ + j0);
      }
    }
    if (BR == 0) {
      if (tid < 128) {
        const int t = tid >> 1, hf = tid & 1;
        float a8[8];
        unpack8(Ral, a8);
        *(float4*)(AL + t * 16 + hf * 8) = make_float4(a8[0], a8[1], a8[2], a8[3]);
        *(float4*)(AL + t * 16 + hf * 8 + 4) = make_float4(a8[4], a8[5], a8[6], a8[7]);
      }
      __syncthreads();
      {
        float run = 0.f;
#pragma unroll 4
        for (int tt = 0; tt < 16; ++tt) {
          const int t = part * 16 + tt;
          const float4 x0 = *(const float4*)(AL + t * 16), x1 = *(const float4*)(AL + t * 16 + 4);
          const float4 x2 = *(const float4*)(AL + t * 16 + 8), x3 = *(const float4*)(AL + t * 16 + 12);
          float a = bias;
          a += x0.x * w2r[0] + x0.y * w2r[1] + x0.z * w2r[2] + x0.w * w2r[3];
          a += x1.x * w2r[4] + x1.y * w2r[5] + x1.z * w2r[6] + x1.w * w2r[7];
          a += x2.x * w2r[8] + x2.y * w2r[9] + x2.z * w2r[10] + x2.w * w2r[11];
          a += x3.x * w2r[12] + x3.y * w2r[13] + x3.z * w2r[14] + x3.w * w2r[15];
          float g = (fminf(a, 0.f) - __logf(1.f + __expf(-fabsf(a)))) * (1.f / 16.f);
          if (t >= nvalid) g = 0.f;
          run += g;
          Gl[t * 64 + ci] = run;
        }
        psum[part * 64 + ci] = run;
      }
      __syncthreads();
      {
        float off = 0.f;
        for (int p = 0; p < part; ++p) off += psum[p * 64 + ci];
#pragma unroll 4
        for (int tt = 0; tt < 16; ++tt) Gl[(part * 16 + tt) * 64 + ci] += off;
      }
      __syncthreads();
#pragma unroll
      for (int it = 0; it < 2; ++it) {
        const int id = tid + 256 * it;
        const int t = id >> 3, i0 = (id & 7) * 8;
        const bool valid = t < nvalid;
        float qf[8], kf[8], G[8], Ge[8], qa[8], kb[8];
        unpack8(Rq[it], qf); unpack8(Rk[it], kf);
        *(float4*)&G[0] = *(const float4*)(Gl + t * 64 + i0);
        *(float4*)&G[4] = *(const float4*)(Gl + t * 64 + i0 + 4);
        *(float4*)&Ge[0] = *(const float4*)(Gl + 63 * 64 + i0);
        *(float4*)&Ge[4] = *(const float4*)(Gl + 63 * 64 + i0 + 4);
#pragma unroll
        for (int e = 0; e < 8; ++e) {
          const float qv = valid ? qf[e] : 0.f, kv = valid ? kf[e] : 0.f;
          qa[e] = qv * 0.125f * __expf(G[e]);
          kb[e] = kv * __expf(-G[e]);
          KT[tsw(i0 + e, t)] = (u16)f2bf(kv * __expf(Ge[e] - G[e]));
        }
        *(uint4*)(QA + t * LDT + i0) = pack8(qa);
        *(uint4*)(KB + t * LDT + i0) = pack8(kb);
        if (t == 63) {
#pragma unroll
          for (int e = 0; e < 8; ++e) dec[i0 + e] = __expf(Ge[e]);
        }
        __builtin_amdgcn_sched_barrier(0);
      }
#pragma unroll
      for (int it = 0; it < 4; ++it) {
        const int id = tid + 256 * it;
        const int t = id >> 4, j0 = (id & 15) * 8;
        uint4 v4 = Rv[it];
        if (t >= nvalid) v4 = make_uint4(0, 0, 0, 0);
        VT[tsw(j0 + 0, t)] = (u16)(v4.x & 0xffffu); VT[tsw(j0 + 1, t)] = (u16)(v4.x >> 16);
        VT[tsw(j0 + 2, t)] = (u16)(v4.y & 0xffffu); VT[tsw(j0 + 3, t)] = (u16)(v4.y >> 16);
        VT[tsw(j0 + 4, t)] = (u16)(v4.z & 0xffffu); VT[tsw(j0 + 5, t)] = (u16)(v4.z >> 16);
        VT[tsw(j0 + 6, t)] = (u16)(v4.w & 0xffffu); VT[tsw(j0 + 7, t)] = (u16)(v4.w >> 16);
      }
      if (tid < 64) Gsc[tid] = 0.f;
    }
    if (BR == 2) {
      {
        const int t = tid >> 2, i0 = (tid & 3) * 8;
        const bool valid = t < nvalid;
        float q1f[8], q2f[8], k1f[8], k2f[8], o1[8], o2[8], p1[8], p2[8];
        unpack8(Rq1, q1f); unpack8(Rq2, q2f); unpack8(Rk1, k1f); unpack8(Rk2, k2f);
        const float pos = (float)(pos0 + c0 + t);
        const float ed = __expf(lg * (float)(nvalid - min(t + 1, nvalid)));
#pragma unroll
        for (int e = 0; e < 8; ++e) {
          const float ang = pos * invf[i0 + e];
          double rev = (double)ang * 0.15915494309189535;
          rev -= floor(rev);
          const float rf = (float)rev;
          const float sn = __builtin_amdgcn_sinf(rf), cs = __builtin_amdgcn_cosf(rf);
          const float a1 = valid ? q1f[e] : 0.f, a2 = valid ? q2f[e] : 0.f;
          const float b1 = valid ? k1f[e] : 0.f, b2 = valid ? k2f[e] : 0.f;
          o1[e] = a1 * cs - a2 * sn;
          o2[e] = a1 * sn + a2 * cs;
          p1[e] = (b1 * cs - b2 * sn) * 0.125f;
          p2[e] = (b1 * sn + b2 * cs) * 0.125f;
          KT[tsw(i0 + e, t)] = (u16)f2bf(p1[e] * ed);
          KT[tsw(32 + i0 + e, t)] = (u16)f2bf(p2[e] * ed);
        }
        *(uint4*)(QA + t * LDT + i0) = pack8(o1);
        *(uint4*)(QA + t * LDT + 32 + i0) = pack8(o2);
        *(uint4*)(KB + t * LDT + i0) = pack8(p1);
        *(uint4*)(KB + t * LDT + 32 + i0) = pack8(p2);
      }
#pragma unroll
      for (int it = 0; it < 4; ++it) {
        const int id = tid + 256 * it;
        const int t = id >> 4, j0 = (id & 15) * 8;
        uint4 v4 = Rv[it];
        if (t >= nvalid) v4 = make_uint4(0, 0, 0, 0);
        VT[tsw(j0 + 0, t)] = (u16)(v4.x & 0xffffu); VT[tsw(j0 + 1, t)] = (u16)(v4.x >> 16);
        VT[tsw(j0 + 2, t)] = (u16)(v4.y & 0xffffu); VT[tsw(j0 + 3, t)] = (u16)(v4.y >> 16);
        VT[tsw(j0 + 4, t)] = (u16)(v4.z & 0xffffu); VT[tsw(j0 + 5, t)] = (u16)(v4.z >> 16);
        VT[tsw(j0 + 6, t)] = (u16)(v4.w & 0xffffu); VT[tsw(j0 + 7, t)] = (u16)(v4.w >> 16);
      }
      if (tid < 64) {
        Gsc[tid] = lg * (float)min(tid + 1, nvalid);
        dec[tid] = __expf(lg * (float)nvalid);
      }
    }
    if (BR == 1) {
      if (w == 0) {
        float dt = 0.f, g = 0.f;
        if (lane < nvalid) {
          dt = softplus_f(dtraw + dtb);
          g = dt * aneg;
        }
        float x = g;
#pragma unroll
        for (int o = 1; o < 64; o <<= 1) {
          float y = __shfl_up(x, o);
          if (lane >= o) x += y;
        }
        const float ge = __shfl(x, 63);
        Gsc[lane] = x; dtv[lane] = dt; dec[lane] = __expf(ge); psum[lane] = __expf(ge - x);
      }
      __syncthreads();
      if (act) {
        const bool first = (c0 == 0 && ts == 0);
        const float* cst = P.in[4] + (size_t)(l * 128 + b) * 3 * 768 + chan;
#pragma unroll
        for (int p = 0; p < 4; ++p) {
          float x0[11], x1[11];
#pragma unroll
          for (int k = 0; k < 11; ++k) {
            const unsigned wd = p == 0 ? Rx[k].x : (p == 1 ? Rx[k].y : (p == 2 ? Rx[k].z : Rx[k].w));
            x0[k] = __uint_as_float(wd << 16);
            x1[k] = __uint_as_float(wd & 0xffff0000u);
          }
          if (first) {
#pragma unroll
            for (int k = 0; k < 3; ++k) {
              const float2 sv = *(const float2*)(cst + k * 768 + 2 * p);
              x0[k] = sample ? sv.x : 0.f;
              x1[k] = sample ? sv.y : 0.f;
            }
          }
          float o0[8], o1[8];
#pragma unroll
          for (int tt = 0; tt < 8; ++tt) {
            const bool valid = (ts * 8 + tt) < nvalid;
            float a0 = cbv[2 * p], a1 = cbv[2 * p + 1];
#pragma unroll
            for (int i = 0; i < 4; ++i) { a0 += cwv[i][2 * p] * x0[tt + i]; a1 += cwv[i][2 * p + 1] * x1[tt + i]; }
            o0[tt] = valid ? silu_f(a0) : 0.f;
            o1[tt] = valid ? silu_f(a1) : 0.f;
          }
          u16* rowdst = seg == 0 ? XH : (seg == 1 ? KB : QA);
#pragma unroll
          for (int tt = 0; tt < 8; ++tt) *(unsigned*)(rowdst + (ts * 8 + tt) * LDT + c8 + 2 * p) = pack2(o0[tt], o1[tt]);
          if (seg < 2) {
            const float* sc = seg == 0 ? dtv : psum;
            u16* cdst = seg == 0 ? VT : KT;
            float c0v[8], c1v[8];
#pragma unroll
            for (int tt = 0; tt < 8; ++tt) { const float f = sc[ts * 8 + tt]; c0v[tt] = o0[tt] * f; c1v[tt] = o1[tt] * f; }
            *(uint4*)(cdst + tsw(c8 + 2 * p, ts * 8)) = pack8(c0v);
            *(uint4*)(cdst + tsw(c8 + 2 * p + 1, ts * 8)) = pack8(c1v);
          }
          __builtin_amdgcn_sched_barrier(0);
        }
      }
    }
    __syncthreads();
    if (c0 + 64 < T) { REC_LOAD(c0 + 64, RgN) }

#pragma unroll
    for (int nf = 0; nf < NFV; ++nf)
      *(uint2*)(ST + (nf * 16 + r) * LDT + 16 * w + q * 4) = make_uint2(pack2(S[nf][0], S[nf][1]), pack2(S[nf][2], S[nf][3]));

    bf16x8 aq[2];
    aq[0] = *(const bf16x8*)(QA + (16 * w + r) * LDT + q * 8);
    aq[1] = *(const bf16x8*)(QA + (16 * w + r) * LDT + 32 + q * 8);
    float gt[4];
#pragma unroll
    for (int e = 0; e < 4; ++e) gt[e] = Gsc[16 * w + q * 4 + e];
#pragma unroll
    for (int n = 0; n < 4; ++n) {
      f32x4 a = (f32x4){0.f, 0.f, 0.f, 0.f};
      if (n <= w) {
#pragma unroll
        for (int kk = 0; kk < 2; ++kk) {
          bf16x8 bk = *(const bf16x8*)(KB + (16 * n + r) * LDT + kk * 32 + q * 8);
          a = __builtin_amdgcn_mfma_f32_16x16x32_bf16(aq[kk], bk, a, 0, 0, 0);
        }
      }
      const int s = 16 * n + r;
      const float gs = Gsc[s];
#pragma unroll
      for (int e = 0; e < 4; ++e) {
        const int t = 16 * w + q * 4 + e;
        float v = (s <= t) ? a[e] * __expf(gt[e] - gs) : 0.f;
        ATT[t * LDT + s] = (u16)f2bf(v);
      }
    }
    __syncthreads();

    f32x4 O[NFV];
#pragma unroll
    for (int nf = 0; nf < NFV; ++nf) O[nf] = (f32x4){0.f, 0.f, 0.f, 0.f};
#pragma unroll
    for (int kk = 0; kk < 2; ++kk)
#pragma unroll
      for (int nf = 0; nf < NFV; ++nf) {
        bf16x8 bs = *(const bf16x8*)(ST + (nf * 16 + r) * LDT + kk * 32 + q * 8);
        O[nf] = __builtin_amdgcn_mfma_f32_16x16x32_bf16(aq[kk], bs, O[nf], 0, 0, 0);
      }
    if (BR != 0) {
#pragma unroll
      for (int e = 0; e < 4; ++e) {
        const float sc = __expf(gt[e]);
#pragma unroll
        for (int nf = 0; nf < NFV; ++nf) O[nf][e] *= sc;
      }
    }
    {
      float dc[4];
#pragma unroll
      for (int e = 0; e < 4; ++e) dc[e] = dec[16 * w + q * 4 + e];
#pragma unroll
      for (int nf = 0; nf < NFV; ++nf)
#pragma unroll
        for (int e = 0; e < 4; ++e) S[nf][e] *= dc[e];
    }
    int vtb[2], ktb[2];
    vtb[0] = r * LDT + ((q ^ (r >> 3)) << 3);
    vtb[1] = r * LDT + ((q ^ (2 + (r >> 3))) << 3);
    ktb[0] = tsw(16 * w + r, q * 8);
    ktb[1] = tsw(16 * w + r, 32 + q * 8);
#pragma unroll
    for (int kk = 0; kk < 2; ++kk) {
      bf16x8 at = *(const bf16x8*)(ATT + (16 * w + r) * LDT + kk * 32 + q * 8);
      bf16x8 ak = *(const bf16x8*)(KT + ktb[kk]);
#pragma unroll
      for (int nf = 0; nf < NFV; ++nf) {
        bf16x8 bv = *(const bf16x8*)(VT + vtb[nf & 1] + nf * 16 * LDT + ((kk ^ ((nf >> 1) & 1)) * 32));
        O[nf] = __builtin_amdgcn_mfma_f32_16x16x32_bf16(at, bv, O[nf], 0, 0, 0);
        S[nf] = __builtin_amdgcn_mfma_f32_16x16x32_bf16(ak, bv, S[nf], 0, 0, 0);
      }
    }
    __syncthreads();
#pragma unroll
    for (int nf = 0; nf < NFV; ++nf)
#pragma unroll
      for (int e = 0; e < 4; ++e) OST[(16 * w + q * 4 + e) * OLD + nf * 16 + r] = O[nf][e];
    __syncthreads();

#pragma unroll
    for (int it = 0; it < NEP; ++it) {
      const int id = tid + 256 * it;
      const int t = (DV == 128) ? (id >> 4) : (id >> 3);
      const int j0 = (DV == 128) ? (id & 15) * 8 : (id & 7) * 8;
      const bool valid = t < nvalid;
      const size_t row = (size_t)(row0 + c0 + t);
      float ov[8], gv[8], y[8];
      *(float4*)&ov[0] = *(const float4*)(OST + t * OLD + j0);
      *(float4*)&ov[4] = *(const float4*)(OST + t * OLD + j0 + 4);
      unpack8(Rg[it], gv);
      if (BR == 1) {
        float xh[8];
        unpack8(*(const uint4*)(XH + t * LDT + j0), xh);
        float ss = 0.f;
#pragma unroll
        for (int e = 0; e < 8; ++e) { y[e] = (ov[e] + dsk * xh[e]) * silu_rcp(gv[e]); ss += y[e] * y[e]; }
        ss += __shfl_xor(ss, 1); ss += __shfl_xor(ss, 2); ss += __shfl_xor(ss, 4);
        if (valid) {
          *(uint4*)(ybr + row * LDY + h * 64 + j0) = pack8(y);
          if ((tid & 7) == 0) ssq[row * 8 + h] = ss;
        }
      } else {
        float ss = 0.f;
#pragma unroll
        for (int e = 0; e < 8; ++e) ss += ov[e] * ov[e];
        ss += __shfl_xor(ss, 1); ss += __shfl_xor(ss, 2); ss += __shfl_xor(ss, 4); ss += __shfl_xor(ss, 8);
        const float rs = rsqrtf(ss * (1.f / 128.f) + 1e-6f);
        if (BR == 0) {
          const float* wn = P.in[12] + l * 128 + j0;
          const float4 w0 = *(const float4*)wn, w1 = *(const float4*)(wn + 4);
          const float wv[8] = {w0.x, w0.y, w0.z, w0.w, w1.x, w1.y, w1.z, w1.w};
#pragma unroll
          for (int e = 0; e < 8; ++e) y[e] = silu_rcp(gv[e]) * ov[e] * rs * wv[e];
        } else {
#pragma unroll
          for (int e = 0; e < 8; ++e) y[e] = silu_rcp(gv[e]) * ov[e] * rs;
        }
        if (valid) *(uint4*)(ybr + row * LDY + h * 128 + j0) = pack8(y);
      }
      __builtin_amdgcn_sched_barrier(0);
    }
#pragma unroll
    for (int it = 0; it < NEP; ++it) Rg[it] = RgN[it];
    __syncthreads();
  }
#undef REC_LOAD

  {
    float* so;
    if (sample) so = P.out + (BR == 0 ? O_SGS : (BR == 1 ? O_SSS : O_SRS)) + ((size_t)(l * 128 + b) * NH + h) * 64 * DV;
    else so = P.out + (BR == 0 ? O_SGP : (BR == 1 ? O_SSP : O_SRP)) + ((size_t)(l * 8 + b) * NH + h) * 64 * DV;
#pragma unroll
    for (int nf = 0; nf < NFV; ++nf)
#pragma unroll
      for (int e = 0; e < 4; ++e) so[(size_t)(16 * w + q * 4 + e) * DV + nf * 16 + r] = S[nf][e];
  }
}

#ifndef REC_ONLY
#define REC_ONLY -1
#endif
template <int BR>
__device__ __forceinline__ void rec_branch(const Params& P, int l, bool split, int wb, int nwb, int lb0, unsigned char* ldsb) {
  if (!(REC_ONLY < 0 || REC_ONLY == BR)) return;
  constexpr int NH = (BR == 1) ? 8 : 4;
  constexpr int nl = 8 * NH;
  const int end = nl + 128 * NH;
  int it, step;
  if (split) {
    const int bx = blockIdx.x;
    if (bx >= lb0 && bx < lb0 + nl) { it = bx - lb0; step = 1 << 20; }
    else if (bx >= 128) { it = nl + wb; step = nwb; }
    else { it = end; step = 1; }
  } else { it = blockIdx.x; step = gridDim.x; }
  for (; it < end; it += step) {
    const int sample = it >= nl;
    const int idx = sample ? it - nl : it;
    int ll = l;
    asm volatile("" : "+s"(ll));
    rec_item<BR>(P, ll, idx / NH, idx % NH, sample, ldsb);
  }
}

__device__ __forceinline__ void phase_rec(const Params& P, int l, unsigned char* ldsb) {
  const int G = gridDim.x;
  const u16* proj = (const u16*)(P.ws + WS_A);
  const bool split = (G >= 256);
  const int wb = split ? (int)blockIdx.x - 128 : (int)blockIdx.x;
  int nwb = split ? G - 128 : G;
  asm volatile("" : "+s"(nwb));
  if (wb >= 0) {
    for (int i = wb * 256 + otid(); i < (8 + 128) * 3 * 768; i += nwb * 256) {
      const bool pr = i < 8 * 3 * 768;
      const int j = pr ? i : i - 8 * 3 * 768;
      const int b = j / (3 * 768), rem = j - b * 3 * 768, rr = rem / 768, c = rem - rr * 768;
      const size_t row = pr ? (size_t)(b * TP + 2061 + rr) : (size_t)(MP + b * 4 + 1 + rr);
      const size_t oo = pr ? O_SCP + (size_t)l * 8 * 3 * 768 + j : O_SCS + (size_t)l * 128 * 3 * 768 + j;
      P.out[oo] = bf2f(proj[row * NPJ + 2064 + c]);
    }
  }
  rec_branch<0>(P, l, split, wb, nwb, 0, ldsb);
  rec_branch<1>(P, l, split, wb, nwb, 32, ldsb);
  rec_branch<2>(P, l, split, wb, nwb, 96, ldsb);
  if (wb >= 0) {
    __syncthreads();
    if (l == 0) {
      convert_layer(P, 0, ldsb, 1888, 4576, wb, nwb);
      convert_layer(P, 1, ldsb, 0, 2528, wb, nwb);
    } else {
      convert_layer(P, 1, ldsb, 2528, 4576, wb, nwb);
    }
    phase_gates(P, l, wb, nwb, ldsb);
  }
}


#define XB_TMO      128
#define XB_XCNT(j)  (256  + 64 * (j))
#define XB_XSUB(j)  (1280 + 64 * (j))
#define XB_XGEN(j)  (2304 + 64 * (j))
#define XB_TOP      3328
#define XB_TOPGEN   3392
#define XCD_BAR_WORDS 3456
#define XB_SPIN_CAP (1u << 22)
__device__ __forceinline__ unsigned xb_ld(unsigned* p) { return __hip_atomic_load(p, __ATOMIC_RELAXED, __HIP_MEMORY_SCOPE_AGENT); }
__device__ __forceinline__ unsigned xb_add(unsigned* p, unsigned v) { return __hip_atomic_fetch_add(p, v, __ATOMIC_RELAXED, __HIP_MEMORY_SCOPE_AGENT); }
__device__ __forceinline__ unsigned xb_xcc_id() { return (unsigned)__builtin_amdgcn_s_getreg((3 << 11) | 20) & 0xFu; }
#define XB_SPIN(cond, bar) do { unsigned _sp = 0; while (cond) { __builtin_amdgcn_s_sleep(1); \
    if ((++_sp & 255u) == 0u) { if (xb_ld(&(bar)[XB_TMO])) break; if (_sp > XB_SPIN_CAP) { atomicAdd(&(bar)[XB_TMO], 1u); break; } } } } while (0)
struct XcdBarrier { unsigned* bar; unsigned x; volatile LAS unsigned* st; };
__device__ __forceinline__ XcdBarrier xcd_barrier_post(unsigned* bar, volatile LAS unsigned* st) {
  XcdBarrier b; b.bar = bar; b.x = xb_xcc_id(); b.st = st;
  if (threadIdx.x == 0) (void)xb_add(&bar[XB_XCNT(b.x)], 1u);
  return b;
}
__device__ __forceinline__ void xcd_barrier_complete(unsigned* bar, unsigned x, unsigned& nloc, unsigned& nx) {
  const unsigned G = gridDim.x * gridDim.y * gridDim.z;
  unsigned sum, cnt, mine, sp = 0u;
  for (;;) {
    sum = 0u; cnt = 0u; mine = 0u;
#pragma unroll
    for (unsigned j = 0; j < 16; ++j) { const unsigned c = xb_ld(&bar[XB_XCNT(j)]); sum += c; cnt += (c > 0u) ? 1u : 0u; mine = (j == x) ? c : mine; }
    if (sum == G) break;
    __builtin_amdgcn_s_sleep(1);
    if ((++sp & 255u) == 0u) { if (xb_ld(&bar[XB_TMO])) break; if (sp > XB_SPIN_CAP) { atomicAdd(&bar[XB_TMO], 1u); break; } }
  }
  nloc = mine > 0u ? mine : 1u; nx = cnt > 0u ? cnt : 1u;
}
__device__ __forceinline__ void xcd_barrier(const XcdBarrier& b) {
  asm volatile("s_waitcnt vmcnt(0)" ::: "memory");
  __syncthreads();
  if (threadIdx.x == 0) {
    unsigned* bar = b.bar;
    __builtin_amdgcn_s_waitcnt(0);
    unsigned nloc = b.st[0], nx = b.st[1];
    if (nloc == 0u) { xcd_barrier_complete(bar, b.x, nloc, nx); b.st[0] = nloc; b.st[1] = nx; }
    const unsigned old = xb_add(&bar[XB_XSUB(b.x)], 1u);
    const unsigned gen = old / nloc;
    if (old + 1u == (gen + 1u) * nloc) {
      __builtin_amdgcn_fence(__ATOMIC_RELEASE, "agent");
      asm volatile("s_waitcnt vmcnt(0)" ::: "memory");
      const unsigned og = xb_add(&bar[XB_TOP], 1u);
      const unsigned tg = og / nx;
      if (og + 1u == (tg + 1u) * nx) xb_add(&bar[XB_TOPGEN], 1u);
      else XB_SPIN(xb_ld(&bar[XB_TOPGEN]) == tg, bar);
      __builtin_amdgcn_fence(__ATOMIC_ACQUIRE, "agent");
      xb_add(&bar[XB_XGEN(b.x)], 1u);
      asm volatile("s_waitcnt vmcnt(0)" ::: "memory");
    } else {
      XB_SPIN(xb_ld(&bar[XB_XGEN(b.x)]) == gen, bar);
      __builtin_amdgcn_fence(__ATOMIC_ACQUIRE, "agent");
      asm volatile("s_waitcnt vmcnt(0)" ::: "memory");
    }
  }
  __syncthreads();
}

__global__ void __launch_bounds__(256, 2) fwd_kernel(Params P, int ph_lo, int ph_hi) {
  extern __shared__ __attribute__((aligned(16))) unsigned char ldsb[];
  cg::grid_group grid = cg::this_grid();
  volatile LAS unsigned* xst = (volatile LAS unsigned*)(ldsb + 75904);
  if (threadIdx.x == 0) { xst[0] = 0u; xst[1] = 0u; xst[2] = 0u; xst[3] = 0u; }
  __syncthreads();
  XcdBarrier xb = xcd_barrier_post((unsigned*)(P.ws + WS_BAR), xst);
  if (ph_hi > 1000) grid.sync();
  for (int ph = ph_lo; ph < ph_hi; ++ph) {
    if (ph > ph_lo) xcd_barrier(xb);
    if (ph == 0) {
      if (PH_ON(0)) { convert_layer(P, 0, ldsb, 0, 1888, blockIdx.x, gridDim.x); ln_phase(P, 0, 0); }
      continue;
    }
    int phl = ph;
    asm volatile("" : "+s"(phl));
    const int l = (phl - 1) >> 3, s = (phl - 1) & 7;
    switch (s) {
      case 0: if (PH_ON(1)) { phase_proj(P, l, ldsb); if (DUP(1)) phase_proj(P, l, ldsb); } break;
      case 1: if (PH_ON(2)) { phase_rec(P, l, ldsb); if (DUP(2)) { __syncthreads(); phase_rec(P, l, ldsb); } } break;
      case 2: if (PH_ON(3)) { phase_merge(P, l, ldsb); if (DUP(3)) phase_merge(P, l, ldsb); } break;
      case 3: if (PH_ON(4)) { phase_resid(P, 0, l, ldsb); if (DUP(4)) phase_resid(P, 0, l, ldsb); } break;
      case 4: if (PH_ON(5)) { ln_phase(P, 1, l); if (DUP(5)) ln_phase(P, 1, l); } break;
      case 5: if (PH_ON(6)) { phase_ff1(P, l, ldsb); if (DUP(6)) phase_ff1(P, l, ldsb); } break;
      case 6: if (PH_ON(7)) { phase_resid(P, 1, l, ldsb); if (DUP(7)) phase_resid(P, 1, l, ldsb); } break;
      case 7:
        if (PH_ON(8)) { ln_phase(P, 2, l); }
        break;
    }
  }
}

extern "C" void kernel_launch(void* const* d_in, const int* in_sizes, int n_in, void* d_out, int out_size, void* d_ws,
                              size_t ws_size, hipStream_t stream) {
  static int grid_blocks = 0;
  if (grid_blocks == 0) {
    if (n_in != 31 || ws_size < WS_END || out_size != 44666880) {
      fprintf(stderr, "kernel_launch: unexpected problem (n_in %d, ws %zu, out %d)\n", n_in, ws_size, out_size);
      grid_blocks = -1;
      return;
    }
    int dev = 0, cus = 0, per_cu = 0;
    hipGetDevice(&dev);
    hipDeviceGetAttribute(&cus, hipDeviceAttributeMultiprocessorCount, dev);
    hipFuncSetAttribute((const void*)fwd_kernel, hipFuncAttributeMaxDynamicSharedMemorySize, LDS_BYTES);
    hipOccupancyMaxActiveBlocksPerMultiprocessor(&per_cu, (const void*)fwd_kernel, 256, LDS_BYTES);
    if (per_cu < 1) { fprintf(stderr, "kernel_launch: occupancy query says 0 blocks per CU\n"); grid_blocks = -1; return; }
    if (per_cu > 2) per_cu = 2;
    grid_blocks = cus * per_cu;
    grid_blocks -= grid_blocks % 8;
  }
  if (grid_blocks < 0) return;
  Params p{};
  for (int i = 0; i < 31; ++i) p.in[i] = (const float*)d_in[i];
  p.out = (float*)d_out;
  p.ws = (unsigned char*)d_ws;
  if (hipMemsetAsync((char*)d_ws + WS_BAR, 0, XCD_BAR_WORDS * 4, stream) != hipSuccess) { fprintf(stderr, "memset failed\n"); return; }
#if ONE_LAUNCH
  int lo = 0, hi = NPHASE;
  void* args[] = {&p, &lo, &hi};
  hipError_t e = hipLaunchCooperativeKernel((const void*)fwd_kernel, dim3(grid_blocks), dim3(256), args, LDS_BYTES, stream);
  if (e != hipSuccess) fprintf(stderr, "cooperative launch failed: %s (grid %d)\n", hipGetErrorString(e), grid_blocks);
#else
  for (int ph = 0; ph < NPHASE; ++ph) {
    hipLaunchKernelGGL(fwd_kernel, dim3(grid_blocks), dim3(256), LDS_BYTES, stream, p, ph, ph + 1);
  }
#endif
}
```

```cpp
#include <hip/hip_runtime.h>
#include <hip/hip_cooperative_groups.h>
#include <stdint.h>
#include <stdio.h>
namespace cg = cooperative_groups;

#ifndef ONE_LAUNCH
#define ONE_LAUNCH 1
#endif
#ifndef PHASE_ONLY
#define PHASE_ONLY -1
#endif
#define PH_ON(n) (PHASE_ONLY < 0 || PHASE_ONLY == (n))
#ifndef DUP_MASK
#define DUP_MASK 0
#endif
#define DUP(n) ((DUP_MASK >> (n)) & 1)

#define LAS __attribute__((address_space(3)))
typedef unsigned short u16;
typedef __attribute__((ext_vector_type(8))) short bf16x8;
typedef __attribute__((ext_vector_type(4))) float f32x4;

constexpr int D = 1024;
constexpr int TP = 2064;
constexpr int MP = 8 * TP;
constexpr int MS = 512;
constexpr int M = MP + MS;
constexpr int NPJ = 4376;
constexpr int LDT = 72;
constexpr float ALPHA = 1.4142135623730951f;
constexpr int NPHASE = 17;
constexpr int SPLIT_ROW0 = 128 * 128;

constexpr int LDA = 1088;
constexpr int LDY = 576;
constexpr int LDH = 4160;
constexpr size_t WS_WIN = 0;
constexpr size_t WS_WGATE = 9748480;
constexpr size_t WS_WOUT = 16433152;
constexpr size_t WS_WO = 19972096;
constexpr size_t WS_WFF1 = 22200320;
constexpr size_t WS_WFF2 = 31113216;
constexpr size_t WS_ACT = 39632896;
constexpr size_t WS_SSQ = 76677120;
constexpr size_t WS_A = 77221888;
constexpr size_t WS_B = 226215936;
constexpr size_t WS_BAR = 295946240;
constexpr size_t WS_W2 = WS_BAR + 16384;
constexpr size_t WS_G1X = WS_W2 + 22200320;
constexpr size_t WS_END = WS_G1X + 524288;
constexpr int G1_SPLIT = 16768;
constexpr size_t A_PRE = 37044224;

constexpr size_t O_YP = 0, O_YS = 16777216, O_SGP = 17301504, O_SGS = 17825792, O_SSP = 26214400, O_SSS = 26738688,
                 O_SCP = 35127296, O_SCS = 35164160, O_SRP = 35753984, O_SRS = 36278272;

constexpr int LDS_BYTES = 76032;

struct Params { const float* in[31]; float* out; unsigned char* ws; };

__device__ __forceinline__ unsigned f2bf(float f) {
  unsigned u = __float_as_uint(f);
  u += 0x7fffu + ((u >> 16) & 1u);
  return u >> 16;
}
__device__ __forceinline__ float bf2f(u16 h) { return __uint_as_float(((unsigned)h) << 16); }
__device__ __forceinline__ unsigned pack2(float a, float b) { return f2bf(a) | (f2bf(b) << 16); }
__device__ __forceinline__ void unpack8(uint4 v, float (&f)[8]) {
  f[0] = __uint_as_float(v.x << 16); f[1] = __uint_as_float(v.x & 0xffff0000u);
  f[2] = __uint_as_float(v.y << 16); f[3] = __uint_as_float(v.y & 0xffff0000u);
  f[4] = __uint_as_float(v.z << 16); f[5] = __uint_as_float(v.z & 0xffff0000u);
  f[6] = __uint_as_float(v.w << 16); f[7] = __uint_as_float(v.w & 0xffff0000u);
}
__device__ __forceinline__ uint4 pack8(const float (&f)[8]) {
  return make_uint4(pack2(f[0], f[1]), pack2(f[2], f[3]), pack2(f[4], f[5]), pack2(f[6], f[7]));
}
__device__ __forceinline__ int tsw(int row, int col) { return row * LDT + (col ^ (((row >> 3) & 7) << 3)); }
__device__ __forceinline__ int otid() { int t = threadIdx.x; asm volatile("" : "+v"(t)); return t; }
__device__ __forceinline__ float silu_f(float x) { return x / (1.f + __expf(-x)); }
__device__ __forceinline__ float silu_rcp(float x) { return x * __builtin_amdgcn_rcpf(1.f + __expf(-x)); }
__device__ __forceinline__ float sigmoid_f(float x) { return __builtin_amdgcn_rcpf(1.f + __expf(-x)); }
__device__ __forceinline__ float softplus_f(float x) {
  const float e = __expf(-fabsf(x));
  const float l1p = e < 1e-3f ? e * (1.f - 0.5f * e) : __logf(1.f + e);
  return fmaxf(x, 0.f) + l1p;
}

__device__ __forceinline__ void conv_tile64(const float* __restrict__ src, int ld, int ldk, int ncol0, int nvalid, u16* __restrict__ dst,
                            int kt, int nt, const float* __restrict__ kscale, float* tile, int blocked_nkt = 0) {
  const int tid = otid();
  const int c = tid & 63, r4 = tid >> 6;
  const int n = nt * 64 + c;
  const bool ok = n < nvalid;
#pragma unroll
  for (int i = 0; i < 16; ++i) {
    int k = r4 + 4 * i;
    int kg = kt * 64 + k;
    float v = ok ? src[(size_t)kg * ld + ncol0 + n] : 0.f;
    if (kscale) v *= kscale[kg];
    tile[k * 65 + c] = v;
  }
  __syncthreads();
#pragma unroll
  for (int it = 0; it < 2; ++it) {
    int id = tid + 256 * it;
    int nn = id >> 3, kc = id & 7;
    unsigned w0 = pack2(tile[(kc * 8 + 0) * 65 + nn], tile[(kc * 8 + 1) * 65 + nn]);
    unsigned w1 = pack2(tile[(kc * 8 + 2) * 65 + nn], tile[(kc * 8 + 3) * 65 + nn]);
    unsigned w2 = pack2(tile[(kc * 8 + 4) * 65 + nn], tile[(kc * 8 + 5) * 65 + nn]);
    unsigned w3 = pack2(tile[(kc * 8 + 6) * 65 + nn], tile[(kc * 8 + 7) * 65 + nn]);
    const int n_ = nt * 64 + nn;
    const size_t di = blocked_nkt ? ((size_t)((n_ >> 7) * blocked_nkt + kt) * 8192 + (n_ & 127) * 64 + kc * 8)
                                  : ((size_t)n_ * ldk + kt * 64 + kc * 8);
    *(uint4*)(dst + di) = make_uint4(w0, w1, w2, w3);
  }
  __syncthreads();
}

__device__ __forceinline__ void convert_layer(const Params& P, int l, unsigned char* lds, int t_lo, int t_hi, int wb, int nwb) {
  float* tile = (float*)lds;
  unsigned char* ws = P.ws;
  const size_t wsel = (l == 0) ? 0 : WS_W2;
  for (int t = t_lo + wb; t < t_hi; t += nwb) {
    int idx = t;
    if (idx < 1120) {
      conv_tile64(P.in[9] + (size_t)l * 1024 * 7448, 7448, LDA, 0, NPJ, (u16*)(ws + wsel + WS_WIN), idx % 16, idx / 16, nullptr, tile);
      continue;
    }
    idx -= 1120;
    if (idx < 768) {
      conv_tile64(P.in[9] + (size_t)l * 1024 * 7448, 7448, LDA, NPJ, 3072, (u16*)(ws + wsel + WS_WGATE), idx % 16, idx / 16, nullptr, tile);
      continue;
    }
    idx -= 768;
    if (idx < 384) {
      int br = idx / 128, r = idx % 128;
      conv_tile64(P.in[19 + br] + (size_t)l * 512 * 1024, 1024, LDY, 0, 1024, (u16*)(ws + wsel + WS_WOUT) + (size_t)br * 1024 * LDY,
                  r % 8, r / 8, br == 1 ? P.in[18] + l * 512 : nullptr, tile);
      continue;
    }
    idx -= 384;
    if (idx < 256) {
      conv_tile64(P.in[22] + (size_t)l * 1024 * 1024, 1024, LDA, 0, 1024, (u16*)(ws + wsel + WS_WO), idx % 16, idx / 16, nullptr, tile);
      continue;
    }
    idx -= 256;
    if (idx < 1024) {
      conv_tile64(P.in[25] + (size_t)l * 1024 * 4096, 4096, LDA, 0, 4096, (u16*)(ws + WS_WFF1), idx % 16, idx / 16, nullptr, tile);
      continue;
    }
    idx -= 1024;
    conv_tile64(P.in[27] + (size_t)l * 4096 * 1024, 1024, LDH, 0, 1024, (u16*)(ws + WS_WFF2), idx % 64, idx / 64, nullptr, tile, 64);
  }
}

__device__ __forceinline__ void ln_phase(const Params& P, int mode, int l) {
  const int tid_ = otid();
  const int lane = tid_ & 63;
  const int gw = blockIdx.x * 4 + (tid_ >> 6);
  const int nw = gridDim.x * 4;
  const float* wv = mode == 0 ? P.in[7] : (mode == 1 ? P.in[23] + l * D : P.in[29] + l * D);
  const float* bv = mode == 0 ? P.in[8] : (mode == 1 ? P.in[24] + l * D : P.in[30] + l * D);
  u16* act = (u16*)(P.ws + WS_ACT);
  const bool final_out = (mode == 2 && l == 1);
  for (int row = gw; row < M; row += nw) {
    const float* s;
    int b = 0, t = 0;
    if (row < MP) { b = row / TP; t = row - b * TP; }
    if (mode == 0) {
      if (row < MP) s = (t < 16) ? P.in[6] + (size_t)t * D : P.in[0] + ((size_t)b * 2048 + (t - 16)) * D;
      else s = P.in[1] + (size_t)(row - MP) * D;
    } else if (mode == 1) {
      s = (const float*)(P.ws + WS_A + A_PRE) + (size_t)row * D;
    } else {
      s = (const float*)(P.ws + WS_B) + (size_t)row * D;
    }
    float4 v[4];
#pragma unroll
    for (int i = 0; i < 4; ++i) v[i] = *(const float4*)(s + i * 256 + lane * 4);
    float sum = 0.f;
#pragma unroll
    for (int i = 0; i < 4; ++i) sum += v[i].x + v[i].y + v[i].z + v[i].w;
#pragma unroll
    for (int o = 32; o >= 1; o >>= 1) sum += __shfl_xor(sum, o);
    const float mean = sum * (1.f / 1024.f);
    float sq = 0.f;
#pragma unroll
    for (int i = 0; i < 4; ++i) {
      v[i].x -= mean; v[i].y -= mean; v[i].z -= mean; v[i].w -= mean;
      sq += v[i].x * v[i].x + v[i].y * v[i].y + v[i].z * v[i].z + v[i].w * v[i].w;
    }
#pragma unroll
    for (int o = 32; o >= 1; o >>= 1) sq += __shfl_xor(sq, o);
    const float rstd = rsqrtf(sq * (1.f / 1024.f) + 1e-5f);
    float* od = nullptr;
    if (final_out) {
      if (row < MP) { if (t >= 16) od = P.out + O_YP + ((size_t)b * 2048 + (t - 16)) * D; }
      else od = P.out + O_YS + (size_t)(row - MP) * D;
    }
#pragma unroll
    for (int i = 0; i < 4; ++i) {
      const int c = i * 256 + lane * 4;
      float4 w4 = *(const float4*)(wv + c), b4 = *(const float4*)(bv + c);
      float y0 = v[i].x * rstd * w4.x + b4.x, y1 = v[i].y * rstd * w4.y + b4.y;
      float y2 = v[i].z * rstd * w4.z + b4.z, y3 = v[i].w * rstd * w4.w + b4.w;
      if (final_out) {
        if (od) *(float4*)(od + c) = make_float4(y0, y1, y2, y3);
      } else {
        const unsigned p0 = pack2(y0, y1), p1 = pack2(y2, y3);
        *(uint2*)(act + (size_t)row * LDA + c) = make_uint2(p0, p1);
        if (mode == 1 && row >= SPLIT_ROW0) {
          const float4 bb = *(const float4*)(P.in[28] + l * D + c);
          float* pz = (float*)(P.ws + WS_B) + (size_t)row * D + c;
          *(float4*)pz = make_float4(ALPHA * __uint_as_float(p0 << 16) + bb.x, ALPHA * __uint_as_float(p0 & 0xffff0000u) + bb.y,
                                     ALPHA * __uint_as_float(p1 << 16) + bb.z, ALPHA * __uint_as_float(p1 & 0xffff0000u) + bb.w);
        }
      }
    }
  }
}

#define G_LOAD4(R, k0)                                                                    \
  R##a0 = *(const uint4*)(ap + (k0)); R##a1 = *(const uint4*)(ap + sa + (k0));            \
  R##a2 = *(const uint4*)(ap + 2 * sa + (k0)); R##a3 = *(const uint4*)(ap + 3 * sa + (k0)); \
  R##b0 = *(const uint4*)(bp + (k0)); R##b1 = *(const uint4*)(bp + sb + (k0));
#define G_LOADB(R, k0)                                                                    \
  R##b2 = *(const uint4*)(bp + 2 * sb + (k0)); R##b3 = *(const uint4*)(bp + 3 * sb + (k0));
#define L_STORE4(R, buf)                                                                  \
  { u16* ad = As + (buf) * 128 * LDT + crow * LDT + cck;                                  \
    u16* bd = Bs + (buf) * BN * LDT + crow * LDT + cck;                                   \
    *(uint4*)(ad) = R##a0; *(uint4*)(ad + 32 * LDT) = R##a1; *(uint4*)(ad + 64 * LDT) = R##a2; *(uint4*)(ad + 96 * LDT) = R##a3; \
    *(uint4*)(bd) = R##b0; *(uint4*)(bd + 32 * LDT) = R##b1;                              \
    if (NF == 4) { *(uint4*)(bd + 64 * LDT) = R##b2; *(uint4*)(bd + 96 * LDT) = R##b3; } }
#define MMA_TILE(buf)                                                                     \
  { const u16* as = As + (buf) * 128 * LDT + (wm * 64 + r) * LDT + q * 8;                 \
    const u16* bs = Bs + (buf) * BN * LDT + (wn * NF * 16 + r) * LDT + q * 8;             \
    _Pragma("unroll") for (int kk = 0; kk < 2; ++kk) {                                    \
      bf16x8 af[4], bfr[NF];                                                              \
      _Pragma("unroll") for (int mf = 0; mf < 4; ++mf) af[mf] = *(const bf16x8*)(as + mf * 16 * LDT + kk * 32); \
      _Pragma("unroll") for (int nf = 0; nf < NF; ++nf) bfr[nf] = *(const bf16x8*)(bs + nf * 16 * LDT + kk * 32); \
      _Pragma("unroll") for (int mf = 0; mf < 4; ++mf)                                    \
        _Pragma("unroll") for (int nf = 0; nf < NF; ++nf)                                 \
          acc[mf][nf] = __builtin_amdgcn_mfma_f32_16x16x32_bf16(af[mf], bfr[nf], acc[mf][nf], 0, 0, 0); \
    } }

__device__ __forceinline__ int lds_byte(int r, int c) {
  int st = (r >> 4) * 2 + (c >> 5), rr = r & 15, cc = c & 31, ob = rr * 64 + cc * 2;
  return st * 1024 + (ob ^ (((ob >> 9) & 1) << 5));
}
__device__ __forceinline__ void stage_rc(int b, int& R, int& C) {
  int st = b >> 10, sb = b & 1023, swz = sb ^ (((sb >> 9) & 1) << 5);
  R = (st >> 1) * 16 + (swz >> 6);
  C = (st & 1) * 32 + ((swz & 63) >> 1);
}

template <int NF>
__device__ __forceinline__ void gemm_core(f32x4 (&acc)[4][NF], const u16* __restrict__ A, int lda,
                                          const u16* __restrict__ B, int ldb, int K, u16* lds, int kadv = 64) {
  constexpr int BN = 32 * NF;
  constexpr int ABYTES = 128 * 64 * 2;
  constexpr int BBYTES = BN * 64 * 2;
  constexpr int BUF = ABYTES + BBYTES;
  unsigned char* base = (unsigned char*)lds;
  const int tid = otid(), lane = tid & 63, w = tid >> 6, wm = w >> 1, wn = w & 1, r = lane & 15, q = lane >> 4;
  const u16* ga[4]; const u16* gb[NF];
#pragma unroll
  for (int i = 0; i < 4; ++i) { int R, C; stage_rc(tid * 16 + i * 4096, R, C); ga[i] = A + (size_t)R * lda + C; }
#pragma unroll
  for (int i = 0; i < NF; ++i) { int R, C; stage_rc(tid * 16 + i * 4096, R, C); gb[i] = B + (size_t)R * ldb + C; }
  int oa[4][2], ob[NF][2];
#pragma unroll
  for (int mf = 0; mf < 4; ++mf)
#pragma unroll
    for (int kk = 0; kk < 2; ++kk) oa[mf][kk] = lds_byte(wm * 64 + mf * 16 + r, kk * 32 + q * 8);
#pragma unroll
  for (int nf = 0; nf < NF; ++nf)
#pragma unroll
    for (int kk = 0; kk < 2; ++kk) ob[nf][kk] = lds_byte(wn * NF * 16 + nf * 16 + r, kk * 32 + q * 8);
#define STAGE_TILE(buf, k0)                                                                              \
  {                                                                                                      \
    _Pragma("unroll") for (int i = 0; i < 4; ++i)                                                        \
      __builtin_amdgcn_global_load_lds((const unsigned*)(ga[i] + (k0)),                                  \
        (LAS unsigned*)(base + (buf) * BUF + tid * 16 + i * 4096), 16, 0, 0);                            \
    _Pragma("unroll") for (int i = 0; i < NF; ++i)                                                       \
      __builtin_amdgcn_global_load_lds((const unsigned*)(gb[i] + (k0)),                                  \
        (LAS unsigned*)(base + (buf) * BUF + ABYTES + tid * 16 + i * 4096), 16, 0, 0);                   \
  }
  const int nk = K >> 6;
  STAGE_TILE(0, 0)
  asm volatile("s_waitcnt vmcnt(0)" ::: "memory");
  __syncthreads();
  for (int kt = 0; kt < nk; ++kt) {
    const int buf = kt & 1;
    if (kt + 1 < nk) STAGE_TILE(buf ^ 1, (size_t)(kt + 1) * kadv)
    const unsigned char* as = base + buf * BUF;
    const unsigned char* bs = as + ABYTES;
    bf16x8 af0[4], bf0[NF], af1[4], bf1[NF];
#pragma unroll
    for (int mf = 0; mf < 4; ++mf) af0[mf] = *(const bf16x8*)(as + oa[mf][0]);
#pragma unroll
    for (int nf = 0; nf < NF; ++nf) bf0[nf] = *(const bf16x8*)(bs + ob[nf][0]);
    __builtin_amdgcn_s_setprio(1);
#pragma unroll
    for (int nf = 0; nf < NF / 2; ++nf)
#pragma unroll
      for (int mf = 0; mf < 4; ++mf)
        acc[mf][nf] = __builtin_amdgcn_mfma_f32_16x16x32_bf16(af0[mf], bf0[nf], acc[mf][nf], 0, 0, 0);
    __builtin_amdgcn_s_setprio(0);
#pragma unroll
    for (int mf = 0; mf < 4; ++mf) af1[mf] = *(const bf16x8*)(as + oa[mf][1]);
#pragma unroll
    for (int nf = 0; nf < NF; ++nf) bf1[nf] = *(const bf16x8*)(bs + ob[nf][1]);
    __builtin_amdgcn_s_setprio(1);
#pragma unroll
    for (int nf = NF / 2; nf < NF; ++nf)
#pragma unroll
      for (int mf = 0; mf < 4; ++mf)
        acc[mf][nf] = __builtin_amdgcn_mfma_f32_16x16x32_bf16(af0[mf], bf0[nf], acc[mf][nf], 0, 0, 0);
#pragma unroll
    for (int nf = 0; nf < NF; ++nf)
#pragma unroll
      for (int mf = 0; mf < 4; ++mf)
        acc[mf][nf] = __builtin_amdgcn_mfma_f32_16x16x32_bf16(af1[mf], bf1[nf], acc[mf][nf], 0, 0, 0);
    __builtin_amdgcn_s_setprio(0);
    asm volatile("s_waitcnt vmcnt(0)" ::: "memory");
    __syncthreads();
  }
#undef STAGE_TILE
}

#define TILE_LOOP(total)                                                                      \
  const int _nx = (gridDim.x % 8 == 0) ? 8 : 1;                                              \
  const int _ns = gridDim.x / _nx;                                                           \
  const int _x = blockIdx.x % _nx, _s = blockIdx.x / _nx;                                    \
  const int _per = ((total) + _nx - 1) / _nx;                                                \
  const int _lo = _x * _per;                                                                 \
  const int _hi = min((total), _lo + _per);                                                  \
  for (int t = _lo + _s; t < _hi; t += _ns)

__device__ __forceinline__ void tile_decode(int t, int MT, int NT, int& mt, int& nt) {
  int g = t / (8 * NT), r = t - g * 8 * NT;
  int gs = min(8, MT - g * 8);
  mt = g * 8 + r % gs;
  nt = r / gs;
}

template <int NF>
__device__ __forceinline__ void zero_acc(f32x4 (&acc)[4][NF]) {
#pragma unroll
  for (int i = 0; i < 4; ++i)
#pragma unroll
    for (int j = 0; j < NF; ++j) acc[i][j] = (f32x4){0.f, 0.f, 0.f, 0.f};
}

__device__ __forceinline__ void phase_proj(const Params& P, int l, unsigned char* ldsb) {
  const u16* act = (const u16*)(P.ws + WS_ACT);
  const u16* W = (const u16*)(P.ws + (l == 0 ? 0 : WS_W2) + WS_WIN);
  u16* proj = (u16*)(P.ws + WS_A);
  constexpr int MT = 133, NT = 35;
  TILE_LOOP(MT * NT) {
    int mt, nt; tile_decode(t, MT, NT, mt, nt);
    const int tid_ = otid(), lane = tid_ & 63, w = tid_ >> 6, wm = w >> 1, wn = w & 1, r = lane & 15, q = lane >> 4;
    f32x4 acc[4][4]; zero_acc<4>(acc);
    gemm_core<4>(acc, act + (size_t)mt * 128 * LDA, LDA, W + (size_t)nt * 128 * LDA, LDA, D, (u16*)ldsb);
#pragma unroll
    for (int mf = 0; mf < 4; ++mf)
#pragma unroll
      for (int nf = 0; nf < 4; ++nf) {
        const int col = nt * 128 + wn * 64 + nf * 16 + r;
        if (col < NPJ) {
#pragma unroll
          for (int e = 0; e < 4; ++e) {
            const int row = mt * 128 + wm * 64 + mf * 16 + q * 4 + e;
            proj[(size_t)row * NPJ + col] = (u16)f2bf(acc[mf][nf][e]);
          }
        }
      }
  }
}

__device__ __forceinline__ u16* gate_row(const Params& P, int br, int row) {
  if (br == 0) return (u16*)P.out + (size_t)row * D;
  if (row < G1_SPLIT) return (u16*)P.out + (size_t)M * D + (size_t)row * D;
  return (u16*)(P.ws + WS_G1X) + (size_t)(row - G1_SPLIT) * D;
}

__device__ __forceinline__ void phase_gates(const Params& P, int l, int wb, int nwb, unsigned char* ldsb) {
  const u16* act = (const u16*)(P.ws + WS_ACT);
  const u16* Wg = (const u16*)(P.ws + (l == 0 ? 0 : WS_W2) + WS_WGATE);
  constexpr int MT = 133, NT = 8;
  for (int t = wb; t < 2 * MT * NT; t += nwb) {
    const int br = t / (MT * NT);
    int mt, nt; tile_decode(t - br * MT * NT, MT, NT, mt, nt);
    const int tid_ = otid(), lane = tid_ & 63, w = tid_ >> 6, wm = w >> 1, wn = w & 1, r = lane & 15, q = lane >> 4;
    f32x4 acc[4][4]; zero_acc<4>(acc);
    gemm_core<4>(acc, act + (size_t)mt * 128 * LDA, LDA, Wg + ((size_t)br * 1024 + nt * 128) * LDA, LDA, D, (u16*)ldsb);
#pragma unroll
    for (int mf = 0; mf < 4; ++mf)
#pragma unroll
      for (int e = 0; e < 4; ++e) {
        const int row = mt * 128 + wm * 64 + mf * 16 + q * 4 + e;
        u16* gr = gate_row(P, br, row);
#pragma unroll
        for (int nf = 0; nf < 4; ++nf) gr[nt * 128 + wn * 64 + nf * 16 + r] = (u16)f2bf(sigmoid_f(acc[mf][nf][e]));
      }
  }
}

__device__ __forceinline__ void phase_merge(const Params& P, int l, unsigned char* ldsb) {
  const u16* act = (const u16*)(P.ws + WS_ACT);
  const u16* Wg = (const u16*)(P.ws + (l == 0 ? 0 : WS_W2) + WS_WGATE);
  const u16* Wo = (const u16*)(P.ws + (l == 0 ? 0 : WS_W2) + WS_WOUT);
  const u16* ybr = (const u16*)(P.ws + WS_B);
  const float* ssq = (const float*)(P.ws + WS_SSQ);
  u16* merged = (u16*)(P.ws + WS_A);
  constexpr int MT = 133, NT = 16;
  {
    float* pre = (float*)(P.ws + WS_A + A_PRE);
    for (int i = blockIdx.x * 256 + otid(); i < (M - SPLIT_ROW0) * (D / 4); i += gridDim.x * 256) {
      const int row = SPLIT_ROW0 + i / (D / 4), c = (i % (D / 4)) * 4;
      const uint2 xv = *(const uint2*)(act + (size_t)row * LDA + c);
      *(float4*)(pre + (size_t)row * D + c) = make_float4(ALPHA * __uint_as_float(xv.x << 16), ALPHA * __uint_as_float(xv.x & 0xffff0000u),
                                                          ALPHA * __uint_as_float(xv.y << 16), ALPHA * __uint_as_float(xv.y & 0xffff0000u));
    }
  }
  TILE_LOOP(MT * NT) {
    int mt, nt; tile_decode(t, MT, NT, mt, nt);
    const int tid_ = otid(), lane = tid_ & 63, w = tid_ >> 6, wm = w >> 1, wn = w & 1, r = lane & 15, q = lane >> 4;
    f32x4 fin[4][2]; zero_acc<2>(fin);
#pragma unroll 1
    for (int br = 0; br < 3; ++br) {
      f32x4 g[4][2]; zero_acc<2>(g);
      if (br == 2) {
        gemm_core<2>(g, act + (size_t)mt * 128 * LDA, LDA, Wg + ((size_t)br * 1024 + nt * 64) * LDA, LDA, D, (u16*)ldsb);
#pragma unroll
        for (int mf = 0; mf < 4; ++mf)
#pragma unroll
          for (int nf = 0; nf < 2; ++nf)
#pragma unroll
            for (int e = 0; e < 4; ++e) g[mf][nf][e] = sigmoid_f(g[mf][nf][e]);
      } else {
#pragma unroll
        for (int mf = 0; mf < 4; ++mf)
#pragma unroll
          for (int e = 0; e < 4; ++e) {
            const u16* gr = gate_row(P, br, mt * 128 + wm * 64 + mf * 16 + q * 4 + e) + nt * 64 + wn * 32 + r;
#pragma unroll
            for (int nf = 0; nf < 2; ++nf) g[mf][nf][e] = bf2f(gr[nf * 16]);
          }
      }
      const u16* yb = ybr + (size_t)br * M * LDY + (size_t)mt * 128 * LDY;
      const u16* wb = Wo + (size_t)br * 1024 * LDY + (size_t)nt * 64 * LDY;
      if (br != 1) {
        f32x4 acc[4][2]; zero_acc<2>(acc);
        gemm_core<2>(acc, yb, LDY, wb, LDY, 512, (u16*)ldsb);
#pragma unroll
        for (int mf = 0; mf < 4; ++mf)
#pragma unroll
          for (int nf = 0; nf < 2; ++nf)
#pragma unroll
            for (int e = 0; e < 4; ++e) fin[mf][nf][e] += g[mf][nf][e] * acc[mf][nf][e];
      } else {
#pragma unroll 1
        for (int grp = 0; grp < 2; ++grp) {
          f32x4 acc[4][2]; zero_acc<2>(acc);
          gemm_core<2>(acc, yb + grp * 256, LDY, wb + grp * 256, LDY, 256, (u16*)ldsb);
#pragma unroll
          for (int mf = 0; mf < 4; ++mf)
#pragma unroll
            for (int e = 0; e < 4; ++e) {
              const int row = mt * 128 + wm * 64 + mf * 16 + q * 4 + e;
              float4 s4 = *(const float4*)(ssq + (size_t)row * 8 + grp * 4);
              float rs = rsqrtf((s4.x + s4.y + s4.z + s4.w) * (1.f / 256.f) + 1e-6f);
#pragma unroll
              for (int nf = 0; nf < 2; ++nf) fin[mf][nf][e] += g[mf][nf][e] * rs * acc[mf][nf][e];
            }
        }
      }
    }
#pragma unroll
    for (int mf = 0; mf < 4; ++mf)
#pragma unroll
      for (int nf = 0; nf < 2; ++nf)
#pragma unroll
        for (int e = 0; e < 4; ++e) {
          const int row = mt * 128 + wm * 64 + mf * 16 + q * 4 + e;
          const int col = nt * 64 + wn * 32 + nf * 16 + r;
          merged[(size_t)row * LDA + col] = (u16)f2bf(fin[mf][nf][e]);
        }
  }
}

__device__ __forceinline__ void phase_resid(const Params& P, int mode, int l, unsigned char* ldsb) {
  const u16* act = (const u16*)(P.ws + WS_ACT);
  const u16* A = (const u16*)(P.ws + WS_A);
  const int K = mode == 0 ? 1024 : 4096;
  const int ldk = mode == 0 ? LDA : LDH;
  const u16* W = (const u16*)(P.ws + (mode == 0 ? (l == 0 ? 0 : WS_W2) + WS_WO : WS_WFF2));
  float* dst = mode == 0 ? (float*)(P.ws + WS_A + A_PRE) : (float*)(P.ws + WS_B);
  const float* bias = P.in[28] + l * D;
  constexpr int MT = 128, NT = 8;
  TILE_LOOP(MT * NT) {
    int mt, nt; tile_decode(t, MT, NT, mt, nt);
    const int tid_ = otid(), lane = tid_ & 63, w = tid_ >> 6, wm = w >> 1, wn = w & 1, r = lane & 15, q = lane >> 4;
    f32x4 acc[4][4]; zero_acc<4>(acc);
    if (mode == 0) gemm_core<4>(acc, A + (size_t)mt * 128 * ldk, ldk, W + (size_t)nt * 128 * ldk, ldk, K, (u16*)ldsb);
    else gemm_core<4>(acc, A + (size_t)mt * 64 * 8192, 64, W + (size_t)nt * 64 * 8192, 64, K, (u16*)ldsb, 8192);
#pragma unroll
    for (int mf = 0; mf < 4; ++mf)
#pragma unroll
      for (int nf = 0; nf < 4; ++nf) {
        const int col = nt * 128 + wn * 64 + nf * 16 + r;
        const float bb = mode == 1 ? bias[col] : 0.f;
#pragma unroll
        for (int e = 0; e < 4; ++e) {
          const int row = mt * 128 + wm * 64 + mf * 16 + q * 4 + e;
          dst[(size_t)row * D + col] = ALPHA * bf2f(act[(size_t)row * LDA + col]) + acc[mf][nf][e] + bb;
        }
      }
  }
  {
    constexpr int S = 8;
    const int KS = K / S;
    for (int li = blockIdx.x; li < 40 * S; li += gridDim.x) {
      const int sl = li % S, tl = li / S;
      const int mt = 128 + tl / 8, nt = tl % 8;
      const int tid_ = otid(), lane = tid_ & 63, w = tid_ >> 6, wm = w >> 1, wn = w & 1, r = lane & 15, q = lane >> 4;
      f32x4 acc[4][4]; zero_acc<4>(acc);
      if (mode == 0) gemm_core<4>(acc, A + (size_t)mt * 128 * ldk + sl * KS, ldk, W + (size_t)nt * 128 * ldk + sl * KS, ldk, KS, (u16*)ldsb);
      else gemm_core<4>(acc, A + ((size_t)mt * 64 + sl * (KS / 64)) * 8192, 64, W + ((size_t)nt * 64 + sl * (KS / 64)) * 8192, 64, KS, (u16*)ldsb, 8192);
#pragma unroll
      for (int mf = 0; mf < 4; ++mf)
#pragma unroll
        for (int nf = 0; nf < 4; ++nf) {
          const int col = nt * 128 + wn * 64 + nf * 16 + r;
#pragma unroll
          for (int e = 0; e < 4; ++e) {
            const int row = mt * 128 + wm * 64 + mf * 16 + q * 4 + e;
            (void)__hip_atomic_fetch_add(dst + (size_t)row * D + col, acc[mf][nf][e], __ATOMIC_RELAXED, __HIP_MEMORY_SCOPE_AGENT);
          }
        }
    }
  }
}

__device__ __forceinline__ void phase_ff1(const Params& P, int l, unsigned char* ldsb) {
  const u16* act = (const u16*)(P.ws + WS_ACT);
  const u16* W = (const u16*)(P.ws + WS_WFF1);
  u16* hid = (u16*)(P.ws + WS_A);
  const float* bias = P.in[26] + l * 4096;
  constexpr int MT = 133, NT = 32;
  TILE_LOOP(MT * NT) {
    int mt, nt; tile_decode(t, MT, NT, mt, nt);
    const int tid_ = otid(), lane = tid_ & 63, w = tid_ >> 6, wm = w >> 1, wn = w & 1, r = lane & 15, q = lane >> 4;
    f32x4 acc[4][4]; zero_acc<4>(acc);
    gemm_core<4>(acc, act + (size_t)mt * 128 * LDA, LDA, W + (size_t)nt * 128 * LDA, LDA, D, (u16*)ldsb);
#pragma unroll
    for (int mf = 0; mf < 4; ++mf)
#pragma unroll
      for (int nf = 0; nf < 4; ++nf) {
        const int col = nt * 128 + wn * 64 + nf * 16 + r;
        const float bb = bias[col];
#pragma unroll
        for (int e = 0; e < 4; ++e) {
          const int row = mt * 128 + wm * 64 + mf * 16 + q * 4 + e;
          float v = fmaxf(acc[mf][nf][e] + bb, 0.f);
          hid[((size_t)(row >> 7) * 64 + (col >> 6)) * 8192 + (row & 127) * 64 + (col & 63)] = (u16)f2bf(v * v);
        }
      }
  }
}

template <int BR>
__device__ __forceinline__ void rec_item(const Params& P, int l, int b, int h, int sample, unsigned char* ldsb) {
  constexpr int DV = (BR == 1) ? 64 : 128;
  constexpr int NFV = DV / 16;
  constexpr int NH = (BR == 1) ? 8 : 4;
  constexpr int OLD = DV + 4;
  constexpr int NEP = DV / 32;
  u16* QA = (u16*)ldsb;
  u16* KB = QA + 64 * LDT;
  u16* KT = KB + 64 * LDT;
  u16* ATT = KT + 64 * LDT;
  u16* VT = ATT + 64 * LDT;
  u16* ST = VT + 128 * LDT;
  float* Gsc = (float*)(ST + 128 * LDT);
  float* dec = Gsc + 64;
  float* dtv = dec + 64;
  float* psum = dtv + 64;
  float* invf = psum + 256;
  float* Gl = (float*)ST;
  float* AL = (float*)ATT;
  float* OST = (float*)ldsb;
  u16* XH = VT + 64 * LDT;

  const int tid = otid(), lane = tid & 63, w = tid >> 6, r = lane & 15, q = lane >> 4;
  const int T = sample ? 4 : TP;
  const int row0 = sample ? MP + b * 4 : b * TP;
  const int pos0 = sample ? 16384 : 0;
  const u16* proj = (const u16*)(P.ws + WS_A);
  u16* ybr = (u16*)(P.ws + WS_B) + (size_t)BR * M * LDY;
  float* ssq = (float*)(P.ws + WS_SSQ);

  float lg = 0.f, aneg = 0.f, dtb = 0.f, dsk = 0.f;
  if (BR == 2) {
    lg = log1pf(-exp2f(-5.f - (float)h));
    if (tid < 32) invf[tid] = exp2f(-(float)tid * (13.287712379549449f / 32.0f));
  }
  if (BR == 1) {
    aneg = -__expf(P.in[16][l * 8 + h]);
    dtb = P.in[15][l * 8 + h];
    dsk = P.in[17][l * 8 + h];
  }
  const int grp = h >> 2;

  f32x4 S[NFV];
  {
    const float* sin_ = P.in[2];
    if (sample) {
      const float* base = BR == 0 ? P.in[2] : (BR == 1 ? P.in[3] : P.in[5]);
      sin_ = base + ((size_t)(l * 128 + b) * NH + h) * 64 * DV;
    }
#pragma unroll
    for (int nf = 0; nf < NFV; ++nf)
#pragma unroll
      for (int e = 0; e < 4; ++e) {
        float v = sin_[(size_t)(16 * w + q * 4 + e) * DV + nf * 16 + r];
        S[nf][e] = sample ? v : 0.f;
      }
  }
  __syncthreads();

  uint4 Rg[NEP], RgN[NEP];
  uint4 Rq[2], Rk[2], Rv[4], Ral;
  uint4 Rq1, Rq2, Rk1, Rk2;
  uint4 Rx[11];
  float dtraw = 0.f;
  const int ci = tid & 63, part = tid >> 6;
  float w2r[16];
  float bias = 0.f;
  if (BR == 0) {
#pragma unroll
    for (int rr = 0; rr < 16; ++rr) w2r[rr] = P.in[10][(size_t)(l * 16 + rr) * 256 + h * 64 + ci];
    bias = P.in[11][l * 256 + h * 64 + ci];
  }
  const int cc = tid >> 3, ts = tid & 7;
  const bool act = tid < 192;
  const int seg = cc >> 3, c8 = (cc & 7) * 8;
  const int chan = seg == 0 ? h * 64 + c8 : (seg == 1 ? 512 + grp * 64 + c8 : 640 + grp * 64 + c8);
  float cwv[4][8], cbv[8];
  if (BR == 1 && act) {
    const float* cw = P.in[13] + (size_t)l * 4 * 768 + chan;
    const float* cb = P.in[14] + (size_t)l * 768 + chan;
#pragma unroll
    for (int i = 0; i < 4; ++i) {
      *(float4*)&cwv[i][0] = *(const float4*)(cw + i * 768);
      *(float4*)&cwv[i][4] = *(const float4*)(cw + i * 768 + 4);
    }
    *(float4*)&cbv[0] = *(const float4*)cb;
    *(float4*)&cbv[4] = *(const float4*)(cb + 4);
  }
#define REC_LOAD(CB, RGD)                                                                                     \
  {                                                                                                           \
    const int goff_ = BR == 0 ? 1024 + h * 128 : (BR == 1 ? 1552 + h * 64 : 3864 + h * 128);                  \
    _Pragma("unroll") for (int it = 0; it < NEP; ++it) {                                                      \
      const int id = tid + 256 * it;                                                                          \
      const int t = (DV == 128) ? (id >> 4) : (id >> 3);                                                      \
      const int j0 = (DV == 128) ? (id & 15) * 8 : (id & 7) * 8;                                              \
      RGD[it] = *(const uint4*)(proj + (size_t)(row0 + min((CB) + t, T - 1)) * NPJ + goff_ + j0);             \
    }                                                                                                         \
    if (BR == 0) {                                                                                            \
      _Pragma("unroll") for (int it = 0; it < 2; ++it) {                                                      \
        const int id = tid + 256 * it;                                                                        \
        const int t = id >> 3, i0 = (id & 7) * 8;                                                             \
        const u16* rp = proj + (size_t)(row0 + min((CB) + t, T - 1)) * NPJ + h * 64 + i0;                     \
        Rq[it] = *(const uint4*)rp;                                                                           \
        Rk[it] = *(const uint4*)(rp + 256);                                                                   \
      }                                                                                                       \
      { const int t = (tid & 127) >> 1, hf = tid & 1;                                                         \
        Ral = *(const uint4*)(proj + (size_t)(row0 + min((CB) + t, T - 1)) * NPJ + 1536 + hf * 8); }          \
    }                                                                                                         \
    if (BR == 2) {                                                                                            \
      const int t = tid >> 2, i0 = (tid & 3) * 8;                                                             \
      const u16* rp = proj + (size_t)(row0 + min((CB) + t, T - 1)) * NPJ + 2840 + h * 64 + i0;                \
      Rq1 = *(const uint4*)rp; Rq2 = *(const uint4*)(rp + 32);                                                \
      Rk1 = *(const uint4*)(rp + 256); Rk2 = *(const uint4*)(rp + 288);                                       \
    }                                                                                                         \
    if (BR == 1) {                                                                                            \
      if (act) {                                                                                              \
        _Pragma("unroll") for (int k = 0; k < 11; ++k) {                                                      \
          int tau = (CB) + ts * 8 - 3 + k;                                                                    \
          tau = min(max(tau, 0), T - 1);                                                                      \
          Rx[k] = *(const uint4*)(proj + (size_t)(row0 + tau) * NPJ + 2064 + chan);                           \
        }                                                                                                     \
      }                                                                                                       \
      if (w == 0) dtraw = bf2f(proj[(size_t)(row0 + min((CB) + lane, T - 1)) * NPJ + 2832 + h]);              \
    }                                                                                                         \
  }
  REC_LOAD(0, Rg)

  for (int c0 = 0; c0 < T; c0 += 64) {
    const int nvalid = min(64, T - c0);
    if (BR == 0 || BR == 2) {
      const int voff_ = (BR == 0 ? 512 : 3352) + h * 128;
#pragma unroll
      for (int it = 0; it < 4; ++it) {
        const int id = tid + 256 * it;
        const int t = id >> 4, j0 = (id & 15) * 8;
        Rv[it] = *(const uint4*)(proj + (size_t)(row0 + min(c0 + t, T - 1)) * NPJ + voff_ + j0);
      }
    }
    if (BR == 0) {
      if (tid < 128) {
        const int t = tid >> 1, hf = tid & 1;
        float a8[8];
        unpack8(Ral, a8);
        *(float4*)(AL + t * 16 + hf * 8) = make_float4(a8[0], a8[1], a8[2], a8[3]);
        *(float4*)(AL + t * 16 + hf * 8 + 4) = make_float4(a8[4], a8[5], a8[6], a8[7]);
      }
      __syncthreads();
      {
        float run = 0.f;
#pragma unroll 4
        for (int tt = 0; tt < 16; ++tt) {
          const int t = part * 16 + tt;
          const float4 x0 = *(const float4*)(AL + t * 16), x1 = *(const float4*)(AL + t * 16 + 4);
          const float4 x2 = *(const float4*)(AL + t * 16 + 8), x3 = *(const float4*)(AL + t * 16 + 12);
          float a = bias;
          a += x0.x * w2r[0] + x0.y * w2r[1] + x0.z * w2r[2] + x0.w * w2r[3];
          a += x1.x * w2r[4] + x1.y * w2r[5] + x1.z * w2r[6] + x1.w * w2r[7];
          a += x2.x * w2r[8] + x2.y * w2r[9] + x2.z * w2r[10] + x2.w * w2r[11];
          a += x3.x * w2r[12] + x3.y * w2r[13] + x3.z * w2r[14] + x3.w * w2r[15];
          float g = (fminf(a, 0.f) - __logf(1.f + __expf(-fabsf(a)))) * (1.f / 16.f);
          if (t >= nvalid) g = 0.f;
          run += g;
          Gl[t * 64 + ci] = run;
        }
        psum[part * 64 + ci] = run;
      }
      __syncthreads();
      {
        float off = 0.f;
        for (int p = 0; p < part; ++p) off += psum[p * 64 + ci];
#pragma unroll 4
        for (int tt = 0; tt < 16; ++tt) Gl[(part * 16 + tt) * 64 + ci] += off;
      }
      __syncthreads();
#pragma unroll
      for (int it = 0; it < 2; ++it) {
        const int id = tid + 256 * it;
        const int t = id >> 3, i0 = (id & 7) * 8;
        const bool valid = t < nvalid;
        float qf[8], kf[8], G[8], Ge[8], qa[8], kb[8];
        unpack8(Rq[it], qf); unpack8(Rk[it], kf);
        *(float4*)&G[0] = *(const float4*)(Gl + t * 64 + i0);
        *(float4*)&G[4] = *(const float4*)(Gl + t * 64 + i0 + 4);
        *(float4*)&Ge[0] = *(const float4*)(Gl + 63 * 64 + i0);
        *(float4*)&Ge[4] = *(const float4*)(Gl + 63 * 64 + i0 + 4);
#pragma unroll
        for (int e = 0; e < 8; ++e) {
          const float qv = valid ? qf[e] : 0.f, kv = valid ? kf[e] : 0.f;
          const float eg = __expf(G[e]);
          const float ig = __builtin_amdgcn_rcpf(eg);
          Ge[e] = __expf(Ge[e]);
          qa[e] = qv * 0.125f * eg;
          kb[e] = kv * ig;
          KT[tsw(i0 + e, t)] = (u16)f2bf(kv * (Ge[e] * ig));
        }
        *(uint4*)(QA + t * LDT + i0) = pack8(qa);
        *(uint4*)(KB + t * LDT + i0) = pack8(kb);
        if (t == 63) {
#pragma unroll
          for (int e = 0; e < 8; ++e) dec[i0 + e] = Ge[e];
        }
        __builtin_amdgcn_sched_barrier(0);
      }
#pragma unroll
      for (int it = 0; it < 4; ++it) {
        const int id = tid + 256 * it;
        const int t = id >> 4, j0 = (id & 15) * 8;
        uint4 v4 = Rv[it];
        if (t >= nvalid) v4 = make_uint4(0, 0, 0, 0);
        VT[tsw(j0 + 0, t)] = (u16)(v4.x & 0xffffu); VT[tsw(j0 + 1, t)] = (u16)(v4.x >> 16);
        VT[tsw(j0 + 2, t)] = (u16)(v4.y & 0xffffu); VT[tsw(j0 + 3, t)] = (u16)(v4.y >> 16);
        VT[tsw(j0 + 4, t)] = (u16)(v4.z & 0xffffu); VT[tsw(j0 + 5, t)] = (u16)(v4.z >> 16);
        VT[tsw(j0 + 6, t)] = (u16)(v4.w & 0xffffu); VT[tsw(j0 + 7, t)] = (u16)(v4.w >> 16);
      }
      if (tid < 64) Gsc[tid] = 0.f;
    }
    if (BR == 2) {
      {
        const int t = tid >> 2, i0 = (tid & 3) * 8;
        const bool valid = t < nvalid;
        float q1f[8], q2f[8], k1f[8], k2f[8], o1[8], o2[8], p1[8], p2[8];
        unpack8(Rq1, q1f); unpack8(Rq2, q2f); unpack8(Rk1, k1f); unpack8(Rk2, k2f);
        const float pos = (float)(pos0 + c0 + t);
        const float ed = __expf(lg * (float)(nvalid - min(t + 1, nvalid)));
#pragma unroll
        for (int e = 0; e < 8; ++e) {
          const float ang = pos * invf[i0 + e];
          const float nrev = rintf(ang * 0.15915493667125702f);
          const float rf = fmaf(ang, 6.4206382432985265e-09f, fmaf(ang, 0.15915493667125702f, -nrev));
          const float sn = __builtin_amdgcn_sinf(rf), cs = __builtin_amdgcn_cosf(rf);
          const float a1 = valid ? q1f[e] : 0.f, a2 = valid ? q2f[e] : 0.f;
          const float b1 = valid ? k1f[e] : 0.f, b2 = valid ? k2f[e] : 0.f;
          o1[e] = a1 * cs - a2 * sn;
          o2[e] = a1 * sn + a2 * cs;
          p1[e] = (b1 * cs - b2 * sn) * 0.125f;
          p2[e] = (b1 * sn + b2 * cs) * 0.125f;
          KT[tsw(i0 + e, t)] = (u16)f2bf(p1[e] * ed);
          KT[tsw(32 + i0 + e, t)] = (u16)f2bf(p2[e] * ed);
        }
        *(uint4*)(QA + t * LDT + i0) = pack8(o1);
        *(uint4*)(QA + t * LDT + 32 + i0) = pack8(o2);
        *(uint4*)(KB + t * LDT + i0) = pack8(p1);
        *(uint4*)(KB + t * LDT + 32 + i0) = pack8(p2);
      }
#pragma unroll
      for (int it = 0; it < 4; ++it) {
        const int id = tid + 256 * it;
        const int t = id >> 4, j0 = (id & 15) * 8;
        uint4 v4 = Rv[it];
        if (t >= nvalid) v4 = make_uint4(0, 0, 0, 0);
        VT[tsw(j0 + 0, t)] = (u16)(v4.x & 0xffffu); VT[tsw(j0 + 1, t)] = (u16)(v4.x >> 16);
        VT[tsw(j0 + 2, t)] = (u16)(v4.y & 0xffffu); VT[tsw(j0 + 3, t)] = (u16)(v4.y >> 16);
        VT[tsw(j0 + 4, t)] = (u16)(v4.z & 0xffffu); VT[tsw(j0 + 5, t)] = (u16)(v4.z >> 16);
        VT[tsw(j0 + 6, t)] = (u16)(v4.w & 0xffffu); VT[tsw(j0 + 7, t)] = (u16)(v4.w >> 16);
      }
      if (tid < 64) {
        Gsc[tid] = lg * (float)min(tid + 1, nvalid);
        dec[tid] = __expf(lg * (float)nvalid);
      }
    }
    if (BR == 1) {
      if (w == 0) {
        float dt = 0.f, g = 0.f;
        if (lane < nvalid) {
          dt = softplus_f(dtraw + dtb);
          g = dt * aneg;
        }
        float x = g;
#pragma unroll
        for (int o = 1; o < 64; o <<= 1) {
          float y = __shfl_up(x, o);
          if (lane >= o) x += y;
        }
        const float ge = __shfl(x, 63);
        Gsc[lane] = x; dtv[lane] = dt; dec[lane] = __expf(ge); psum[lane] = __expf(ge - x);
      }
      __syncthreads();
      if (act) {
        const bool first = (c0 == 0 && ts == 0);
        const float* cst = P.in[4] + (size_t)(l * 128 + b) * 3 * 768 + chan;
#pragma unroll
        for (int p = 0; p < 4; ++p) {
          float x0[11], x1[11];
#pragma unroll
          for (int k = 0; k < 11; ++k) {
            const unsigned wd = p == 0 ? Rx[k].x : (p == 1 ? Rx[k].y : (p == 2 ? Rx[k].z : Rx[k].w));
            x0[k] = __uint_as_float(wd << 16);
            x1[k] = __uint_as_float(wd & 0xffff0000u);
          }
          if (first) {
#pragma unroll
            for (int k = 0; k < 3; ++k) {
              const float2 sv = *(const float2*)(cst + k * 768 + 2 * p);
              x0[k] = sample ? sv.x : 0.f;
              x1[k] = sample ? sv.y : 0.f;
            }
          }
          float o0[8], o1[8];
#pragma unroll
          for (int tt = 0; tt < 8; ++tt) {
            const bool valid = (ts * 8 + tt) < nvalid;
            float a0 = cbv[2 * p], a1 = cbv[2 * p + 1];
#pragma unroll
            for (int i = 0; i < 4; ++i) { a0 += cwv[i][2 * p] * x0[tt + i]; a1 += cwv[i][2 * p + 1] * x1[tt + i]; }
            o0[tt] = valid ? silu_f(a0) : 0.f;
            o1[tt] = valid ? silu_f(a1) : 0.f;
          }
          u16* rowdst = seg == 0 ? XH : (seg == 1 ? KB : QA);
#pragma unroll
          for (int tt = 0; tt < 8; ++tt) *(unsigned*)(rowdst + (ts * 8 + tt) * LDT + c8 + 2 * p) = pack2(o0[tt], o1[tt]);
          if (seg < 2) {
            const float* sc = seg == 0 ? dtv : psum;
            u16* cdst = seg == 0 ? VT : KT;
            float c0v[8], c1v[8];
#pragma unroll
            for (int tt = 0; tt < 8; ++tt) { const float f = sc[ts * 8 + tt]; c0v[tt] = o0[tt] * f; c1v[tt] = o1[tt] * f; }
            *(uint4*)(cdst + tsw(c8 + 2 * p, ts * 8)) = pack8(c0v);
            *(uint4*)(cdst + tsw(c8 + 2 * p + 1, ts * 8)) = pack8(c1v);
          }
          __builtin_amdgcn_sched_barrier(0);
        }
      }
    }
    __syncthreads();
    if (c0 + 64 < T) { REC_LOAD(c0 + 64, RgN) }

#pragma unroll
    for (int nf = 0; nf < NFV; ++nf)
      *(uint2*)(ST + (nf * 16 + r) * LDT + 16 * w + q * 4) = make_uint2(pack2(S[nf][0], S[nf][1]), pack2(S[nf][2], S[nf][3]));

    bf16x8 aq[2];
    aq[0] = *(const bf16x8*)(QA + (16 * w + r) * LDT + q * 8);
    aq[1] = *(const bf16x8*)(QA + (16 * w + r) * LDT + 32 + q * 8);
    float gt[4];
#pragma unroll
    for (int e = 0; e < 4; ++e) gt[e] = Gsc[16 * w + q * 4 + e];
#pragma unroll
    for (int n = 0; n < 4; ++n) {
      f32x4 a = (f32x4){0.f, 0.f, 0.f, 0.f};
      if (n <= w) {
#pragma unroll
        for (int kk = 0; kk < 2; ++kk) {
          bf16x8 bk = *(const bf16x8*)(KB + (16 * n + r) * LDT + kk * 32 + q * 8);
          a = __builtin_amdgcn_mfma_f32_16x16x32_bf16(aq[kk], bk, a, 0, 0, 0);
        }
      }
      const int s = 16 * n + r;
      const float gs = Gsc[s];
#pragma unroll
      for (int e = 0; e < 4; ++e) {
        const int t = 16 * w + q * 4 + e;
        float v = (s <= t) ? a[e] * __expf(gt[e] - gs) : 0.f;
        ATT[t * LDT + s] = (u16)f2bf(v);
      }
    }
    __syncthreads();

    f32x4 O[NFV];
#pragma unroll
    for (int nf = 0; nf < NFV; ++nf) O[nf] = (f32x4){0.f, 0.f, 0.f, 0.f};
#pragma unroll
    for (int kk = 0; kk < 2; ++kk)
#pragma unroll
      for (int nf = 0; nf < NFV; ++nf) {
        bf16x8 bs = *(const bf16x8*)(ST + (nf * 16 + r) * LDT + kk * 32 + q * 8);
        O[nf] = __builtin_amdgcn_mfma_f32_16x16x32_bf16(aq[kk], bs, O[nf], 0, 0, 0);
      }
    if (BR != 0) {
#pragma unroll
      for (int e = 0; e < 4; ++e) {
        const float sc = __expf(gt[e]);
#pragma unroll
        for (int nf = 0; nf < NFV; ++nf) O[nf][e] *= sc;
      }
    }
    {
      float dc[4];
#pragma unroll
      for (int e = 0; e < 4; ++e) dc[e] = dec[16 * w + q * 4 + e];
#pragma unroll
      for (int nf = 0; nf < NFV; ++nf)
#pragma unroll
        for (int e = 0; e < 4; ++e) S[nf][e] *= dc[e];
    }
    int vtb[2], ktb[2];
    vtb[0] = r * LDT + ((q ^ (r >> 3)) << 3);
    vtb[1] = r * LDT + ((q ^ (2 + (r >> 3))) << 3);
    ktb[0] = tsw(16 * w + r, q * 8);
    ktb[1] = tsw(16 * w + r, 32 + q * 8);
#pragma unroll
    for (int kk = 0; kk < 2; ++kk) {
      bf16x8 at = *(const bf16x8*)(ATT + (16 * w + r) * LDT + kk * 32 + q * 8);
      bf16x8 ak = *(const bf16x8*)(KT + ktb[kk]);
#pragma unroll
      for (int nf = 0; nf < NFV; ++nf) {
        bf16x8 bv = *(const bf16x8*)(VT + vtb[nf & 1] + nf * 16 * LDT + ((kk ^ ((nf >> 1) & 1)) * 32));
        O[nf] = __builtin_amdgcn_mfma_f32_16x16x32_bf16(at, bv, O[nf], 0, 0, 0);
        S[nf] = __builtin_amdgcn_mfma_f32_16x16x32_bf16(ak, bv, S[nf], 0, 0, 0);
      }
    }
    __syncthreads();
#pragma unroll
    for (int nf = 0; nf < NFV; ++nf)
#pragma unroll
      for (int e = 0; e < 4; ++e) OST[(16 * w + q * 4 + e) * OLD + nf * 16 + r] = O[nf][e];
    __syncthreads();

#pragma unroll
    for (int it = 0; it < NEP; ++it) {
      const int id = tid + 256 * it;
      const int t = (DV == 128) ? (id >> 4) : (id >> 3);
      const int j0 = (DV == 128) ? (id & 15) * 8 : (id & 7) * 8;
      const bool valid = t < nvalid;
      const size_t row = (size_t)(row0 + c0 + t);
      float ov[8], gv[8], y[8];
      *(float4*)&ov[0] = *(const float4*)(OST + t * OLD + j0);
      *(float4*)&ov[4] = *(const float4*)(OST + t * OLD + j0 + 4);
      unpack8(Rg[it], gv);
      if (BR == 1) {
        float xh[8];
        unpack8(*(const uint4*)(XH + t * LDT + j0), xh);
        float ss = 0.f;
#pragma unroll
        for (int e = 0; e < 8; ++e) { y[e] = (ov[e] + dsk * xh[e]) * silu_rcp(gv[e]); ss += y[e] * y[e]; }
        ss += __shfl_xor(ss, 1); ss += __shfl_xor(ss, 2); ss += __shfl_xor(ss, 4);
        if (valid) {
          *(uint4*)(ybr + row * LDY + h * 64 + j0) = pack8(y);
          if ((tid & 7) == 0) ssq[row * 8 + h] = ss;
        }
      } else {
        float ss = 0.f;
#pragma unroll
        for (int e = 0; e < 8; ++e) ss += ov[e] * ov[e];
        ss += __shfl_xor(ss, 1); ss += __shfl_xor(ss, 2); ss += __shfl_xor(ss, 4); ss += __shfl_xor(ss, 8);
        const float rs = rsqrtf(ss * (1.f / 128.f) + 1e-6f);
        if (BR == 0) {
          const float* wn = P.in[12] + l * 128 + j0;
          const float4 w0 = *(const float4*)wn, w1 = *(const float4*)(wn + 4);
          const float wv[8] = {w0.x, w0.y, w0.z, w0.w, w1.x, w1.y, w1.z, w1.w};
#pragma unroll
          for (int e = 0; e < 8; ++e) y[e] = silu_rcp(gv[e]) * ov[e] * rs * wv[e];
        } else {
#pragma unroll
          for (int e = 0; e < 8; ++e) y[e] = silu_rcp(gv[e]) * ov[e] * rs;
        }
        if (valid) *(uint4*)(ybr + row * LDY + h * 128 + j0) = pack8(y);
      }
      __builtin_amdgcn_sched_barrier(0);
    }
#pragma unroll
    for (int it = 0; it < NEP; ++it) Rg[it] = RgN[it];
    __syncthreads();
  }
#undef REC_LOAD

  {
    float* so;
    if (sample) so = P.out + (BR == 0 ? O_SGS : (BR == 1 ? O_SSS : O_SRS)) + ((size_t)(l * 128 + b) * NH + h) * 64 * DV;
    else so = P.out + (BR == 0 ? O_SGP : (BR == 1 ? O_SSP : O_SRP)) + ((size_t)(l * 8 + b) * NH + h) * 64 * DV;
#pragma unroll
    for (int nf = 0; nf < NFV; ++nf)
#pragma unroll
      for (int e = 0; e < 4; ++e) so[(size_t)(16 * w + q * 4 + e) * DV + nf * 16 + r] = S[nf][e];
  }
}

#ifndef REC_ONLY
#define REC_ONLY -1
#endif
template <int BR>
__device__ __forceinline__ void rec_branch(const Params& P, int l, bool split, int wb, int nwb, int lb0, unsigned char* ldsb) {
  if (!(REC_ONLY < 0 || REC_ONLY == BR)) return;
  constexpr int NH = (BR == 1) ? 8 : 4;
  constexpr int nl = 8 * NH;
  const int end = nl + 128 * NH;
  int it, step;
  if (split) {
    const int bx = blockIdx.x;
    if (bx >= lb0 && bx < lb0 + nl) { it = bx - lb0; step = 1 << 20; }
    else if (bx >= 128) { it = nl + wb; step = nwb; }
    else { it = end; step = 1; }
  } else { it = blockIdx.x; step = gridDim.x; }
  for (; it < end; it += step) {
    const int sample = it >= nl;
    const int idx = sample ? it - nl : it;
    int ll = l;
    asm volatile("" : "+s"(ll));
    rec_item<BR>(P, ll, idx / NH, idx % NH, sample, ldsb);
  }
}

__device__ __forceinline__ void phase_rec(const Params& P, int l, unsigned char* ldsb) {
  const int G = gridDim.x;
  const u16* proj = (const u16*)(P.ws + WS_A);
  const bool split = (G >= 256);
  const int wb = split ? (int)blockIdx.x - 128 : (int)blockIdx.x;
  int nwb = split ? G - 128 : G;
  asm volatile("" : "+s"(nwb));
  if (wb >= 0) {
    for (int i = wb * 256 + otid(); i < (8 + 128) * 3 * 768; i += nwb * 256) {
      const bool pr = i < 8 * 3 * 768;
      const int j = pr ? i : i - 8 * 3 * 768;
      const int b = j / (3 * 768), rem = j - b * 3 * 768, rr = rem / 768, c = rem - rr * 768;
      const size_t row = pr ? (size_t)(b * TP + 2061 + rr) : (size_t)(MP + b * 4 + 1 + rr);
      const size_t oo = pr ? O_SCP + (size_t)l * 8 * 3 * 768 + j : O_SCS + (size_t)l * 128 * 3 * 768 + j;
      P.out[oo] = bf2f(proj[row * NPJ + 2064 + c]);
    }
  }
  rec_branch<0>(P, l, split, wb, nwb, 0, ldsb);
  rec_branch<1>(P, l, split, wb, nwb, 32, ldsb);
  rec_branch<2>(P, l, split, wb, nwb, 96, ldsb);
  if (wb >= 0) {
    __syncthreads();
    if (l == 0) {
      convert_layer(P, 0, ldsb, 1888, 4576, wb, nwb);
      convert_layer(P, 1, ldsb, 0, 2528, wb, nwb);
    } else {
      convert_layer(P, 1, ldsb, 2528, 4576, wb, nwb);
    }
    phase_gates(P, l, wb, nwb, ldsb);
  }
}


#define XB_TMO      128
#define XB_XCNT(j)  (256  + 64 * (j))
#define XB_XSUB(j)  (1280 + 64 * (j))
#define XB_XGEN(j)  (2304 + 64 * (j))
#define XB_TOP      3328
#define XB_TOPGEN   3392
#define XCD_BAR_WORDS 3456
#define XB_SPIN_CAP (1u << 22)
__device__ __forceinline__ unsigned xb_ld(unsigned* p) { return __hip_atomic_load(p, __ATOMIC_RELAXED, __HIP_MEMORY_SCOPE_AGENT); }
__device__ __forceinline__ unsigned xb_add(unsigned* p, unsigned v) { return __hip_atomic_fetch_add(p, v, __ATOMIC_RELAXED, __HIP_MEMORY_SCOPE_AGENT); }
__device__ __forceinline__ unsigned xb_xcc_id() { return (unsigned)__builtin_amdgcn_s_getreg((3 << 11) | 20) & 0xFu; }
#define XB_SPIN(cond, bar) do { unsigned _sp = 0; while (cond) { __builtin_amdgcn_s_sleep(1); \
    if ((++_sp & 255u) == 0u) { if (xb_ld(&(bar)[XB_TMO])) break; if (_sp > XB_SPIN_CAP) { atomicAdd(&(bar)[XB_TMO], 1u); break; } } } } while (0)
struct XcdBarrier { unsigned* bar; unsigned x; volatile LAS unsigned* st; };
__device__ __forceinline__ XcdBarrier xcd_barrier_post(unsigned* bar, volatile LAS unsigned* st) {
  XcdBarrier b; b.bar = bar; b.x = xb_xcc_id(); b.st = st;
  if (threadIdx.x == 0) (void)xb_add(&bar[XB_XCNT(b.x)], 1u);
  return b;
}
__device__ __forceinline__ void xcd_barrier_complete(unsigned* bar, unsigned x, unsigned& nloc, unsigned& nx) {
  const unsigned G = gridDim.x * gridDim.y * gridDim.z;
  unsigned sum, cnt, mine, sp = 0u;
  for (;;) {
    sum = 0u; cnt = 0u; mine = 0u;
#pragma unroll
    for (unsigned j = 0; j < 16; ++j) { const unsigned c = xb_ld(&bar[XB_XCNT(j)]); sum += c; cnt += (c > 0u) ? 1u : 0u; mine = (j == x) ? c : mine; }
    if (sum == G) break;
    __builtin_amdgcn_s_sleep(1);
    if ((++sp & 255u) == 0u) { if (xb_ld(&bar[XB_TMO])) break; if (sp > XB_SPIN_CAP) { atomicAdd(&bar[XB_TMO], 1u); break; } }
  }
  nloc = mine > 0u ? mine : 1u; nx = cnt > 0u ? cnt : 1u;
}
__device__ __forceinline__ void xcd_barrier(const XcdBarrier& b) {
  asm volatile("s_waitcnt vmcnt(0)" ::: "memory");
  __syncthreads();
  if (threadIdx.x == 0) {
    unsigned* bar = b.bar;
    __builtin_amdgcn_s_waitcnt(0);
    unsigned nloc = b.st[0], nx = b.st[1];
    if (nloc == 0u) { xcd_barrier_complete(bar, b.x, nloc, nx); b.st[0] = nloc; b.st[1] = nx; }
    const unsigned old = xb_add(&bar[XB_XSUB(b.x)], 1u);
    const unsigned gen = old / nloc;
    if (old + 1u == (gen + 1u) * nloc) {
      __builtin_amdgcn_fence(__ATOMIC_RELEASE, "agent");
      asm volatile("s_waitcnt vmcnt(0)" ::: "memory");
      const unsigned og = xb_add(&bar[XB_TOP], 1u);
      const unsigned tg = og / nx;
      if (og + 1u == (tg + 1u) * nx) xb_add(&bar[XB_TOPGEN], 1u);
      else XB_SPIN(xb_ld(&bar[XB_TOPGEN]) == tg, bar);
      __builtin_amdgcn_fence(__ATOMIC_ACQUIRE, "agent");
      xb_add(&bar[XB_XGEN(b.x)], 1u);
      asm volatile("s_waitcnt vmcnt(0)" ::: "memory");
    } else {
      XB_SPIN(xb_ld(&bar[XB_XGEN(b.x)]) == gen, bar);
      __builtin_amdgcn_fence(__ATOMIC_ACQUIRE, "agent");
      asm volatile("s_waitcnt vmcnt(0)" ::: "memory");
    }
  }
  __syncthreads();
}

__global__ void __launch_bounds__(256, 2) fwd_kernel(Params P, int ph_lo, int ph_hi) {
  extern __shared__ __attribute__((aligned(16))) unsigned char ldsb[];
  cg::grid_group grid = cg::this_grid();
  volatile LAS unsigned* xst = (volatile LAS unsigned*)(ldsb + 75904);
  if (threadIdx.x == 0) { xst[0] = 0u; xst[1] = 0u; xst[2] = 0u; xst[3] = 0u; }
  __syncthreads();
  XcdBarrier xb = xcd_barrier_post((unsigned*)(P.ws + WS_BAR), xst);
  if (ph_hi > 1000) grid.sync();
  for (int ph = ph_lo; ph < ph_hi; ++ph) {
    if (ph > ph_lo) xcd_barrier(xb);
    if (ph == 0) {
      if (PH_ON(0)) { convert_layer(P, 0, ldsb, 0, 1888, blockIdx.x, gridDim.x); ln_phase(P, 0, 0); }
      continue;
    }
    int phl = ph;
    asm volatile("" : "+s"(phl));
    const int l = (phl - 1) >> 3, s = (phl - 1) & 7;
    switch (s) {
      case 0: if (PH_ON(1)) { phase_proj(P, l, ldsb); if (DUP(1)) phase_proj(P, l, ldsb); } break;
      case 1: if (PH_ON(2)) { phase_rec(P, l, ldsb); if (DUP(2)) { __syncthreads(); phase_rec(P, l, ldsb); } } break;
      case 2: if (PH_ON(3)) { phase_merge(P, l, ldsb); if (DUP(3)) phase_merge(P, l, ldsb); } break;
      case 3: if (PH_ON(4)) { phase_resid(P, 0, l, ldsb); if (DUP(4)) phase_resid(P, 0, l, ldsb); } break;
      case 4: if (PH_ON(5)) { ln_phase(P, 1, l); if (DUP(5)) ln_phase(P, 1, l); } break;
      case 5: if (PH_ON(6)) { phase_ff1(P, l, ldsb); if (DUP(6)) phase_ff1(P, l, ldsb); } break;
      case 6: if (PH_ON(7)) { phase_resid(P, 1, l, ldsb); if (DUP(7)) phase_resid(P, 1, l, ldsb); } break;
      case 7:
        if (PH_ON(8)) { ln_phase(P, 2, l); }
        break;
    }
  }
}

extern "C" void kernel_launch(void* const* d_in, const int* in_sizes, int n_in, void* d_out, int out_size, void* d_ws,
                              size_t ws_size, hipStream_t stream) {
  static int grid_blocks = 0;
  if (grid_blocks == 0) {
    if (n_in != 31 || ws_size < WS_END || out_size != 44666880) {
      fprintf(stderr, "kernel_launch: unexpected problem (n_in %d, ws %zu, out %d)\n", n_in, ws_size, out_size);
      grid_blocks = -1;
      return;
    }
    int dev = 0, cus = 0, per_cu = 0;
    hipGetDevice(&dev);
    hipDeviceGetAttribute(&cus, hipDeviceAttributeMultiprocessorCount, dev);
    hipFuncSetAttribute((const void*)fwd_kernel, hipFuncAttributeMaxDynamicSharedMemorySize, LDS_BYTES);
    hipOccupancyMaxActiveBlocksPerMultiprocessor(&per_cu, (const void*)fwd_kernel, 256, LDS_BYTES);
    if (per_cu < 1) { fprintf(stderr, "kernel_launch: occupancy query says 0 blocks per CU\n"); grid_blocks = -1; return; }
    if (per_cu > 2) per_cu = 2;
    grid_blocks = cus * per_cu;
    grid_blocks -= grid_blocks % 8;
  }
  if (grid_blocks < 0) return;
  Params p{};
  for (int i = 0; i < 31; ++i) p.in[i] = (const float*)d_in[i];
  p.out = (float*)d_out;
  p.ws = (unsigned char*)d_ws;
  if (hipMemsetAsync((char*)d_ws + WS_BAR, 0, XCD_BAR_WORDS * 4, stream) != hipSuccess) { fprintf(stderr, "memset failed\n"); return; }
#if ONE_LAUNCH
  int lo = 0, hi = NPHASE;
  void* args[] = {&p, &lo, &hi};
  hipError_t e = hipLaunchCooperativeKernel((const void*)fwd_kernel, dim3(grid_blocks), dim3(256), args, LDS_BYTES, stream);
  if (e != hipSuccess) fprintf(stderr, "cooperative launch failed: %s (grid %d)\n", hipGetErrorString(e), grid_blocks);
#else
  for (int ph = 0; ph < NPHASE; ++ph) {
    hipLaunchKernelGGL(fwd_kernel, dim3(grid_blocks), dim3(256), LDS_BYTES, stream, p, ph, ph + 1);
  }
#endif
}
```

```cpp
#include <hip/hip_runtime.h>
#include <hip/hip_cooperative_groups.h>
#include <stdint.h>
#include <stdio.h>
namespace cg = cooperative_groups;

#ifndef ONE_LAUNCH
#define ONE_LAUNCH 1
#endif
#ifndef PHASE_ONLY
#define PHASE_ONLY -1
#endif
#define PH_ON(n) (PHASE_ONLY < 0 || PHASE_ONLY == (n))
#ifndef DUP_MASK
#define DUP_MASK 0
#endif
#define DUP(n) ((DUP_MASK >> (n)) & 1)

#define LAS __attribute__((address_space(3)))
typedef unsigned short u16;
typedef __attribute__((ext_vector_type(8))) short bf16x8;
typedef __attribute__((ext_vector_type(4))) float f32x4;

constexpr int D = 1024;
constexpr int TP = 2064;
constexpr int MP = 8 * TP;
constexpr int MS = 512;
constexpr int M = MP + MS;
constexpr int NPJ = 4376;
constexpr int LDT = 72;
constexpr float ALPHA = 1.4142135623730951f;
constexpr int NPHASE = 17;
constexpr int SPLIT_ROW0 = 128 * 128;

constexpr int LDA = 1088;
constexpr int LDY = 576;
constexpr int LDH = 4160;
constexpr size_t WS_WIN = 0;
constexpr size_t WS_WGATE = 9748480;
constexpr size_t WS_WOUT = 16433152;
constexpr size_t WS_WO = 19972096;
constexpr size_t WS_WFF1 = 22200320;
constexpr size_t WS_WFF2 = 31113216;
constexpr size_t WS_ACT = 39632896;
constexpr size_t WS_SSQ = 76677120;
constexpr size_t WS_A = 77221888;
constexpr size_t WS_B = 226215936;
constexpr size_t WS_BAR = 295946240;
constexpr size_t WS_W2 = WS_BAR + 16384;
constexpr size_t WS_G1X = WS_W2 + 22200320;
constexpr size_t WS_END = WS_G1X + 524288;
constexpr int G1_SPLIT = 16768;
constexpr size_t A_PRE = 37044224;

constexpr size_t O_YP = 0, O_YS = 16777216, O_SGP = 17301504, O_SGS = 17825792, O_SSP = 26214400, O_SSS = 26738688,
                 O_SCP = 35127296, O_SCS = 35164160, O_SRP = 35753984, O_SRS = 36278272;

constexpr int LDS_BYTES = 76032;

struct Params { const float* in[31]; float* out; unsigned char* ws; };

typedef __bf16 hw_bf16x2 __attribute__((ext_vector_type(2)));
typedef float hw_f32x2 __attribute__((ext_vector_type(2)));
__device__ __forceinline__ unsigned pack2(float a, float b) {
  hw_f32x2 v = {a, b};
  return __builtin_bit_cast(unsigned, __builtin_convertvector(v, hw_bf16x2));
}
__device__ __forceinline__ unsigned f2bf(float f) { return pack2(f, 0.f) & 0xffffu; }
__device__ __forceinline__ float bf2f(u16 h) { return __uint_as_float(((unsigned)h) << 16); }
__device__ __forceinline__ void unpack8(uint4 v, float (&f)[8]) {
  f[0] = __uint_as_float(v.x << 16); f[1] = __uint_as_float(v.x & 0xffff0000u);
  f[2] = __uint_as_float(v.y << 16); f[3] = __uint_as_float(v.y & 0xffff0000u);
  f[4] = __uint_as_float(v.z << 16); f[5] = __uint_as_float(v.z & 0xffff0000u);
  f[6] = __uint_as_float(v.w << 16); f[7] = __uint_as_float(v.w & 0xffff0000u);
}
__device__ __forceinline__ uint4 pack8(const float (&f)[8]) {
  return make_uint4(pack2(f[0], f[1]), pack2(f[2], f[3]), pack2(f[4], f[5]), pack2(f[6], f[7]));
}
__device__ __forceinline__ int tsw(int row, int col) { return row * LDT + (col ^ (((row >> 3) & 7) << 3)); }
__device__ __forceinline__ int otid() { int t = threadIdx.x; asm volatile("" : "+v"(t)); return t; }
__device__ __forceinline__ float silu_f(float x) { return x / (1.f + __expf(-x)); }
__device__ __forceinline__ float silu_rcp(float x) { return x * __builtin_amdgcn_rcpf(1.f + __expf(-x)); }
__device__ __forceinline__ float sigmoid_f(float x) { return __builtin_amdgcn_rcpf(1.f + __expf(-x)); }
__device__ __forceinline__ float softplus_f(float x) {
  const float e = __expf(-fabsf(x));
  const float l1p = e < 1e-3f ? e * (1.f - 0.5f * e) : __logf(1.f + e);
  return fmaxf(x, 0.f) + l1p;
}

__device__ __forceinline__ void conv_tile64(const float* __restrict__ src, int ld, int ldk, int ncol0, int nvalid, u16* __restrict__ dst,
                            int kt, int nt, const float* __restrict__ kscale, float* tile, int blocked_nkt = 0) {
  const int tid = otid();
  const int c = tid & 63, r4 = tid >> 6;
  const int n = nt * 64 + c;
  const bool ok = n < nvalid;
#pragma unroll
  for (int i = 0; i < 16; ++i) {
    int k = r4 + 4 * i;
    int kg = kt * 64 + k;
    float v = ok ? src[(size_t)kg * ld + ncol0 + n] : 0.f;
    if (kscale) v *= kscale[kg];
    tile[k * 65 + c] = v;
  }
  __syncthreads();
#pragma unroll
  for (int it = 0; it < 2; ++it) {
    int id = tid + 256 * it;
    int nn = id >> 3, kc = id & 7;
    unsigned w0 = pack2(tile[(kc * 8 + 0) * 65 + nn], tile[(kc * 8 + 1) * 65 + nn]);
    unsigned w1 = pack2(tile[(kc * 8 + 2) * 65 + nn], tile[(kc * 8 + 3) * 65 + nn]);
    unsigned w2 = pack2(tile[(kc * 8 + 4) * 65 + nn], tile[(kc * 8 + 5) * 65 + nn]);
    unsigned w3 = pack2(tile[(kc * 8 + 6) * 65 + nn], tile[(kc * 8 + 7) * 65 + nn]);
    const int n_ = nt * 64 + nn;
    const size_t di = blocked_nkt ? ((size_t)((n_ >> 7) * blocked_nkt + kt) * 8192 + (n_ & 127) * 64 + kc * 8)
                                  : ((size_t)n_ * ldk + kt * 64 + kc * 8);
    *(uint4*)(dst + di) = make_uint4(w0, w1, w2, w3);
  }
  __syncthreads();
}

__device__ __forceinline__ void convert_layer(const Params& P, int l, unsigned char* lds, int t_lo, int t_hi, int wb, int nwb) {
  float* tile = (float*)lds;
  unsigned char* ws = P.ws;
  const size_t wsel = (l == 0) ? 0 : WS_W2;
  for (int t = t_lo + wb; t < t_hi; t += nwb) {
    int idx = t;
    if (idx < 1120) {
      conv_tile64(P.in[9] + (size_t)l * 1024 * 7448, 7448, LDA, 0, NPJ, (u16*)(ws + wsel + WS_WIN), idx % 16, idx / 16, nullptr, tile);
      continue;
    }
    idx -= 1120;
    if (idx < 768) {
      conv_tile64(P.in[9] + (size_t)l * 1024 * 7448, 7448, LDA, NPJ, 3072, (u16*)(ws + wsel + WS_WGATE), idx % 16, idx / 16, nullptr, tile);
      continue;
    }
    idx -= 768;
    if (idx < 384) {
      int br = idx / 128, r = idx % 128;
      conv_tile64(P.in[19 + br] + (size_t)l * 512 * 1024, 1024, LDY, 0, 1024, (u16*)(ws + wsel + WS_WOUT) + (size_t)br * 1024 * LDY,
                  r % 8, r / 8, br == 1 ? P.in[18] + l * 512 : nullptr, tile);
      continue;
    }
    idx -= 384;
    if (idx < 256) {
      conv_tile64(P.in[22] + (size_t)l * 1024 * 1024, 1024, LDA, 0, 1024, (u16*)(ws + wsel + WS_WO), idx % 16, idx / 16, nullptr, tile);
      continue;
    }
    idx -= 256;
    if (idx < 1024) {
      conv_tile64(P.in[25] + (size_t)l * 1024 * 4096, 4096, LDA, 0, 4096, (u16*)(ws + WS_WFF1), idx % 16, idx / 16, nullptr, tile);
      continue;
    }
    idx -= 1024;
    conv_tile64(P.in[27] + (size_t)l * 4096 * 1024, 1024, LDH, 0, 1024, (u16*)(ws + WS_WFF2), idx % 64, idx / 64, nullptr, tile, 64);
  }
}

__device__ __forceinline__ void ln_phase(const Params& P, int mode, int l) {
  const int tid_ = otid();
  const int lane = tid_ & 63;
  const int gw = blockIdx.x * 4 + (tid_ >> 6);
  const int nw = gridDim.x * 4;
  const float* wv = mode == 0 ? P.in[7] : (mode == 1 ? P.in[23] + l * D : P.in[29] + l * D);
  const float* bv = mode == 0 ? P.in[8] : (mode == 1 ? P.in[24] + l * D : P.in[30] + l * D);
  u16* act = (u16*)(P.ws + WS_ACT);
  const bool final_out = (mode == 2 && l == 1);
  for (int row = gw; row < M; row += nw) {
    const float* s;
    int b = 0, t = 0;
    if (row < MP) { b = row / TP; t = row - b * TP; }
    if (mode == 0) {
      if (row < MP) s = (t < 16) ? P.in[6] + (size_t)t * D : P.in[0] + ((size_t)b * 2048 + (t - 16)) * D;
      else s = P.in[1] + (size_t)(row - MP) * D;
    } else if (mode == 1) {
      s = (const float*)(P.ws + WS_A + A_PRE) + (size_t)row * D;
    } else {
      s = (const float*)(P.ws + WS_B) + (size_t)row * D;
    }
    float4 v[4];
#pragma unroll
    for (int i = 0; i < 4; ++i) v[i] = *(const float4*)(s + i * 256 + lane * 4);
    float sum = 0.f;
#pragma unroll
    for (int i = 0; i < 4; ++i) sum += v[i].x + v[i].y + v[i].z + v[i].w;
#pragma unroll
    for (int o = 32; o >= 1; o >>= 1) sum += __shfl_xor(sum, o);
    const float mean = sum * (1.f / 1024.f);
    float sq = 0.f;
#pragma unroll
    for (int i = 0; i < 4; ++i) {
      v[i].x -= mean; v[i].y -= mean; v[i].z -= mean; v[i].w -= mean;
      sq += v[i].x * v[i].x + v[i].y * v[i].y + v[i].z * v[i].z + v[i].w * v[i].w;
    }
#pragma unroll
    for (int o = 32; o >= 1; o >>= 1) sq += __shfl_xor(sq, o);
    const float rstd = rsqrtf(sq * (1.f / 1024.f) + 1e-5f);
    float* od = nullptr;
    if (final_out) {
      if (row < MP) { if (t >= 16) od = P.out + O_YP + ((size_t)b * 2048 + (t - 16)) * D; }
      else od = P.out + O_YS + (size_t)(row - MP) * D;
    }
#pragma unroll
    for (int i = 0; i < 4; ++i) {
      const int c = i * 256 + lane * 4;
      float4 w4 = *(const float4*)(wv + c), b4 = *(const float4*)(bv + c);
      float y0 = v[i].x * rstd * w4.x + b4.x, y1 = v[i].y * rstd * w4.y + b4.y;
      float y2 = v[i].z * rstd * w4.z + b4.z, y3 = v[i].w * rstd * w4.w + b4.w;
      if (final_out) {
        if (od) *(float4*)(od + c) = make_float4(y0, y1, y2, y3);
      } else {
        const unsigned p0 = pack2(y0, y1), p1 = pack2(y2, y3);
        *(uint2*)(act + (size_t)row * LDA + c) = make_uint2(p0, p1);
        if (mode == 1 && row >= SPLIT_ROW0) {
          const float4 bb = *(const float4*)(P.in[28] + l * D + c);
          float* pz = (float*)(P.ws + WS_B) + (size_t)row * D + c;
          *(float4*)pz = make_float4(ALPHA * __uint_as_float(p0 << 16) + bb.x, ALPHA * __uint_as_float(p0 & 0xffff0000u) + bb.y,
                                     ALPHA * __uint_as_float(p1 << 16) + bb.z, ALPHA * __uint_as_float(p1 & 0xffff0000u) + bb.w);
        }
      }
    }
  }
}

#define G_LOAD4(R, k0)                                                                    \
  R##a0 = *(const uint4*)(ap + (k0)); R##a1 = *(const uint4*)(ap + sa + (k0));            \
  R##a2 = *(const uint4*)(ap + 2 * sa + (k0)); R##a3 = *(const uint4*)(ap + 3 * sa + (k0)); \
  R##b0 = *(const uint4*)(bp + (k0)); R##b1 = *(const uint4*)(bp + sb + (k0));
#define G_LOADB(R, k0)                                                                    \
  R##b2 = *(const uint4*)(bp + 2 * sb + (k0)); R##b3 = *(const uint4*)(bp + 3 * sb + (k0));
#define L_STORE4(R, buf)                                                                  \
  { u16* ad = As + (buf) * 128 * LDT + crow * LDT + cck;                                  \
    u16* bd = Bs + (buf) * BN * LDT + crow * LDT + cck;                                   \
    *(uint4*)(ad) = R##a0; *(uint4*)(ad + 32 * LDT) = R##a1; *(uint4*)(ad + 64 * LDT) = R##a2; *(uint4*)(ad + 96 * LDT) = R##a3; \
    *(uint4*)(bd) = R##b0; *(uint4*)(bd + 32 * LDT) = R##b1;                              \
    if (NF == 4) { *(uint4*)(bd + 64 * LDT) = R##b2; *(uint4*)(bd + 96 * LDT) = R##b3; } }
#define MMA_TILE(buf)                                                                     \
  { const u16* as = As + (buf) * 128 * LDT + (wm * 64 + r) * LDT + q * 8;                 \
    const u16* bs = Bs + (buf) * BN * LDT + (wn * NF * 16 + r) * LDT + q * 8;             \
    _Pragma("unroll") for (int kk = 0; kk < 2; ++kk) {                                    \
      bf16x8 af[4], bfr[NF];                                                              \
      _Pragma("unroll") for (int mf = 0; mf < 4; ++mf) af[mf] = *(const bf16x8*)(as + mf * 16 * LDT + kk * 32); \
      _Pragma("unroll") for (int nf = 0; nf < NF; ++nf) bfr[nf] = *(const bf16x8*)(bs + nf * 16 * LDT + kk * 32); \
      _Pragma("unroll") for (int mf = 0; mf < 4; ++mf)                                    \
        _Pragma("unroll") for (int nf = 0; nf < NF; ++nf)                                 \
          acc[mf][nf] = __builtin_amdgcn_mfma_f32_16x16x32_bf16(af[mf], bfr[nf], acc[mf][nf], 0, 0, 0); \
    } }

__device__ __forceinline__ int lds_byte(int r, int c) {
  int st = (r >> 4) * 2 + (c >> 5), rr = r & 15, cc = c & 31, ob = rr * 64 + cc * 2;
  return st * 1024 + (ob ^ (((ob >> 9) & 1) << 5));
}
__device__ __forceinline__ void stage_rc(int b, int& R, int& C) {
  int st = b >> 10, sb = b & 1023, swz = sb ^ (((sb >> 9) & 1) << 5);
  R = (st >> 1) * 16 + (swz >> 6);
  C = (st & 1) * 32 + ((swz & 63) >> 1);
}

template <int NF>
__device__ __forceinline__ void gemm_core(f32x4 (&acc)[4][NF], const u16* __restrict__ A, int lda,
                                          const u16* __restrict__ B, int ldb, int K, u16* lds, int kadv = 64) {
  constexpr int BN = 32 * NF;
  constexpr int ABYTES = 128 * 64 * 2;
  constexpr int BBYTES = BN * 64 * 2;
  constexpr int BUF = ABYTES + BBYTES;
  unsigned char* base = (unsigned char*)lds;
  const int tid = otid(), lane = tid & 63, w = tid >> 6, wm = w >> 1, wn = w & 1, r = lane & 15, q = lane >> 4;
  const u16* ga[4]; const u16* gb[NF];
#pragma unroll
  for (int i = 0; i < 4; ++i) { int R, C; stage_rc(tid * 16 + i * 4096, R, C); ga[i] = A + (size_t)R * lda + C; }
#pragma unroll
  for (int i = 0; i < NF; ++i) { int R, C; stage_rc(tid * 16 + i * 4096, R, C); gb[i] = B + (size_t)R * ldb + C; }
  int oa[4][2], ob[NF][2];
#pragma unroll
  for (int mf = 0; mf < 4; ++mf)
#pragma unroll
    for (int kk = 0; kk < 2; ++kk) oa[mf][kk] = lds_byte(wm * 64 + mf * 16 + r, kk * 32 + q * 8);
#pragma unroll
  for (int nf = 0; nf < NF; ++nf)
#pragma unroll
    for (int kk = 0; kk < 2; ++kk) ob[nf][kk] = lds_byte(wn * NF * 16 + nf * 16 + r, kk * 32 + q * 8);
#define STAGE_TILE(buf, k0)                                                                              \
  {                                                                                                      \
    _Pragma("unroll") for (int i = 0; i < 4; ++i)                                                        \
      __builtin_amdgcn_global_load_lds((const unsigned*)(ga[i] + (k0)),                                  \
        (LAS unsigned*)(base + (buf) * BUF + tid * 16 + i * 4096), 16, 0, 0);                            \
    _Pragma("unroll") for (int i = 0; i < NF; ++i)                                                       \
      __builtin_amdgcn_global_load_lds((const unsigned*)(gb[i] + (k0)),                                  \
        (LAS unsigned*)(base + (buf) * BUF + ABYTES + tid * 16 + i * 4096), 16, 0, 0);                   \
  }
  const int nk = K >> 6;
  STAGE_TILE(0, 0)
  asm volatile("s_waitcnt vmcnt(0)" ::: "memory");
  __syncthreads();
  for (int kt = 0; kt < nk; ++kt) {
    const int buf = kt & 1;
    if (kt + 1 < nk) STAGE_TILE(buf ^ 1, (size_t)(kt + 1) * kadv)
    const unsigned char* as = base + buf * BUF;
    const unsigned char* bs = as + ABYTES;
    bf16x8 af0[4], bf0[NF], af1[4], bf1[NF];
#pragma unroll
    for (int mf = 0; mf < 4; ++mf) af0[mf] = *(const bf16x8*)(as + oa[mf][0]);
#pragma unroll
    for (int nf = 0; nf < NF; ++nf) bf0[nf] = *(const bf16x8*)(bs + ob[nf][0]);
    __builtin_amdgcn_s_setprio(1);
#pragma unroll
    for (int nf = 0; nf < NF / 2; ++nf)
#pragma unroll
      for (int mf = 0; mf < 4; ++mf)
        acc[mf][nf] = __builtin_amdgcn_mfma_f32_16x16x32_bf16(af0[mf], bf0[nf], acc[mf][nf], 0, 0, 0);
    __builtin_amdgcn_s_setprio(0);
#pragma unroll
    for (int mf = 0; mf < 4; ++mf) af1[mf] = *(const bf16x8*)(as + oa[mf][1]);
#pragma unroll
    for (int nf = 0; nf < NF; ++nf) bf1[nf] = *(const bf16x8*)(bs + ob[nf][1]);
    __builtin_amdgcn_s_setprio(1);
#pragma unroll
    for (int nf = NF / 2; nf < NF; ++nf)
#pragma unroll
      for (int mf = 0; mf < 4; ++mf)
        acc[mf][nf] = __builtin_amdgcn_mfma_f32_16x16x32_bf16(af0[mf], bf0[nf], acc[mf][nf], 0, 0, 0);
#pragma unroll
    for (int nf = 0; nf < NF; ++nf)
#pragma unroll
      for (int mf = 0; mf < 4; ++mf)
        acc[mf][nf] = __builtin_amdgcn_mfma_f32_16x16x32_bf16(af1[mf], bf1[nf], acc[mf][nf], 0, 0, 0);
    __builtin_amdgcn_s_setprio(0);
    asm volatile("s_waitcnt vmcnt(0)" ::: "memory");
    __syncthreads();
  }
#undef STAGE_TILE
}

#define TILE_LOOP(total)                                                                      \
  const int _nx = (gridDim.x % 8 == 0) ? 8 : 1;                                              \
  const int _ns = gridDim.x / _nx;                                                           \
  const int _x = blockIdx.x % _nx, _s = blockIdx.x / _nx;                                    \
  const int _per = ((total) + _nx - 1) / _nx;                                                \
  const int _lo = _x * _per;                                                                 \
  const int _hi = min((total), _lo + _per);                                                  \
  for (int t = _lo + _s; t < _hi; t += _ns)

__device__ __forceinline__ void tile_decode(int t, int MT, int NT, int& mt, int& nt) {
  int g = t / (8 * NT), r = t - g * 8 * NT;
  int gs = min(8, MT - g * 8);
  mt = g * 8 + r % gs;
  nt = r / gs;
}

template <int NF>
__device__ __forceinline__ void zero_acc(f32x4 (&acc)[4][NF]) {
#pragma unroll
  for (int i = 0; i < 4; ++i)
#pragma unroll
    for (int j = 0; j < NF; ++j) acc[i][j] = (f32x4){0.f, 0.f, 0.f, 0.f};
}

__device__ __forceinline__ void phase_proj(const Params& P, int l, unsigned char* ldsb) {
  const u16* act = (const u16*)(P.ws + WS_ACT);
  const u16* W = (const u16*)(P.ws + (l == 0 ? 0 : WS_W2) + WS_WIN);
  u16* proj = (u16*)(P.ws + WS_A);
  constexpr int MT = 133, NT = 35;
  TILE_LOOP(MT * NT) {
    int mt, nt; tile_decode(t, MT, NT, mt, nt);
    const int tid_ = otid(), lane = tid_ & 63, w = tid_ >> 6, wm = w >> 1, wn = w & 1, r = lane & 15, q = lane >> 4;
    f32x4 acc[4][4]; zero_acc<4>(acc);
    gemm_core<4>(acc, act + (size_t)mt * 128 * LDA, LDA, W + (size_t)nt * 128 * LDA, LDA, D, (u16*)ldsb);
#pragma unroll
    for (int mf = 0; mf < 4; ++mf)
#pragma unroll
      for (int nf = 0; nf < 4; ++nf) {
        const int col = nt * 128 + wn * 64 + nf * 16 + r;
        if (col < NPJ) {
#pragma unroll
          for (int e = 0; e < 4; ++e) {
            const int row = mt * 128 + wm * 64 + mf * 16 + q * 4 + e;
            proj[(size_t)row * NPJ + col] = (u16)f2bf(acc[mf][nf][e]);
          }
        }
      }
  }
}

__device__ __forceinline__ u16* gate_row(const Params& P, int br, int row) {
  if (br == 0) return (u16*)P.out + (size_t)row * D;
  if (row < G1_SPLIT) return (u16*)P.out + (size_t)M * D + (size_t)row * D;
  return (u16*)(P.ws + WS_G1X) + (size_t)(row - G1_SPLIT) * D;
}

__device__ __forceinline__ void phase_gates(const Params& P, int l, int wb, int nwb, unsigned char* ldsb) {
  const u16* act = (const u16*)(P.ws + WS_ACT);
  const u16* Wg = (const u16*)(P.ws + (l == 0 ? 0 : WS_W2) + WS_WGATE);
  constexpr int MT = 133, NT = 8;
  for (int t = wb; t < 2 * MT * NT; t += nwb) {
    const int br = t / (MT * NT);
    int mt, nt; tile_decode(t - br * MT * NT, MT, NT, mt, nt);
    const int tid_ = otid(), lane = tid_ & 63, w = tid_ >> 6, wm = w >> 1, wn = w & 1, r = lane & 15, q = lane >> 4;
    f32x4 acc[4][4]; zero_acc<4>(acc);
    gemm_core<4>(acc, act + (size_t)mt * 128 * LDA, LDA, Wg + ((size_t)br * 1024 + nt * 128) * LDA, LDA, D, (u16*)ldsb);
#pragma unroll
    for (int mf = 0; mf < 4; ++mf)
#pragma unroll
      for (int e = 0; e < 4; ++e) {
        const int row = mt * 128 + wm * 64 + mf * 16 + q * 4 + e;
        u16* gr = gate_row(P, br, row);
#pragma unroll
        for (int nf = 0; nf < 4; ++nf) gr[nt * 128 + wn * 64 + nf * 16 + r] = (u16)f2bf(sigmoid_f(acc[mf][nf][e]));
      }
  }
}

__device__ __forceinline__ void phase_merge(const Params& P, int l, unsigned char* ldsb) {
  const u16* act = (const u16*)(P.ws + WS_ACT);
  const u16* Wg = (const u16*)(P.ws + (l == 0 ? 0 : WS_W2) + WS_WGATE);
  const u16* Wo = (const u16*)(P.ws + (l == 0 ? 0 : WS_W2) + WS_WOUT);
  const u16* ybr = (const u16*)(P.ws + WS_B);
  const float* ssq = (const float*)(P.ws + WS_SSQ);
  u16* merged = (u16*)(P.ws + WS_A);
  constexpr int MT = 133, NT = 16;
  {
    float* pre = (float*)(P.ws + WS_A + A_PRE);
    for (int i = blockIdx.x * 256 + otid(); i < (M - SPLIT_ROW0) * (D / 4); i += gridDim.x * 256) {
      const int row = SPLIT_ROW0 + i / (D / 4), c = (i % (D / 4)) * 4;
      const uint2 xv = *(const uint2*)(act + (size_t)row * LDA + c);
      *(float4*)(pre + (size_t)row * D + c) = make_float4(ALPHA * __uint_as_float(xv.x << 16), ALPHA * __uint_as_float(xv.x & 0xffff0000u),
                                                          ALPHA * __uint_as_float(xv.y << 16), ALPHA * __uint_as_float(xv.y & 0xffff0000u));
    }
  }
  TILE_LOOP(MT * NT) {
    int mt, nt; tile_decode(t, MT, NT, mt, nt);
    const int tid_ = otid(), lane = tid_ & 63, w = tid_ >> 6, wm = w >> 1, wn = w & 1, r = lane & 15, q = lane >> 4;
    f32x4 fin[4][2]; zero_acc<2>(fin);
#pragma unroll 1
    for (int br = 0; br < 3; ++br) {
      f32x4 g[4][2]; zero_acc<2>(g);
      if (br == 2) {
        gemm_core<2>(g, act + (size_t)mt * 128 * LDA, LDA, Wg + ((size_t)br * 1024 + nt * 64) * LDA, LDA, D, (u16*)ldsb);
#pragma unroll
        for (int mf = 0; mf < 4; ++mf)
#pragma unroll
          for (int nf = 0; nf < 2; ++nf)
#pragma unroll
            for (int e = 0; e < 4; ++e) g[mf][nf][e] = sigmoid_f(g[mf][nf][e]);
      } else {
#pragma unroll
        for (int mf = 0; mf < 4; ++mf)
#pragma unroll
          for (int e = 0; e < 4; ++e) {
            const u16* gr = gate_row(P, br, mt * 128 + wm * 64 + mf * 16 + q * 4 + e) + nt * 64 + wn * 32 + r;
#pragma unroll
            for (int nf = 0; nf < 2; ++nf) g[mf][nf][e] = bf2f(gr[nf * 16]);
          }
      }
      const u16* yb = ybr + (size_t)br * M * LDY + (size_t)mt * 128 * LDY;
      const u16* wb = Wo + (size_t)br * 1024 * LDY + (size_t)nt * 64 * LDY;
      if (br != 1) {
        f32x4 acc[4][2]; zero_acc<2>(acc);
        gemm_core<2>(acc, yb, LDY, wb, LDY, 512, (u16*)ldsb);
#pragma unroll
        for (int mf = 0; mf < 4; ++mf)
#pragma unroll
          for (int nf = 0; nf < 2; ++nf)
#pragma unroll
            for (int e = 0; e < 4; ++e) fin[mf][nf][e] += g[mf][nf][e] * acc[mf][nf][e];
      } else {
#pragma unroll 1
        for (int grp = 0; grp < 2; ++grp) {
          f32x4 acc[4][2]; zero_acc<2>(acc);
          gemm_core<2>(acc, yb + grp * 256, LDY, wb + grp * 256, LDY, 256, (u16*)ldsb);
#pragma unroll
          for (int mf = 0; mf < 4; ++mf)
#pragma unroll
            for (int e = 0; e < 4; ++e) {
              const int row = mt * 128 + wm * 64 + mf * 16 + q * 4 + e;
              float4 s4 = *(const float4*)(ssq + (size_t)row * 8 + grp * 4);
              float rs = rsqrtf((s4.x + s4.y + s4.z + s4.w) * (1.f / 256.f) + 1e-6f);
#pragma unroll
              for (int nf = 0; nf < 2; ++nf) fin[mf][nf][e] += g[mf][nf][e] * rs * acc[mf][nf][e];
            }
        }
      }
    }
#pragma unroll
    for (int mf = 0; mf < 4; ++mf)
#pragma unroll
      for (int nf = 0; nf < 2; ++nf)
#pragma unroll
        for (int e = 0; e < 4; ++e) {
          const int row = mt * 128 + wm * 64 + mf * 16 + q * 4 + e;
          const int col = nt * 64 + wn * 32 + nf * 16 + r;
          merged[(size_t)row * LDA + col] = (u16)f2bf(fin[mf][nf][e]);
        }
  }
}

__device__ __forceinline__ void phase_resid(const Params& P, int mode, int l, unsigned char* ldsb) {
  const u16* act = (const u16*)(P.ws + WS_ACT);
  const u16* A = (const u16*)(P.ws + WS_A);
  const int K = mode == 0 ? 1024 : 4096;
  const int ldk = mode == 0 ? LDA : LDH;
  const u16* W = (const u16*)(P.ws + (mode == 0 ? (l == 0 ? 0 : WS_W2) + WS_WO : WS_WFF2));
  float* dst = mode == 0 ? (float*)(P.ws + WS_A + A_PRE) : (float*)(P.ws + WS_B);
  const float* bias = P.in[28] + l * D;
  constexpr int MT = 128, NT = 8;
  TILE_LOOP(MT * NT) {
    int mt, nt; tile_decode(t, MT, NT, mt, nt);
    const int tid_ = otid(), lane = tid_ & 63, w = tid_ >> 6, wm = w >> 1, wn = w & 1, r = lane & 15, q = lane >> 4;
    f32x4 acc[4][4]; zero_acc<4>(acc);
    if (mode == 0) gemm_core<4>(acc, A + (size_t)mt * 128 * ldk, ldk, W + (size_t)nt * 128 * ldk, ldk, K, (u16*)ldsb);
    else gemm_core<4>(acc, A + (size_t)mt * 64 * 8192, 64, W + (size_t)nt * 64 * 8192, 64, K, (u16*)ldsb, 8192);
#pragma unroll
    for (int mf = 0; mf < 4; ++mf)
#pragma unroll
      for (int nf = 0; nf < 4; ++nf) {
        const int col = nt * 128 + wn * 64 + nf * 16 + r;
        const float bb = mode == 1 ? bias[col] : 0.f;
#pragma unroll
        for (int e = 0; e < 4; ++e) {
          const int row = mt * 128 + wm * 64 + mf * 16 + q * 4 + e;
          dst[(size_t)row * D + col] = ALPHA * bf2f(act[(size_t)row * LDA + col]) + acc[mf][nf][e] + bb;
        }
      }
  }
  {
    constexpr int S = 8;
    const int KS = K / S;
    for (int li = blockIdx.x; li < 40 * S; li += gridDim.x) {
      const int sl = li % S, tl = li / S;
      const int mt = 128 + tl / 8, nt = tl % 8;
      const int tid_ = otid(), lane = tid_ & 63, w = tid_ >> 6, wm = w >> 1, wn = w & 1, r = lane & 15, q = lane >> 4;
      f32x4 acc[4][4]; zero_acc<4>(acc);
      if (mode == 0) gemm_core<4>(acc, A + (size_t)mt * 128 * ldk + sl * KS, ldk, W + (size_t)nt * 128 * ldk + sl * KS, ldk, KS, (u16*)ldsb);
      else gemm_core<4>(acc, A + ((size_t)mt * 64 + sl * (KS / 64)) * 8192, 64, W + ((size_t)nt * 64 + sl * (KS / 64)) * 8192, 64, KS, (u16*)ldsb, 8192);
#pragma unroll
      for (int mf = 0; mf < 4; ++mf)
#pragma unroll
        for (int nf = 0; nf < 4; ++nf) {
          const int col = nt * 128 + wn * 64 + nf * 16 + r;
#pragma unroll
          for (int e = 0; e < 4; ++e) {
            const int row = mt * 128 + wm * 64 + mf * 16 + q * 4 + e;
            (void)__hip_atomic_fetch_add(dst + (size_t)row * D + col, acc[mf][nf][e], __ATOMIC_RELAXED, __HIP_MEMORY_SCOPE_AGENT);
          }
        }
    }
  }
}

__device__ __forceinline__ void phase_ff1(const Params& P, int l, unsigned char* ldsb) {
  const u16* act = (const u16*)(P.ws + WS_ACT);
  const u16* W = (const u16*)(P.ws + WS_WFF1);
  u16* hid = (u16*)(P.ws + WS_A);
  const float* bias = P.in[26] + l * 4096;
  constexpr int MT = 133, NT = 32;
  TILE_LOOP(MT * NT) {
    int mt, nt; tile_decode(t, MT, NT, mt, nt);
    const int tid_ = otid(), lane = tid_ & 63, w = tid_ >> 6, wm = w >> 1, wn = w & 1, r = lane & 15, q = lane >> 4;
    f32x4 acc[4][4]; zero_acc<4>(acc);
    gemm_core<4>(acc, act + (size_t)mt * 128 * LDA, LDA, W + (size_t)nt * 128 * LDA, LDA, D, (u16*)ldsb);
#pragma unroll
    for (int mf = 0; mf < 4; ++mf)
#pragma unroll
      for (int nf = 0; nf < 4; ++nf) {
        const int col = nt * 128 + wn * 64 + nf * 16 + r;
        const float bb = bias[col];
#pragma unroll
        for (int e = 0; e < 4; ++e) {
          const int row = mt * 128 + wm * 64 + mf * 16 + q * 4 + e;
          float v = fmaxf(acc[mf][nf][e] + bb, 0.f);
          hid[((size_t)(row >> 7) * 64 + (col >> 6)) * 8192 + (row & 127) * 64 + (col & 63)] = (u16)f2bf(v * v);
        }
      }
  }
}

template <int BR>
__device__ __forceinline__ void rec_item(const Params& P, int l, int b, int h, int sample, unsigned char* ldsb) {
  constexpr int DV = (BR == 1) ? 64 : 128;
  constexpr int NFV = DV / 16;
  constexpr int NH = (BR == 1) ? 8 : 4;
  constexpr int OLD = DV + 4;
  constexpr int NEP = DV / 32;
  u16* QA = (u16*)ldsb;
  u16* KB = QA + 64 * LDT;
  u16* KT = KB + 64 * LDT;
  u16* ATT = KT + 64 * LDT;
  u16* VT = ATT + 64 * LDT;
  u16* ST = VT + 128 * LDT;
  float* Gsc = (float*)(ST + 128 * LDT);
  float* dec = Gsc + 64;
  float* dtv = dec + 64;
  float* psum = dtv + 64;
  float* invf = psum + 256;
  float* Gl = (float*)ST;
  float* AL = (float*)ATT;
  float* OST = (float*)ldsb;
  u16* XH = VT + 64 * LDT;

  const int tid = otid(), lane = tid & 63, w = tid >> 6, r = lane & 15, q = lane >> 4;
  const int T = sample ? 4 : TP;
  const int row0 = sample ? MP + b * 4 : b * TP;
  const int pos0 = sample ? 16384 : 0;
  const u16* proj = (const u16*)(P.ws + WS_A);
  u16* ybr = (u16*)(P.ws + WS_B) + (size_t)BR * M * LDY;
  float* ssq = (float*)(P.ws + WS_SSQ);

  float lg = 0.f, aneg = 0.f, dtb = 0.f, dsk = 0.f;
  if (BR == 2) {
    lg = log1pf(-exp2f(-5.f - (float)h));
    if (tid < 32) invf[tid] = exp2f(-(float)tid * (13.287712379549449f / 32.0f));
  }
  if (BR == 1) {
    aneg = -__expf(P.in[16][l * 8 + h]);
    dtb = P.in[15][l * 8 + h];
    dsk = P.in[17][l * 8 + h];
  }
  const int grp = h >> 2;

  f32x4 S[NFV];
  {
    const float* sin_ = P.in[2];
    if (sample) {
      const float* base = BR == 0 ? P.in[2] : (BR == 1 ? P.in[3] : P.in[5]);
      sin_ = base + ((size_t)(l * 128 + b) * NH + h) * 64 * DV;
    }
#pragma unroll
    for (int nf = 0; nf < NFV; ++nf)
#pragma unroll
      for (int e = 0; e < 4; ++e) {
        float v = sin_[(size_t)(16 * w + q * 4 + e) * DV + nf * 16 + r];
        S[nf][e] = sample ? v : 0.f;
      }
  }
  __syncthreads();

  uint4 Rg[NEP], RgN[NEP];
  uint4 Rq[2], Rk[2], Rv[4], Ral;
  uint4 Rq1, Rq2, Rk1, Rk2;
  uint4 Rx[11];
  float dtraw = 0.f;
  const int ci = tid & 63, part = tid >> 6;
  float w2r[16];
  float bias = 0.f;
  if (BR == 0) {
#pragma unroll
    for (int rr = 0; rr < 16; ++rr) w2r[rr] = P.in[10][(size_t)(l * 16 + rr) * 256 + h * 64 + ci];
    bias = P.in[11][l * 256 + h * 64 + ci];
  }
  const int cc = tid >> 3, ts = tid & 7;
  const bool act = tid < 192;
  const int seg = cc >> 3, c8 = (cc & 7) * 8;
  const int chan = seg == 0 ? h * 64 + c8 : (seg == 1 ? 512 + grp * 64 + c8 : 640 + grp * 64 + c8);
  float cwv[4][8], cbv[8];
  if (BR == 1 && act) {
    const float* cw = P.in[13] + (size_t)l * 4 * 768 + chan;
    const float* cb = P.in[14] + (size_t)l * 768 + chan;
#pragma unroll
    for (int i = 0; i < 4; ++i) {
      *(float4*)&cwv[i][0] = *(const float4*)(cw + i * 768);
      *(float4*)&cwv[i][4] = *(const float4*)(cw + i * 768 + 4);
    }
    *(float4*)&cbv[0] = *(const float4*)cb;
    *(float4*)&cbv[4] = *(const float4*)(cb + 4);
  }
#define REC_LOAD(CB, RGD)                                                                                     \
  {                                                                                                           \
    const int goff_ = BR == 0 ? 1024 + h * 128 : (BR == 1 ? 1552 + h * 64 : 3864 + h * 128);                  \
    _Pragma("unroll") for (int it = 0; it < NEP; ++it) {                                                      \
      const int id = tid + 256 * it;                                                                          \
      const int t = (DV == 128) ? (id >> 4) : (id >> 3);                                                      \
      const int j0 = (DV == 128) ? (id & 15) * 8 : (id & 7) * 8;                                              \
      RGD[it] = *(const uint4*)(proj + (size_t)(row0 + min((CB) + t, T - 1)) * NPJ + goff_ + j0);             \
    }                                                                                                         \
    if (BR == 0) {                                                                                            \
      _Pragma("unroll") for (int it = 0; it < 2; ++it) {                                                      \
        const int id = tid + 256 * it;                                                                        \
        const int t = id >> 3, i0 = (id & 7) * 8;                                                             \
        const u16* rp = proj + (size_t)(row0 + min((CB) + t, T - 1)) * NPJ + h * 64 + i0;                     \
        Rq[it] = *(const uint4*)rp;                                                                           \
        Rk[it] = *(const uint4*)(rp + 256);                                                                   \
      }                                                                                                       \
      { const int t = (tid & 127) >> 1, hf = tid & 1;                                                         \
        Ral = *(const uint4*)(proj + (size_t)(row0 + min((CB) + t, T - 1)) * NPJ + 1536 + hf * 8); }          \
    }                                                                                                         \
    if (BR == 2) {                                                                                            \
      const int t = tid >> 2, i0 = (tid & 3) * 8;                                                             \
      const u16* rp = proj + (size_t)(row0 + min((CB) + t, T - 1)) * NPJ + 2840 + h * 64 + i0;                \
      Rq1 = *(const uint4*)rp; Rq2 = *(const uint4*)(rp + 32);                                                \
      Rk1 = *(const uint4*)(rp + 256); Rk2 = *(const uint4*)(rp + 288);                                       \
    }                                                                                                         \
    if (BR == 1) {                                                                                            \
      if (act) {                                                                                              \
        _Pragma("unroll") for (int k = 0; k < 11; ++k) {                                                      \
          int tau = (CB) + ts * 8 - 3 + k;                                                                    \
          tau = min(max(tau, 0), T - 1);                                                                      \
          Rx[k] = *(const uint4*)(proj + (size_t)(row0 + tau) * NPJ + 2064 + chan);                           \
        }                                                                                                     \
      }                                                                                                       \
      if (w == 0) dtraw = bf2f(proj[(size_t)(row0 + min((CB) + lane, T - 1)) * NPJ + 2832 + h]);              \
    }                                                                                                         \
  }
  REC_LOAD(0, Rg)

  for (int c0 = 0; c0 < T; c0 += 64) {
    const int nvalid = min(64, T - c0);
    if (BR == 0 || BR == 2) {
      const int voff_ = (BR == 0 ? 512 : 3352) + h * 128;
#pragma unroll
      for (int it = 0; it < 4; ++it) {
        const int id = tid + 256 * it;
        const int t = id >> 4, j0 = (id & 15) * 8;
        Rv[it] = *(const uint4*)(proj + (size_t)(row0 + min(c0 + t, T - 1)) * NPJ + voff_ + j0);
      }
    }
    if (BR == 0) {
      if (tid < 128) {
        const int t = tid >> 1, hf = tid & 1;
        float a8[8];
        unpack8(Ral, a8);
        *(float4*)(AL + t * 16 + hf * 8) = make_float4(a8[0], a8[1], a8[2], a8[3]);
        *(float4*)(AL + t * 16 + hf * 8 + 4) = make_float4(a8[4], a8[5], a8[6], a8[7]);
      }
      __syncthreads();
      {
        float run = 0.f;
#pragma unroll 4
        for (int tt = 0; tt < 16; ++tt) {
          const int t = part * 16 + tt;
          const float4 x0 = *(const float4*)(AL + t * 16), x1 = *(const float4*)(AL + t * 16 + 4);
          const float4 x2 = *(const float4*)(AL + t * 16 + 8), x3 = *(const float4*)(AL + t * 16 + 12);
          float a = bias;
          a += x0.x * w2r[0] + x0.y * w2r[1] + x0.z * w2r[2] + x0.w * w2r[3];
          a += x1.x * w2r[4] + x1.y * w2r[5] + x1.z * w2r[6] + x1.w * w2r[7];
          a += x2.x * w2r[8] + x2.y * w2r[9] + x2.z * w2r[10] + x2.w * w2r[11];
          a += x3.x * w2r[12] + x3.y * w2r[13] + x3.z * w2r[14] + x3.w * w2r[15];
          float g = (fminf(a, 0.f) - __logf(1.f + __expf(-fabsf(a)))) * (1.f / 16.f);
          if (t >= nvalid) g = 0.f;
          run += g;
          Gl[t * 64 + ci] = run;
        }
        psum[part * 64 + ci] = run;
      }
      __syncthreads();
      {
        float off = 0.f;
        for (int p = 0; p < part; ++p) off += psum[p * 64 + ci];
#pragma unroll 4
        for (int tt = 0; tt < 16; ++tt) Gl[(part * 16 + tt) * 64 + ci] += off;
      }
      __syncthreads();
#pragma unroll
      for (int it = 0; it < 2; ++it) {
        const int id = tid + 256 * it;
        const int t = id >> 3, i0 = (id & 7) * 8;
        const bool valid = t < nvalid;
        float qf[8], kf[8], G[8], Ge[8], qa[8], kb[8];
        unpack8(Rq[it], qf); unpack8(Rk[it], kf);
        *(float4*)&G[0] = *(const float4*)(Gl + t * 64 + i0);
        *(float4*)&G[4] = *(const float4*)(Gl + t * 64 + i0 + 4);
        *(float4*)&Ge[0] = *(const float4*)(Gl + 63 * 64 + i0);
        *(float4*)&Ge[4] = *(const float4*)(Gl + 63 * 64 + i0 + 4);
#pragma unroll
        for (int e = 0; e < 8; ++e) {
          const float qv = valid ? qf[e] : 0.f, kv = valid ? kf[e] : 0.f;
          const float eg = __expf(G[e]);
          const float ig = __builtin_amdgcn_rcpf(eg);
          Ge[e] = __expf(Ge[e]);
          qa[e] = qv * 0.125f * eg;
          kb[e] = kv * ig;
          KT[tsw(i0 + e, t)] = (u16)f2bf(kv * (Ge[e] * ig));
        }
        *(uint4*)(QA + t * LDT + i0) = pack8(qa);
        *(uint4*)(KB + t * LDT + i0) = pack8(kb);
        if (t == 63) {
#pragma unroll
          for (int e = 0; e < 8; ++e) dec[i0 + e] = Ge[e];
        }
        __builtin_amdgcn_sched_barrier(0);
      }
#pragma unroll
      for (int it = 0; it < 4; ++it) {
        const int id = tid + 256 * it;
        const int t = id >> 4, j0 = (id & 15) * 8;
        uint4 v4 = Rv[it];
        if (t >= nvalid) v4 = make_uint4(0, 0, 0, 0);
        VT[tsw(j0 + 0, t)] = (u16)(v4.x & 0xffffu); VT[tsw(j0 + 1, t)] = (u16)(v4.x >> 16);
        VT[tsw(j0 + 2, t)] = (u16)(v4.y & 0xffffu); VT[tsw(j0 + 3, t)] = (u16)(v4.y >> 16);
        VT[tsw(j0 + 4, t)] = (u16)(v4.z & 0xffffu); VT[tsw(j0 + 5, t)] = (u16)(v4.z >> 16);
        VT[tsw(j0 + 6, t)] = (u16)(v4.w & 0xffffu); VT[tsw(j0 + 7, t)] = (u16)(v4.w >> 16);
      }
      if (tid < 64) Gsc[tid] = 0.f;
    }
    if (BR == 2) {
      {
        const int t = tid >> 2, i0 = (tid & 3) * 8;
        const bool valid = t < nvalid;
        float q1f[8], q2f[8], k1f[8], k2f[8], o1[8], o2[8], p1[8], p2[8];
        unpack8(Rq1, q1f); unpack8(Rq2, q2f); unpack8(Rk1, k1f); unpack8(Rk2, k2f);
        const float pos = (float)(pos0 + c0 + t);
        const float ed = __expf(lg * (float)(nvalid - min(t + 1, nvalid)));
#pragma unroll
        for (int e = 0; e < 8; ++e) {
          const float ang = pos * invf[i0 + e];
          const float nrev = rintf(ang * 0.15915493667125702f);
          const float rf = fmaf(ang, 6.4206382432985265e-09f, fmaf(ang, 0.15915493667125702f, -nrev));
          const float sn = __builtin_amdgcn_sinf(rf), cs = __builtin_amdgcn_cosf(rf);
          const float a1 = valid ? q1f[e] : 0.f, a2 = valid ? q2f[e] : 0.f;
          const float b1 = valid ? k1f[e] : 0.f, b2 = valid ? k2f[e] : 0.f;
          o1[e] = a1 * cs - a2 * sn;
          o2[e] = a1 * sn + a2 * cs;
          p1[e] = (b1 * cs - b2 * sn) * 0.125f;
          p2[e] = (b1 * sn + b2 * cs) * 0.125f;
          KT[tsw(i0 + e, t)] = (u16)f2bf(p1[e] * ed);
          KT[tsw(32 + i0 + e, t)] = (u16)f2bf(p2[e] * ed);
        }
        *(uint4*)(QA + t * LDT + i0) = pack8(o1);
        *(uint4*)(QA + t * LDT + 32 + i0) = pack8(o2);
        *(uint4*)(KB + t * LDT + i0) = pack8(p1);
        *(uint4*)(KB + t * LDT + 32 + i0) = pack8(p2);
      }
#pragma unroll
      for (int it = 0; it < 4; ++it) {
        const int id = tid + 256 * it;
        const int t = id >> 4, j0 = (id & 15) * 8;
        uint4 v4 = Rv[it];
        if (t >= nvalid) v4 = make_uint4(0, 0, 0, 0);
        VT[tsw(j0 + 0, t)] = (u16)(v4.x & 0xffffu); VT[tsw(j0 + 1, t)] = (u16)(v4.x >> 16);
        VT[tsw(j0 + 2, t)] = (u16)(v4.y & 0xffffu); VT[tsw(j0 + 3, t)] = (u16)(v4.y >> 16);
        VT[tsw(j0 + 4, t)] = (u16)(v4.z & 0xffffu); VT[tsw(j0 + 5, t)] = (u16)(v4.z >> 16);
        VT[tsw(j0 + 6, t)] = (u16)(v4.w & 0xffffu); VT[tsw(j0 + 7, t)] = (u16)(v4.w >> 16);
      }
      if (tid < 64) {
        Gsc[tid] = lg * (float)min(tid + 1, nvalid);
        dec[tid] = __expf(lg * (float)nvalid);
      }
    }
    if (BR == 1) {
      if (w == 0) {
        float dt = 0.f, g = 0.f;
        if (lane < nvalid) {
          dt = softplus_f(dtraw + dtb);
          g = dt * aneg;
        }
        float x = g;
#pragma unroll
        for (int o = 1; o < 64; o <<= 1) {
          float y = __shfl_up(x, o);
          if (lane >= o) x += y;
        }
        const float ge = __shfl(x, 63);
        Gsc[lane] = x; dtv[lane] = dt; dec[lane] = __expf(ge); psum[lane] = __expf(ge - x);
      }
      __syncthreads();
      if (act) {
        const bool first = (c0 == 0 && ts == 0);
        const float* cst = P.in[4] + (size_t)(l * 128 + b) * 3 * 768 + chan;
#pragma unroll
        for (int p = 0; p < 4; ++p) {
          float x0[11], x1[11];
#pragma unroll
          for (int k = 0; k < 11; ++k) {
            const unsigned wd = p == 0 ? Rx[k].x : (p == 1 ? Rx[k].y : (p == 2 ? Rx[k].z : Rx[k].w));
            x0[k] = __uint_as_float(wd << 16);
            x1[k] = __uint_as_float(wd & 0xffff0000u);
          }
          if (first) {
#pragma unroll
            for (int k = 0; k < 3; ++k) {
              const float2 sv = *(const float2*)(cst + k * 768 + 2 * p);
              x0[k] = sample ? sv.x : 0.f;
              x1[k] = sample ? sv.y : 0.f;
            }
          }
          float o0[8], o1[8];
#pragma unroll
          for (int tt = 0; tt < 8; ++tt) {
            const bool valid = (ts * 8 + tt) < nvalid;
            float a0 = cbv[2 * p], a1 = cbv[2 * p + 1];
#pragma unroll
            for (int i = 0; i < 4; ++i) { a0 += cwv[i][2 * p] * x0[tt + i]; a1 += cwv[i][2 * p + 1] * x1[tt + i]; }
            o0[tt] = valid ? silu_f(a0) : 0.f;
            o1[tt] = valid ? silu_f(a1) : 0.f;
          }
          u16* rowdst = seg == 0 ? XH : (seg == 1 ? KB : QA);
#pragma unroll
          for (int tt = 0; tt < 8; ++tt) *(unsigned*)(rowdst + (ts * 8 + tt) * LDT + c8 + 2 * p) = pack2(o0[tt], o1[tt]);
          if (seg < 2) {
            const float* sc = seg == 0 ? dtv : psum;
            u16* cdst = seg == 0 ? VT : KT;
            float c0v[8], c1v[8];
#pragma unroll
            for (int tt = 0; tt < 8; ++tt) { const float f = sc[ts * 8 + tt]; c0v[tt] = o0[tt] * f; c1v[tt] = o1[tt] * f; }
            *(uint4*)(cdst + tsw(c8 + 2 * p, ts * 8)) = pack8(c0v);
            *(uint4*)(cdst + tsw(c8 + 2 * p + 1, ts * 8)) = pack8(c1v);
          }
          __builtin_amdgcn_sched_barrier(0);
        }
      }
    }
    __syncthreads();
    if (c0 + 64 < T) { REC_LOAD(c0 + 64, RgN) }

#pragma unroll
    for (int nf = 0; nf < NFV; ++nf)
      *(uint2*)(ST + (nf * 16 + r) * LDT + 16 * w + q * 4) = make_uint2(pack2(S[nf][0], S[nf][1]), pack2(S[nf][2], S[nf][3]));

    bf16x8 aq[2];
    aq[0] = *(const bf16x8*)(QA + (16 * w + r) * LDT + q * 8);
    aq[1] = *(const bf16x8*)(QA + (16 * w + r) * LDT + 32 + q * 8);
    float gt[4];
#pragma unroll
    for (int e = 0; e < 4; ++e) gt[e] = Gsc[16 * w + q * 4 + e];
#pragma unroll
    for (int n = 0; n < 4; ++n) {
      f32x4 a = (f32x4){0.f, 0.f, 0.f, 0.f};
      if (n <= w) {
#pragma unroll
        for (int kk = 0; kk < 2; ++kk) {
          bf16x8 bk = *(const bf16x8*)(KB + (16 * n + r) * LDT + kk * 32 + q * 8);
          a = __builtin_amdgcn_mfma_f32_16x16x32_bf16(aq[kk], bk, a, 0, 0, 0);
        }
      }
      const int s = 16 * n + r;
      const float gs = Gsc[s];
#pragma unroll
      for (int e = 0; e < 4; ++e) {
        const int t = 16 * w + q * 4 + e;
        float v = (s <= t) ? a[e] * __expf(gt[e] - gs) : 0.f;
        ATT[t * LDT + s] = (u16)f2bf(v);
      }
    }
    __syncthreads();

    f32x4 O[NFV];
#pragma unroll
    for (int nf = 0; nf < NFV; ++nf) O[nf] = (f32x4){0.f, 0.f, 0.f, 0.f};
#pragma unroll
    for (int kk = 0; kk < 2; ++kk)
#pragma unroll
      for (int nf = 0; nf < NFV; ++nf) {
        bf16x8 bs = *(const bf16x8*)(ST + (nf * 16 + r) * LDT + kk * 32 + q * 8);
        O[nf] = __builtin_amdgcn_mfma_f32_16x16x32_bf16(aq[kk], bs, O[nf], 0, 0, 0);
      }
    if (BR != 0) {
#pragma unroll
      for (int e = 0; e < 4; ++e) {
        const float sc = __expf(gt[e]);
#pragma unroll
        for (int nf = 0; nf < NFV; ++nf) O[nf][e] *= sc;
      }
    }
    {
      float dc[4];
#pragma unroll
      for (int e = 0; e < 4; ++e) dc[e] = dec[16 * w + q * 4 + e];
#pragma unroll
      for (int nf = 0; nf < NFV; ++nf)
#pragma unroll
        for (int e = 0; e < 4; ++e) S[nf][e] *= dc[e];
    }
    int vtb[2], ktb[2];
    vtb[0] = r * LDT + ((q ^ (r >> 3)) << 3);
    vtb[1] = r * LDT + ((q ^ (2 + (r >> 3))) << 3);
    ktb[0] = tsw(16 * w + r, q * 8);
    ktb[1] = tsw(16 * w + r, 32 + q * 8);
#pragma unroll
    for (int kk = 0; kk < 2; ++kk) {
      bf16x8 at = *(const bf16x8*)(ATT + (16 * w + r) * LDT + kk * 32 + q * 8);
      bf16x8 ak = *(const bf16x8*)(KT + ktb[kk]);
#pragma unroll
      for (int nf = 0; nf < NFV; ++nf) {
        bf16x8 bv = *(const bf16x8*)(VT + vtb[nf & 1] + nf * 16 * LDT + ((kk ^ ((nf >> 1) & 1)) * 32));
        O[nf] = __builtin_amdgcn_mfma_f32_16x16x32_bf16(at, bv, O[nf], 0, 0, 0);
        S[nf] = __builtin_amdgcn_mfma_f32_16x16x32_bf16(ak, bv, S[nf], 0, 0, 0);
      }
    }
    __syncthreads();
#pragma unroll
    for (int nf = 0; nf < NFV; ++nf)
#pragma unroll
      for (int e = 0; e < 4; ++e) OST[(16 * w + q * 4 + e) * OLD + nf * 16 + r] = O[nf][e];
    __syncthreads();

#pragma unroll
    for (int it = 0; it < NEP; ++it) {
      const int id = tid + 256 * it;
      const int t = (DV == 128) ? (id >> 4) : (id >> 3);
      const int j0 = (DV == 128) ? (id & 15) * 8 : (id & 7) * 8;
      const bool valid = t < nvalid;
      const size_t row = (size_t)(row0 + c0 + t);
      float ov[8], gv[8], y[8];
      *(float4*)&ov[0] = *(const float4*)(OST + t * OLD + j0);
      *(float4*)&ov[4] = *(const float4*)(OST + t * OLD + j0 + 4);
      unpack8(Rg[it], gv);
      if (BR == 1) {
        float xh[8];
        unpack8(*(const uint4*)(XH + t * LDT + j0), xh);
        float ss = 0.f;
#pragma unroll
        for (int e = 0; e < 8; ++e) { y[e] = (ov[e] + dsk * xh[e]) * silu_rcp(gv[e]); ss += y[e] * y[e]; }
        ss += __shfl_xor(ss, 1); ss += __shfl_xor(ss, 2); ss += __shfl_xor(ss, 4);
        if (valid) {
          *(uint4*)(ybr + row * LDY + h * 64 + j0) = pack8(y);
          if ((tid & 7) == 0) ssq[row * 8 + h] = ss;
        }
      } else {
        float ss = 0.f;
#pragma unroll
        for (int e = 0; e < 8; ++e) ss += ov[e] * ov[e];
        ss += __shfl_xor(ss, 1); ss += __shfl_xor(ss, 2); ss += __shfl_xor(ss, 4); ss += __shfl_xor(ss, 8);
        const float rs = rsqrtf(ss * (1.f / 128.f) + 1e-6f);
        if (BR == 0) {
          const float* wn = P.in[12] + l * 128 + j0;
          const float4 w0 = *(const float4*)wn, w1 = *(const float4*)(wn + 4);
          const float wv[8] = {w0.x, w0.y, w0.z, w0.w, w1.x, w1.y, w1.z, w1.w};
#pragma unroll
          for (int e = 0; e < 8; ++e) y[e] = silu_rcp(gv[e]) * ov[e] * rs * wv[e];
        } else {
#pragma unroll
          for (int e = 0; e < 8; ++e) y[e] = silu_rcp(gv[e]) * ov[e] * rs;
        }
        if (valid) *(uint4*)(ybr + row * LDY + h * 128 + j0) = pack8(y);
      }
      __builtin_amdgcn_sched_barrier(0);
    }
#pragma unroll
    for (int it = 0; it < NEP; ++it) Rg[it] = RgN[it];
    __syncthreads();
  }
#undef REC_LOAD

  {
    float* so;
    if (sample) so = P.out + (BR == 0 ? O_SGS : (BR == 1 ? O_SSS : O_SRS)) + ((size_t)(l * 128 + b) * NH + h) * 64 * DV;
    else so = P.out + (BR == 0 ? O_SGP : (BR == 1 ? O_SSP : O_SRP)) + ((size_t)(l * 8 + b) * NH + h) * 64 * DV;
#pragma unroll
    for (int nf = 0; nf < NFV; ++nf)
#pragma unroll
      for (int e = 0; e < 4; ++e) so[(size_t)(16 * w + q * 4 + e) * DV + nf * 16 + r] = S[nf][e];
  }
}

#ifndef REC_ONLY
#define REC_ONLY -1
#endif
template <int BR>
__device__ __forceinline__ void rec_branch(const Params& P, int l, bool split, int wb, int nwb, int lb0, unsigned char* ldsb) {
  if (!(REC_ONLY < 0 || REC_ONLY == BR)) return;
  constexpr int NH = (BR == 1) ? 8 : 4;
  constexpr int nl = 8 * NH;
  const int end = nl + 128 * NH;
  int it, step;
  if (split) {
    const int bx = blockIdx.x;
    if (bx >= lb0 && bx < lb0 + nl) { it = bx - lb0; step = 1 << 20; }
    else if (bx >= 128) { it = nl + wb; step = nwb; }
    else { it = end; step = 1; }
  } else { it = blockIdx.x; step = gridDim.x; }
  for (; it < end; it += step) {
    const int sample = it >= nl;
    const int idx = sample ? it - nl : it;
    int ll = l;
    asm volatile("" : "+s"(ll));
    rec_item<BR>(P, ll, idx / NH, idx % NH, sample, ldsb);
  }
}

__device__ __forceinline__ void phase_rec(const Params& P, int l, unsigned char* ldsb) {
  const int G = gridDim.x;
  const u16* proj = (const u16*)(P.ws + WS_A);
  const bool split = (G >= 256);
  const int wb = split ? (int)blockIdx.x - 128 : (int)blockIdx.x;
  int nwb = split ? G - 128 : G;
  asm volatile("" : "+s"(nwb));
  if (wb >= 0) {
    for (int i = wb * 256 + otid(); i < (8 + 128) * 3 * 768; i += nwb * 256) {
      const bool pr = i < 8 * 3 * 768;
      const int j = pr ? i : i - 8 * 3 * 768;
      const int b = j / (3 * 768), rem = j - b * 3 * 768, rr = rem / 768, c = rem - rr * 768;
      const size_t row = pr ? (size_t)(b * TP + 2061 + rr) : (size_t)(MP + b * 4 + 1 + rr);
      const size_t oo = pr ? O_SCP + (size_t)l * 8 * 3 * 768 + j : O_SCS + (size_t)l * 128 * 3 * 768 + j;
      P.out[oo] = bf2f(proj[row * NPJ + 2064 + c]);
    }
  }
  rec_branch<0>(P, l, split, wb, nwb, 0, ldsb);
  rec_branch<1>(P, l, split, wb, nwb, 32, ldsb);
  rec_branch<2>(P, l, split, wb, nwb, 96, ldsb);
  if (wb >= 0) {
    __syncthreads();
    if (l == 0) {
      convert_layer(P, 0, ldsb, 1888, 4576, wb, nwb);
      convert_layer(P, 1, ldsb, 0, 2528, wb, nwb);
    } else {
      convert_layer(P, 1, ldsb, 2528, 4576, wb, nwb);
    }
    phase_gates(P, l, wb, nwb, ldsb);
  }
}


#define XB_TMO      128
#define XB_XCNT(j)  (256  + 64 * (j))
#define XB_XSUB(j)  (1280 + 64 * (j))
#define XB_XGEN(j)  (2304 + 64 * (j))
#define XB_TOP      3328
#define XB_TOPGEN   3392
#define XCD_BAR_WORDS 3456
#define XB_SPIN_CAP (1u << 22)
__device__ __forceinline__ unsigned xb_ld(unsigned* p) { return __hip_atomic_load(p, __ATOMIC_RELAXED, __HIP_MEMORY_SCOPE_AGENT); }
__device__ __forceinline__ unsigned xb_add(unsigned* p, unsigned v) { return __hip_atomic_fetch_add(p, v, __ATOMIC_RELAXED, __HIP_MEMORY_SCOPE_AGENT); }
__device__ __forceinline__ unsigned xb_xcc_id() { return (unsigned)__builtin_amdgcn_s_getreg((3 << 11) | 20) & 0xFu; }
#define XB_SPIN(cond, bar) do { unsigned _sp = 0; while (cond) { __builtin_amdgcn_s_sleep(1); \
    if ((++_sp & 255u) == 0u) { if (xb_ld(&(bar)[XB_TMO])) break; if (_sp > XB_SPIN_CAP) { atomicAdd(&(bar)[XB_TMO], 1u); break; } } } } while (0)
struct XcdBarrier { unsigned* bar; unsigned x; volatile LAS unsigned* st; };
__device__ __forceinline__ XcdBarrier xcd_barrier_post(unsigned* bar, volatile LAS unsigned* st) {
  XcdBarrier b; b.bar = bar; b.x = xb_xcc_id(); b.st = st;
  if (threadIdx.x == 0) (void)xb_add(&bar[XB_XCNT(b.x)], 1u);
  return b;
}
__device__ __forceinline__ void xcd_barrier_complete(unsigned* bar, unsigned x, unsigned& nloc, unsigned& nx) {
  const unsigned G = gridDim.x * gridDim.y * gridDim.z;
  unsigned sum, cnt, mine, sp = 0u;
  for (;;) {
    sum = 0u; cnt = 0u; mine = 0u;
#pragma unroll
    for (unsigned j = 0; j < 16; ++j) { const unsigned c = xb_ld(&bar[XB_XCNT(j)]); sum += c; cnt += (c > 0u) ? 1u : 0u; mine = (j == x) ? c : mine; }
    if (sum == G) break;
    __builtin_amdgcn_s_sleep(1);
    if ((++sp & 255u) == 0u) { if (xb_ld(&bar[XB_TMO])) break; if (sp > XB_SPIN_CAP) { atomicAdd(&bar[XB_TMO], 1u); break; } }
  }
  nloc = mine > 0u ? mine : 1u; nx = cnt > 0u ? cnt : 1u;
}
__device__ __forceinline__ void xcd_barrier(const XcdBarrier& b) {
  asm volatile("s_waitcnt vmcnt(0)" ::: "memory");
  __syncthreads();
  if (threadIdx.x == 0) {
    unsigned* bar = b.bar;
    __builtin_amdgcn_s_waitcnt(0);
    unsigned nloc = b.st[0], nx = b.st[1];
    if (nloc == 0u) { xcd_barrier_complete(bar, b.x, nloc, nx); b.st[0] = nloc; b.st[1] = nx; }
    const unsigned old = xb_add(&bar[XB_XSUB(b.x)], 1u);
    const unsigned gen = old / nloc;
    if (old + 1u == (gen + 1u) * nloc) {
      __builtin_amdgcn_fence(__ATOMIC_RELEASE, "agent");
      asm volatile("s_waitcnt vmcnt(0)" ::: "memory");
      const unsigned og = xb_add(&bar[XB_TOP], 1u);
      const unsigned tg = og / nx;
      if (og + 1u == (tg + 1u) * nx) xb_add(&bar[XB_TOPGEN], 1u);
      else XB_SPIN(xb_ld(&bar[XB_TOPGEN]) == tg, bar);
      __builtin_amdgcn_fence(__ATOMIC_ACQUIRE, "agent");
      xb_add(&bar[XB_XGEN(b.x)], 1u);
      asm volatile("s_waitcnt vmcnt(0)" ::: "memory");
    } else {
      XB_SPIN(xb_ld(&bar[XB_XGEN(b.x)]) == gen, bar);
      __builtin_amdgcn_fence(__ATOMIC_ACQUIRE, "agent");
      asm volatile("s_waitcnt vmcnt(0)" ::: "memory");
    }
  }
  __syncthreads();
}

__global__ void __launch_bounds__(256, 2) fwd_kernel(Params P, int ph_lo, int ph_hi) {
  extern __shared__ __attribute__((aligned(16))) unsigned char ldsb[];
  cg::grid_group grid = cg::this_grid();
  volatile LAS unsigned* xst = (volatile LAS unsigned*)(ldsb + 75904);
  if (threadIdx.x == 0) { xst[0] = 0u; xst[1] = 0u; xst[2] = 0u; xst[3] = 0u; }
  __syncthreads();
  XcdBarrier xb = xcd_barrier_post((unsigned*)(P.ws + WS_BAR), xst);
  if (ph_hi > 1000) grid.sync();
  for (int ph = ph_lo; ph < ph_hi; ++ph) {
    if (ph > ph_lo) xcd_barrier(xb);
    if (ph == 0) {
      if (PH_ON(0)) { convert_layer(P, 0, ldsb, 0, 1888, blockIdx.x, gridDim.x); ln_phase(P, 0, 0); }
      continue;
    }
    int phl = ph;
    asm volatile("" : "+s"(phl));
    const int l = (phl - 1) >> 3, s = (phl - 1) & 7;
    switch (s) {
      case 0: if (PH_ON(1)) { phase_proj(P, l, ldsb); if (DUP(1)) phase_proj(P, l, ldsb); } break;
      case 1: if (PH_ON(2)) { phase_rec(P, l, ldsb); if (DUP(2)) { __syncthreads(); phase_rec(P, l, ldsb); } } break;
      case 2: if (PH_ON(3)) { phase_merge(P, l, ldsb); if (DUP(3)) phase_merge(P, l, ldsb); } break;
      case 3: if (PH_ON(4)) { phase_resid(P, 0, l, ldsb); if (DUP(4)) phase_resid(P, 0, l, ldsb); } break;
      case 4: if (PH_ON(5)) { ln_phase(P, 1, l); if (DUP(5)) ln_phase(P, 1, l); } break;
      case 5: if (PH_ON(6)) { phase_ff1(P, l, ldsb); if (DUP(6)) phase_ff1(P, l, ldsb); } break;
      case 6: if (PH_ON(7)) { phase_resid(P, 1, l, ldsb); if (DUP(7)) phase_resid(P, 1, l, ldsb); } break;
      case 7:
        if (PH_ON(8)) { ln_phase(P, 2, l); }
        break;
    }
  }
}

extern "C" void kernel_launch(void* const* d_in, const int* in_sizes, int n_in, void* d_out, int out_size, void* d_ws,
                              size_t ws_size, hipStream_t stream) {
  static int grid_blocks = 0;
  if (grid_blocks == 0) {
    if (n_in != 31 || ws_size < WS_END || out_size != 44666880) {
      fprintf(stderr, "kernel_launch: unexpected problem (n_in %d, ws %zu, out %d)\n", n_in, ws_size, out_size);
      grid_blocks = -1;
      return;
    }
    int dev = 0, cus = 0, per_cu = 0;
    hipGetDevice(&dev);
    hipDeviceGetAttribute(&cus, hipDeviceAttributeMultiprocessorCount, dev);
    hipFuncSetAttribute((const void*)fwd_kernel, hipFuncAttributeMaxDynamicSharedMemorySize, LDS_BYTES);
    hipOccupancyMaxActiveBlocksPerMultiprocessor(&per_cu, (const void*)fwd_kernel, 256, LDS_BYTES);
    if (per_cu < 1) { fprintf(stderr, "kernel_launch: occupancy query says 0 blocks per CU\n"); grid_blocks = -1; return; }
    if (per_cu > 2) per_cu = 2;
    grid_blocks = cus * per_cu;
    grid_blocks -= grid_blocks % 8;
  }
  if (grid_blocks < 0) return;
  Params p{};
  for (int i = 0; i < 31; ++i) p.in[i] = (const float*)d_in[i];
  p.out = (float*)d_out;
  p.ws = (unsigned char*)d_ws;
  if (hipMemsetAsync((char*)d_ws + WS_BAR, 0, XCD_BAR_WORDS * 4, stream) != hipSuccess) { fprintf(stderr, "memset failed\n"); return; }
#if ONE_LAUNCH
  int lo = 0, hi = NPHASE;
  void* args[] = {&p, &lo, &hi};
  hipError_t e = hipLaunchCooperativeKernel((const void*)fwd_kernel, dim3(grid_blocks), dim3(256), args, LDS_BYTES, stream);
  if (e != hipSuccess) fprintf(stderr, "cooperative launch failed: %s (grid %d)\n", hipGetErrorString(e), grid_blocks);
#else
  for (int ph = 0; ph < NPHASE; ++ph) {
    hipLaunchKernelGGL(fwd_kernel, dim3(grid_blocks), dim3(256), LDS_BYTES, stream, p, ph, ph + 1);
  }
#endif
}
```
